# Optimizing an MI355X kernel written in HIP

```python
import jax, jax.numpy as jnp
from jax import lax
import numpy as np

D_MODEL = 1024
BATCH = 8
SEQ = 2048
DEPTH = 1

CHUNK = 64
Q_BLOCK = 128
EPS = 1e-6
NEG_INF = -1e30

MLA_HEADS = 4
MLA_NOPE = 128
MLA_ROPE = 64
MLA_V = 128
Q_LORA = 256
KV_LORA = 128
ROPE_THETA = 10000.0

RWKV_HEADS = 8
RWKV_HD = 64
RWKV_W = RWKV_HEADS * RWKV_HD
DECAY_LORA = 64
AAA_LORA = 64
GATE_LORA = 128
LNX_EPS = 64e-5

MLA_OUT = MLA_HEADS * MLA_V
MIX_W = MLA_OUT + RWKV_W

MLA_IN = Q_LORA + KV_LORA + MLA_ROPE
RWKV_IN = 3 * RWKV_W + DECAY_LORA + AAA_LORA + GATE_LORA
IN_COLS = MLA_IN + RWKV_IN

MEM_TOKENS = 256
XA_HEADS = 4
XA_HD = D_MODEL // XA_HEADS

PEER_HEADS = 8
N_KEYS = 128
N_EXPERTS = N_KEYS * N_KEYS
PEER_TOPK = 16
PEER_QDIM = 256
PEER_HALF = PEER_QDIM // 2
TOKEN_BLOCK = 128

kernel_name = "hybrid_mla_rwkv7_peer_block"


def _rmsnorm(x, g):
    xf = x.astype(jnp.float32)
    y = xf * lax.rsqrt(jnp.mean(xf * xf, axis=-1, keepdims=True) + EPS)
    return (y * g.astype(jnp.float32)).astype(x.dtype)


def _split(p, sizes):
    return jnp.split(p, np.cumsum(sizes)[:-1].tolist(), axis=-1)


def _rope(t, positions):
    d = t.shape[-1]
    inv = ROPE_THETA ** (-jnp.arange(0, d, 2, dtype=jnp.float32) / d)
    ang = positions.astype(jnp.float32)[..., None] * inv
    cos, sin = jnp.cos(ang)[:, :, None, :], jnp.sin(ang)[:, :, None, :]
    tf = t.astype(jnp.float32)
    t1, t2 = tf[..., : d // 2], tf[..., d // 2:]
    return jnp.concatenate([t1 * cos - t2 * sin, t1 * sin + t2 * cos], axis=-1).astype(t.dtype)


def _mla_group(p, positions, q_norm_g, kv_norm_g, w_uq, w_ukv):
    B, S, _ = p.shape
    c_q, c_kv, k_r = _split(p, [Q_LORA, KV_LORA, MLA_ROPE])
    q = (_rmsnorm(c_q, q_norm_g) @ w_uq).reshape(B, S, MLA_HEADS, MLA_NOPE + MLA_ROPE)
    kv = (_rmsnorm(c_kv, kv_norm_g) @ w_ukv).reshape(B, S, MLA_HEADS, MLA_NOPE + MLA_V)
    q_nope, q_rope = q[..., :MLA_NOPE], _rope(q[..., MLA_NOPE:], positions)
    k_nope, v = kv[..., :MLA_NOPE], kv[..., MLA_NOPE:]
    k_rope = jnp.broadcast_to(_rope(k_r[:, :, None, :], positions), (B, S, MLA_HEADS, MLA_ROPE))
    q = jnp.concatenate([q_nope, q_rope], axis=-1)
    k = jnp.concatenate([k_nope, k_rope], axis=-1)
    scale = (MLA_NOPE + MLA_ROPE) ** -0.5
    chunk_id = jnp.arange(S) // CHUNK
    outs = []
    for i in range(S // Q_BLOCK):
        s0, s1 = i * Q_BLOCK, (i + 1) * Q_BLOCK
        sc = jnp.einsum('bqhd,bkhd->bhqk', q[:, s0:s1], k[:, :s1],
                        preferred_element_type=jnp.float32) * scale
        mask = chunk_id[s0:s1, None] >= chunk_id[None, :s1]
        sc = jnp.where(mask[None, None], sc, NEG_INF)
        pr = jax.nn.softmax(sc, axis=-1).astype(v.dtype)
        outs.append(jnp.einsum('bhqk,bkhd->bqhd', pr, v[:, :s1]))
    return jnp.concatenate(outs, axis=1).reshape(B, S, MLA_OUT)


def _rwkv_scan(r, w, k, v, kk, a):
    B, S, H, N = r.shape

    def step(state, inp):
        r_t, w_t, k_t, v_t, kk_t, a_t = inp
        sa = jnp.einsum('bhvk,bhk->bhv', state, kk_t)
        state = (state * w_t[:, :, None, :]
                 - sa[..., None] * (kk_t * a_t)[:, :, None, :]
                 + v_t[..., None] * k_t[:, :, None, :])
        return state, jnp.einsum('bhvk,bhk->bhv', state, r_t)

    xs = tuple(jnp.moveaxis(t, 1, 0) for t in (r, w, k, v, kk, a))
    _, ys = lax.scan(step, jnp.zeros((B, H, N, N), jnp.float32), xs)
    return jnp.moveaxis(ys, 0, 1)


def _rwkv7_group(p, shift_mu, w0, w_up, a0, a_up, g_up, k_k, k_a, r_k, lnx_w, lnx_b):
    B, S, _ = p.shape
    f32 = jnp.float32
    p_prev = jnp.pad(p[:, :-1], ((0, 0), (1, 0), (0, 0)))
    p = p + (p_prev - p) * shift_mu
    r, k, v, wd, ad, gd = _split(p, [RWKV_W, RWKV_W, RWKV_W, DECAY_LORA, AAA_LORA, GATE_LORA])
    r, k, v = r.astype(f32), k.astype(f32), v.astype(f32)
    w_pre = (w0 + jnp.tanh(wd) @ w_up).astype(f32)
    decay = jnp.exp(-jnp.exp(-jax.nn.softplus(-w_pre) - 0.5))
    a = jax.nn.sigmoid((a0 + ad @ a_up).astype(f32))
    g = (jax.nn.sigmoid(gd) @ g_up).astype(f32)
    hs = lambda t: t.reshape(B, S, RWKV_HEADS, RWKV_HD)
    kk = hs(k * k_k.astype(f32))
    kk = kk / jnp.maximum(jnp.linalg.norm(kk, axis=-1, keepdims=True), 1e-12)
    k = k * (1.0 + (a - 1.0) * k_a.astype(f32))
    r, k, v, decay, a = hs(r), hs(k), hs(v), hs(decay), hs(a)
    y = _rwkv_scan(r, decay, k, v, kk, a)
    mu = jnp.mean(y, axis=-1, keepdims=True)
    var = jnp.mean(jnp.square(y - mu), axis=-1, keepdims=True)
    y = ((y - mu) * lax.rsqrt(var + LNX_EPS)).reshape(B, S, RWKV_W)
    y = y * lnx_w.astype(f32) + lnx_b.astype(f32)
    bonus = jnp.sum(r * k * r_k.astype(f32), axis=-1, keepdims=True) * v
    y = (y + bonus.reshape(B, S, RWKV_W)) * g
    return y.astype(p.dtype)


def _cross_attention(hn, memn, wq, wk, wv, wo):
    B, S, _ = hn.shape
    M = memn.shape[1]
    q = (hn @ wq).reshape(B, S, XA_HEADS, XA_HD)
    km = (memn @ wk).reshape(B, M, XA_HEADS, XA_HD)
    vm = (memn @ wv).reshape(B, M, XA_HEADS, XA_HD)
    sc = jnp.einsum('bqhd,bmhd->bhqm', q, km, preferred_element_type=jnp.float32) * XA_HD ** -0.5
    pr = jax.nn.softmax(sc, axis=-1).astype(vm.dtype)
    o = jnp.einsum('bhqm,bmhd->bqhd', pr, vm).reshape(B, S, D_MODEL)
    return o @ wo


def _peer(hn, w_query, sub_keys, expert_u, expert_v):
    B, S, D = hn.shape
    q = (hn @ w_query).reshape(B, S, PEER_HEADS, 2, PEER_HALF)
    s = jnp.einsum('bshpd,hpkd->bshpk', q, sub_keys, preferred_element_type=jnp.float32)
    v1, i1 = lax.top_k(s[..., 0, :], PEER_TOPK)
    v2, i2 = lax.top_k(s[..., 1, :], PEER_TOPK)
    cand = (v1[..., :, None] + v2[..., None, :]).reshape(B, S, PEER_HEADS, PEER_TOPK * PEER_TOPK)
    cv, ci = lax.top_k(cand, PEER_TOPK)
    e1 = jnp.take_along_axis(i1, ci // PEER_TOPK, axis=-1)
    e2 = jnp.take_along_axis(i2, ci % PEER_TOPK, axis=-1)
    expert = e1 * N_KEYS + e2
    gate = jax.nn.softmax(cv, axis=-1)
    T = B * S
    nb = T // TOKEN_BLOCK
    HK = PEER_HEADS * PEER_TOPK
    xb = hn.reshape(nb, TOKEN_BLOCK, D)
    ib = expert.reshape(nb, TOKEN_BLOCK, HK)
    gb = gate.reshape(nb, TOKEN_BLOCK, HK)

    def block(args):
        xt, it, gt = args
        u = expert_u[it]
        pre = jnp.einsum('tkd,td->tk', u, xt, preferred_element_type=jnp.float32)
        act = (jax.nn.gelu(pre, approximate=False) * gt).astype(xt.dtype)
        return jnp.einsum('tk,tkd->td', act, expert_v[it])

    return lax.map(block, (xb, ib, gb)).reshape(B, S, D)


def setup_inputs(seed: int = 0) -> dict:
    key = jax.random.key(seed)
    ks = iter(jax.random.split(key, 64))
    f32 = jnp.float32
    L = DEPTH

    def nrm(shape, scale):
        return jax.random.normal(next(ks), shape, f32) * scale

    def gain(shape):
        return 1.0 + nrm(shape, 0.02)

    x = nrm((BATCH, SEQ, D_MODEL), 1.0)
    mem = nrm((BATCH, MEM_TOKENS, D_MODEL), 1.0)
    offsets = jax.random.randint(next(ks), (BATCH, 1), 0, 4096, dtype=jnp.int32)
    positions = offsets + jnp.arange(SEQ, dtype=jnp.int32)[None, :]
    return {
        "x": x,
        "mem": mem,
        "positions": positions,
        "norm_mix_g": gain((L, D_MODEL)),
        "w_in": nrm((L, D_MODEL, IN_COLS), D_MODEL ** -0.5),
        "shift_mu": jax.random.uniform(next(ks), (L, RWKV_IN), f32),
        "q_norm_g": gain((L, Q_LORA)),
        "kv_norm_g": gain((L, KV_LORA)),
        "w_uq": nrm((L, Q_LORA, MLA_HEADS * (MLA_NOPE + MLA_ROPE)), Q_LORA ** -0.5),
        "w_ukv": nrm((L, KV_LORA, MLA_HEADS * (MLA_NOPE + MLA_V)), KV_LORA ** -0.5),
        "rw_w0": nrm((L, RWKV_W), 1.0),
        "rw_w_up": nrm((L, DECAY_LORA, RWKV_W), DECAY_LORA ** -0.5),
        "rw_a0": nrm((L, RWKV_W), 0.5),
        "rw_a_up": nrm((L, AAA_LORA, RWKV_W), AAA_LORA ** -0.5),
        "rw_g_up": nrm((L, GATE_LORA, RWKV_W), GATE_LORA ** -0.5),
        "rw_k_k": 0.85 + nrm((L, RWKV_W), 0.05),
        "rw_k_a": 1.0 + nrm((L, RWKV_W), 0.05),
        "rw_r_k": nrm((L, RWKV_HEADS, RWKV_HD), 0.1),
        "rw_lnx_w": gain((L, RWKV_W)),
        "rw_lnx_b": nrm((L, RWKV_W), 0.02),
        "w_out": nrm((L, MIX_W, D_MODEL), MIX_W ** -0.5),
        "norm_xa_g": gain((L, D_MODEL)),
        "norm_mem_g": gain((L, D_MODEL)),
        "xa_wq": nrm((L, D_MODEL, D_MODEL), D_MODEL ** -0.5),
        "xa_wk": nrm((L, D_MODEL, D_MODEL), D_MODEL ** -0.5),
        "xa_wv": nrm((L, D_MODEL, D_MODEL), D_MODEL ** -0.5),
        "xa_wo": nrm((L, D_MODEL, D_MODEL), D_MODEL ** -0.5),
        "norm_ffn_g": gain((L, D_MODEL)),
        "peer_wq": nrm((L, D_MODEL, PEER_HEADS * PEER_QDIM), D_MODEL ** -0.5),
        "peer_keys": nrm((L, PEER_HEADS, 2, N_KEYS, PEER_HALF), PEER_HALF ** -0.5),
        "expert_u": nrm((L, N_EXPERTS, D_MODEL), D_MODEL ** -0.5),
        "expert_v": nrm((L, N_EXPERTS, D_MODEL), 0.05),
        "final_norm_g": gain((D_MODEL,)),
    }


def reference(x, mem, positions, norm_mix_g, w_in, shift_mu, q_norm_g, kv_norm_g, w_uq, w_ukv,
              rw_w0, rw_w_up, rw_a0, rw_a_up, rw_g_up, rw_k_k, rw_k_a, rw_r_k, rw_lnx_w, rw_lnx_b,
              w_out, norm_xa_g, norm_mem_g, xa_wq, xa_wk, xa_wv, xa_wo,
              norm_ffn_g, peer_wq, peer_keys, expert_u, expert_v, final_norm_g):
    h = x
    for l in range(DEPTH):
        hn = _rmsnorm(h, norm_mix_g[l])
        p = hn @ w_in[l]
        p_mla, p_rwkv = p[..., :MLA_IN], p[..., MLA_IN:]
        y_mla = _mla_group(p_mla, positions, q_norm_g[l], kv_norm_g[l], w_uq[l], w_ukv[l])
        y_rwkv = _rwkv7_group(p_rwkv, shift_mu[l], rw_w0[l], rw_w_up[l], rw_a0[l], rw_a_up[l],
                              rw_g_up[l], rw_k_k[l], rw_k_a[l], rw_r_k[l], rw_lnx_w[l], rw_lnx_b[l])
        h = h + jnp.concatenate([y_mla, y_rwkv], axis=-1) @ w_out[l]
        hn = _rmsnorm(h, norm_xa_g[l])
        memn = _rmsnorm(mem, norm_mem_g[l])
        h = h + _cross_attention(hn, memn, xa_wq[l], xa_wk[l], xa_wv[l], xa_wo[l])
        hn = _rmsnorm(h, norm_ffn_g[l])
        h = h + _peer(hn, peer_wq[l], peer_keys[l], expert_u[l], expert_v[l])
    return _rmsnorm(h, final_norm_g)
```

```cpp
#include <hip/hip_runtime.h>
#include <hip/hip_cooperative_groups.h>
#include <cstdio>
namespace cg = cooperative_groups;

typedef unsigned short bf16_t;
typedef short bf16x8 __attribute__((ext_vector_type(8)));
typedef float f32x4 __attribute__((ext_vector_type(4)));
typedef unsigned u32x4 __attribute__((ext_vector_type(4)));
typedef unsigned u32x2 __attribute__((ext_vector_type(2)));

#define DEV __device__ __forceinline__

constexpr int T = 16384;
constexpr float EPS = 1e-6f;
constexpr size_t MB = 1u << 20;

constexpr size_t O_WINT  = 0;
constexpr size_t O_WUQT  = O_WINT  + (size_t)2304 * 1024 * 2;
constexpr size_t O_WUKT  = O_WUQT  + (size_t)768 * 256 * 2;
constexpr size_t O_WUVT  = O_WUKT  + (size_t)512 * 128 * 2;
constexpr size_t O_WUPT  = O_WUVT  + (size_t)512 * 128 * 2;
constexpr size_t O_AUPT  = O_WUPT  + (size_t)512 * 64 * 2;
constexpr size_t O_GUPT  = O_AUPT  + (size_t)512 * 64 * 2;
constexpr size_t O_WOUTT = O_GUPT  + (size_t)512 * 128 * 2;
constexpr size_t O_XAQT  = O_WOUTT + (size_t)1024 * 1024 * 2;
constexpr size_t O_XAKVT = O_XAQT  + (size_t)1024 * 1024 * 2;
constexpr size_t O_XAOT  = O_XAKVT + (size_t)2048 * 1024 * 2;
constexpr size_t O_PWQT  = O_XAOT  + (size_t)1024 * 1024 * 2;
constexpr size_t O_KEYS  = O_PWQT  + (size_t)2048 * 1024 * 2;
constexpr size_t O_SSQ   = O_KEYS  + (size_t)16 * 128 * 128 * 2;
constexpr size_t O_CNT   = O_SSQ   + (size_t)8 * 65536;
constexpr size_t O_ROPE  = O_CNT   + 4096;
constexpr size_t O_KM    = O_ROPE  + (size_t)T * 32 * 8;
constexpr size_t O_VMT   = O_KM    + (size_t)2048 * 1024 * 2;
constexpr size_t O_MEMB  = O_VMT   + (size_t)2048 * 1024 * 2;
constexpr size_t O_PERSIST_END = O_MEMB + (size_t)2048 * 1024 * 2;
static_assert(O_PERSIST_END <= 40 * MB, "persistent region too large");
constexpr size_t O_P     = 40 * MB;
constexpr size_t O_YRAW  = 40 * MB;
constexpr size_t O_MIX   = 72 * MB;
constexpr size_t O_OXA   = 40 * MB;
constexpr size_t O_H2B   = 72 * MB;
constexpr size_t O_SCORES= 40 * MB;
constexpr size_t O_XB    = 112 * MB;
constexpr size_t O_G     = 112 * MB;
constexpr size_t O_QXA   = 112 * MB;
constexpr size_t O_RW_R  = 144 * MB;
constexpr size_t O_RW_K  = 160 * MB;
constexpr size_t O_RW_V  = 176 * MB;
constexpr size_t O_RW_KK = 192 * MB;
constexpr size_t O_RW_KA = 208 * MB;
constexpr size_t O_DECAY = 224 * MB;
constexpr size_t O_H1B   = 144 * MB;
constexpr size_t O_EUB   = 176 * MB;
constexpr size_t O_EVB   = 208 * MB;
constexpr size_t O_PQ    = 104 * MB;
constexpr size_t WS_NEED = 256 * MB;

struct Params {
    const float *x, *mem; const int* pos;
    const float *norm_mix_g, *w_in, *shift_mu, *q_norm_g, *kv_norm_g, *w_uq, *w_ukv;
    const float *rw_w0, *rw_w_up, *rw_a0, *rw_a_up, *rw_g_up, *rw_k_k, *rw_k_a, *rw_r_k, *rw_lnx_w, *rw_lnx_b;
    const float *w_out, *norm_xa_g, *norm_mem_g, *xa_wq, *xa_wk, *xa_wv, *xa_wo;
    const float *norm_ffn_g, *peer_wq, *peer_keys, *expert_u, *expert_v, *final_norm_g;
    float* out; char* ws;
};

typedef __bf16 bf16x2_t __attribute__((ext_vector_type(2)));
typedef float f32x2_t __attribute__((ext_vector_type(2)));
DEV unsigned cvt_pk_bf16(float lo, float hi) { const f32x2_t f = {lo, hi}; const bf16x2_t b = __builtin_convertvector(f, bf16x2_t); unsigned r; __builtin_memcpy(&r, &b, 4); return r; }
DEV float bf_lo(unsigned u) { return __uint_as_float(u << 16); }
DEV float bf_hi(unsigned u) { return __uint_as_float(u & 0xffff0000u); }
DEV f32x4 mfma16(bf16x8 a, bf16x8 b, f32x4 c) { return __builtin_amdgcn_mfma_f32_16x16x32_bf16(a, b, c, 0, 0, 0); }
DEV float sigmoidf_(float v) { return 1.0f / (1.0f + __expf(-v)); }
DEV float wave_sum(float v) {
#pragma unroll
    for (int o = 32; o >= 1; o >>= 1) v += __shfl_xor(v, o);
    return v;
}
DEV float allreduce8(float x) {
    x += __int_as_float(__builtin_amdgcn_update_dpp(0, __float_as_int(x), 0xB1, 0xF, 0xF, true));
    x += __int_as_float(__builtin_amdgcn_update_dpp(0, __float_as_int(x), 0x4E, 0xF, 0xF, true));
    x += __int_as_float(__builtin_amdgcn_update_dpp(0, __float_as_int(x), 0x141, 0xF, 0xF, true));
    return x;
}
DEV bf16x8 as_bf16x8(u32x4 v) { bf16x8 r; __builtin_memcpy(&r, &v, 16); return r; }

template <bool SWAP, class AL, class EP>
DEV void gemm_tile(AL aload, const bf16_t* __restrict__ Bt, int ldb, int K, int row0, int col0, char* smem, EP epi) {
    int tid = threadIdx.x; asm volatile("" : "+v"(tid));
    const int wid = __builtin_amdgcn_readfirstlane(tid >> 6), lane = tid & 63, wr = wid >> 1, wc = wid & 1, fr = lane & 15, fq = lane >> 4;
    char* sA = smem; char* sB = smem + 16384;
    f32x4 acc[4][4];
#pragma unroll
    for (int m = 0; m < 4; ++m)
#pragma unroll
        for (int n = 0; n < 4; ++n) acc[m][n] = (f32x4){0.f, 0.f, 0.f, 0.f};
    const int c0 = tid, c1 = tid + 256;
    const int r0 = c0 >> 2, k0c = (c0 & 3) * 8, r1 = c1 >> 2, k1c = (c1 & 3) * 8;
    const bf16_t* bp0 = Bt + (size_t)(col0 + r0) * ldb + k0c;
    const bf16_t* bp1 = Bt + (size_t)(col0 + r1) * ldb + k1c;
    u32x4 ra0, ra1, rb0, rb1;
    ra0 = aload(row0 + r0, k0c); ra1 = aload(row0 + r1, k1c);
    rb0 = *(const u32x4*)(bp0); rb1 = *(const u32x4*)(bp1);
    *(u32x4*)(sA + c0 * 16) = ra0; *(u32x4*)(sA + c1 * 16) = ra1;
    *(u32x4*)(sB + c0 * 16) = rb0; *(u32x4*)(sB + c1 * 16) = rb1;
    __syncthreads();
    const int nt = K >> 5;
    for (int t = 0; t < nt; ++t) {
        const bool more = (t + 1 < nt);
        if (more) {
            const int kb = (t + 1) << 5;
            ra0 = aload(row0 + r0, kb + k0c); ra1 = aload(row0 + r1, kb + k1c);
            rb0 = *(const u32x4*)(bp0 + kb); rb1 = *(const u32x4*)(bp1 + kb);
        }
        const char* a = sA + (t & 1) * 8192; const char* b = sB + (t & 1) * 8192;
        bf16x8 af[4], bfr[4];
#pragma unroll
        for (int m = 0; m < 4; ++m) af[m] = *(const bf16x8*)(a + (wr * 64 + m * 16 + fr) * 64 + fq * 16);
#pragma unroll
        for (int n = 0; n < 4; ++n) bfr[n] = *(const bf16x8*)(b + (wc * 64 + n * 16 + fr) * 64 + fq * 16);
#pragma unroll
        for (int m = 0; m < 4; ++m)
#pragma unroll
            for (int n = 0; n < 4; ++n)
                acc[m][n] = SWAP ? mfma16(bfr[n], af[m], acc[m][n]) : mfma16(af[m], bfr[n], acc[m][n]);
        if (more) {
            const int o = ((t + 1) & 1) * 8192;
            *(u32x4*)(sA + o + c0 * 16) = ra0; *(u32x4*)(sA + o + c1 * 16) = ra1;
            *(u32x4*)(sB + o + c0 * 16) = rb0; *(u32x4*)(sB + o + c1 * 16) = rb1;
        }
        __syncthreads();
    }
    int rb_ = row0 + wr * 64, cb_ = col0 + wc * 64;
    asm volatile("" : "+s"(rb_), "+s"(cb_));
    epi(acc, rb_, cb_, fr, fq);
}

struct PlainA {
    const bf16_t* A; int lda;
    DEV u32x4 operator()(int row, int k) const { return *(const u32x4*)(A + (size_t)row * lda + k); }
};

DEV void tr_tile(const float* __restrict__ src, int ldn, bf16_t* __restrict__ dst, int ldk, int k0, int n0, int drow0,
                 const float* __restrict__ gain, float* tileS) {
    int tid = threadIdx.x; asm volatile("" : "+v"(tid));
    __syncthreads();
#pragma unroll 4
    for (int i = 0; i < 16; ++i) {
        const int kk = i * 4 + (tid >> 6), nn = tid & 63;
        float v = src[(size_t)(k0 + kk) * ldn + n0 + nn];
        if (gain) v *= gain[k0 + kk];
        tileS[kk * 65 + nn] = v;
    }
    __syncthreads();
#pragma unroll 4
    for (int i = 0; i < 16; ++i) {
        const int nn = i * 4 + (tid >> 6), kk = tid & 63;
        const float v = tileS[kk * 65 + nn];
        dst[(size_t)(drow0 + nn) * ldk + k0 + kk] = (bf16_t)(cvt_pk_bf16(v, 0.f) & 0xffffu);
    }
}

template <int DQK, int DV, bool PREF>
DEV void attn_item(const bf16_t* __restrict__ q, int ldq, const bf16_t* __restrict__ k, int ldk,
                   const bf16_t* __restrict__ vT, int ldv, int ntiles, bf16_t* __restrict__ out, int ldo, char* smem) {
    constexpr int KS = DQK / 32, DB = DV / 16;
    constexpr int KSTR = DQK * 2 + 16;
    constexpr int VSTR = 144;
    constexpr int KCH = 64 * DQK / 8 / 256, VCH = DV * 64 / 8 / 256, KCW = DQK / 8;
    char* sK = smem; char* sV = smem + 64 * KSTR;
    int tid = threadIdx.x; asm volatile("" : "+v"(tid));
    const int wid = __builtin_amdgcn_readfirstlane(tid >> 6), lane = tid & 63, fr = lane & 15, fq = lane >> 4;
    bf16x8 qf[KS];
    {
        const bf16_t* qrow = q + (size_t)(wid * 16 + fr) * ldq;
#pragma unroll
        for (int ks = 0; ks < KS; ++ks) qf[ks] = *(const bf16x8*)(qrow + ks * 32 + fq * 8);
    }
    f32x4 o[DB];
#pragma unroll
    for (int db = 0; db < DB; ++db) o[db] = (f32x4){0.f, 0.f, 0.f, 0.f};
    float mrow = -1e30f, lsum = 0.f;
    u32x4 kr[PREF ? KCH : 1], vr[PREF ? VCH : 1];
    if (PREF) {
#pragma unroll
        for (int i = 0; i < KCH; ++i) { const int c = tid + i * 256, key = c / KCW, cc = c % KCW; kr[PREF ? i : 0] = *(const u32x4*)(k + (size_t)key * ldk + cc * 8); }
#pragma unroll
        for (int i = 0; i < VCH; ++i) { const int c = tid + i * 256, d = c >> 3, cc = c & 7; vr[PREF ? i : 0] = *(const u32x4*)(vT + (size_t)d * ldv + cc * 8); }
    }
    for (int kt = 0; kt < ntiles; ++kt) {
        __syncthreads();
        if (PREF) {
#pragma unroll
            for (int i = 0; i < KCH; ++i) { const int c = tid + i * 256, key = c / KCW, cc = c % KCW; *(u32x4*)(sK + key * KSTR + cc * 16) = kr[PREF ? i : 0]; }
#pragma unroll
            for (int i = 0; i < VCH; ++i) { const int c = tid + i * 256, d = c >> 3, cc = c & 7; *(u32x4*)(sV + d * VSTR + cc * 16) = vr[PREF ? i : 0]; }
        } else {
            const int kn = kt * 64;
#pragma unroll 4
            for (int i = 0; i < KCH; ++i) { const int c = tid + i * 256, key = c / KCW, cc = c % KCW; *(u32x4*)(sK + key * KSTR + cc * 16) = *(const u32x4*)(k + (size_t)(kn + key) * ldk + cc * 8); }
#pragma unroll 4
            for (int i = 0; i < VCH; ++i) { const int c = tid + i * 256, d = c >> 3, cc = c & 7; *(u32x4*)(sV + d * VSTR + cc * 16) = *(const u32x4*)(vT + (size_t)d * ldv + kn + cc * 8); }
        }
        __syncthreads();
        if (PREF && kt + 1 < ntiles) {
            const int kn = (kt + 1) * 64;
#pragma unroll
            for (int i = 0; i < KCH; ++i) { const int c = tid + i * 256, key = c / KCW, cc = c % KCW; kr[PREF ? i : 0] = *(const u32x4*)(k + (size_t)(kn + key) * ldk + cc * 8); }
#pragma unroll
            for (int i = 0; i < VCH; ++i) { const int c = tid + i * 256, d = c >> 3, cc = c & 7; vr[PREF ? i : 0] = *(const u32x4*)(vT + (size_t)d * ldv + kn + cc * 8); }
        }
        f32x4 s[4];
#pragma unroll
        for (int kb = 0; kb < 4; ++kb) {
            s[kb] = (f32x4){0.f, 0.f, 0.f, 0.f};
#pragma unroll
            for (int ks = 0; ks < KS; ++ks) {
                const bf16x8 kf = *(const bf16x8*)(sK + (kb * 16 + fr) * KSTR + ks * 64 + fq * 16);
                s[kb] = mfma16(kf, qf[ks], s[kb]);
            }
        }
        float mx = -1e30f;
#pragma unroll
        for (int kb = 0; kb < 4; ++kb)
#pragma unroll
            for (int j = 0; j < 4; ++j) mx = fmaxf(mx, s[kb][j]);
        mx = fmaxf(mx, __shfl_xor(mx, 16)); mx = fmaxf(mx, __shfl_xor(mx, 32));
        const float mnew = fmaxf(mrow, mx);
        const float alpha = __builtin_amdgcn_exp2f(mrow - mnew);
        mrow = mnew;
        float ps = 0.f;
#pragma unroll
        for (int kb = 0; kb < 4; ++kb)
#pragma unroll
            for (int j = 0; j < 4; ++j) { const float e = __builtin_amdgcn_exp2f(s[kb][j] - mnew); s[kb][j] = e; ps += e; }
        lsum = lsum * alpha + ps;
#pragma unroll
        for (int db = 0; db < DB; ++db) o[db] *= alpha;
        bf16x8 pf[2];
#pragma unroll
        for (int g = 0; g < 2; ++g) {
            u32x4 w;
            w.x = cvt_pk_bf16(s[2 * g][0], s[2 * g][1]); w.y = cvt_pk_bf16(s[2 * g][2], s[2 * g][3]);
            w.z = cvt_pk_bf16(s[2 * g + 1][0], s[2 * g + 1][1]); w.w = cvt_pk_bf16(s[2 * g + 1][2], s[2 * g + 1][3]);
            pf[g] = as_bf16x8(w);
        }
#pragma unroll
        for (int db = 0; db < DB; ++db) {
#pragma unroll
            for (int g = 0; g < 2; ++g) {
                const u32x2 v0 = *(const u32x2*)(sV + (db * 16 + fr) * VSTR + ((2 * g) * 16 + fq * 4) * 2);
                const u32x2 v1 = *(const u32x2*)(sV + (db * 16 + fr) * VSTR + ((2 * g + 1) * 16 + fq * 4) * 2);
                u32x4 w; w.x = v0.x; w.y = v0.y; w.z = v1.x; w.w = v1.y;
                o[db] = mfma16(as_bf16x8(w), pf[g], o[db]);
            }
        }
    }
    lsum += __shfl_xor(lsum, 16); lsum += __shfl_xor(lsum, 32);
    const float inv = 1.0f / lsum;
    bf16_t* orow = out + (size_t)(wid * 16 + fr) * ldo + fq * 4;
#pragma unroll
    for (int db = 0; db < DB; ++db) {
        u32x2 w; w.x = cvt_pk_bf16(o[db][0] * inv, o[db][1] * inv); w.y = cvt_pk_bf16(o[db][2] * inv, o[db][3] * inv);
        *(u32x2*)(orow + db * 16) = w;
    }
}

DEV unsigned ordkey(float f) { const unsigned u = __float_as_uint(f); return (u & 0x80000000u) ? ~u : (u | 0x80000000u); }
DEV float unordkey(unsigned k) { const unsigned u = (k & 0x80000000u) ? (k & 0x7fffffffu) : ~k; return __uint_as_float(u); }
#define TOPK_INSERT(L, xk) { unsigned x_ = (xk); _Pragma("unroll") for (int s_ = 0; s_ < 16; ++s_) { const unsigned hi_ = max(L[s_], x_); x_ = min(L[s_], x_); L[s_] = hi_; } }
DEV unsigned byte_lookup(unsigned p0, unsigned p1, unsigned p2, unsigned p3, int a) {
    const unsigned w = (a < 8) ? ((a < 4) ? p0 : p1) : ((a < 12) ? p2 : p3);
    return (w >> ((a & 3) * 8)) & 0xffu;
}

DEV void grid_barrier(unsigned* bar, unsigned nblocks, unsigned& gen) {
    __threadfence();
    __syncthreads();
    gen += 1;
    if (threadIdx.x == 0) {
        const unsigned target = gen * nblocks;
        __hip_atomic_fetch_add(bar, 1u, __ATOMIC_RELEASE, __HIP_MEMORY_SCOPE_AGENT);
        while (__hip_atomic_load(bar, __ATOMIC_ACQUIRE, __HIP_MEMORY_SCOPE_AGENT) < target) __builtin_amdgcn_s_sleep(2);
    }
    __syncthreads();
    __threadfence();
}
#define GRID_SYNC() grid.sync()
#ifndef PH
#define PH 0x0FFF
#endif
constexpr int SMEM_BYTES = 64 * 528 + 256 * 144;

__global__ void __launch_bounds__(256, 2) fwd_megakernel(Params P) {
    cg::grid_group grid = cg::this_grid();
    __shared__ __attribute__((aligned(16))) char smem[SMEM_BYTES];
    __shared__ int s_item;
    const int nb = gridDim.x, bid = blockIdx.x;
    const int gsz = nb * 256;
#define PHASE_IDS int tid = threadIdx.x; asm volatile("" : "+v"(tid)); const int wid = __builtin_amdgcn_readfirstlane(tid >> 6), lane = tid & 63; const int gtid = bid * 256 + tid; (void)wid; (void)lane; (void)gtid;
    char* ws = P.ws;
    float* ssq0 = (float*)(ws + O_SSQ);
    float* ssqm = (float*)(ws + O_SSQ + 65536);
    float* ssqq = (float*)(ws + O_SSQ + 2 * 65536);
    float* ssqkv = (float*)(ws + O_SSQ + 3 * 65536);
    float* ssq1 = (float*)(ws + O_SSQ + 4 * 65536);
    float* ssq2 = (float*)(ws + O_SSQ + 5 * 65536);
    int* counters = (int*)(ws + O_CNT);
    float2* ropetab = (float2*)(ws + O_ROPE);
    bf16_t* p = (bf16_t*)(ws + O_P);
    bf16_t* qmla = (bf16_t*)P.out;
    bf16_t* kfull = (bf16_t*)((char*)P.out + 24 * MB);
    bf16_t* vTm = (bf16_t*)((char*)P.out + 48 * MB);

    if (PH & (1 << 0)) {
        PHASE_IDS
        float* tileS = (float*)smem;
        for (int tile = bid; tile < 2464; tile += nb) {
            const float* src; int ldn; bf16_t* dst; int ldk; int KT; int loc; const float* gain = nullptr; int drow_add = 0;
            bool ukv = false;
            if (tile < 560) { loc = tile; src = P.w_in; ldn = 2240; dst = (bf16_t*)(ws + O_WINT); ldk = 1024; KT = 16; gain = P.norm_mix_g; }
            else if (tile < 608) { loc = tile - 560; src = P.w_uq; ldn = 768; dst = (bf16_t*)(ws + O_WUQT); ldk = 256; KT = 4; gain = P.q_norm_g; }
            else if (tile < 640) { loc = tile - 608; src = P.w_ukv; ldn = 1024; dst = (bf16_t*)(ws + O_WUKT); ldk = 128; KT = 2; gain = P.kv_norm_g; ukv = true; }
            else if (tile < 648) { loc = tile - 640; src = P.rw_w_up; ldn = 512; dst = (bf16_t*)(ws + O_WUPT); ldk = 64; KT = 1; }
            else if (tile < 656) { loc = tile - 648; src = P.rw_a_up; ldn = 512; dst = (bf16_t*)(ws + O_AUPT); ldk = 64; KT = 1; }
            else if (tile < 672) { loc = tile - 656; src = P.rw_g_up; ldn = 512; dst = (bf16_t*)(ws + O_GUPT); ldk = 128; KT = 2; }
            else if (tile < 928) { loc = tile - 672; src = P.w_out; ldn = 1024; dst = (bf16_t*)(ws + O_WOUTT); ldk = 1024; KT = 16; }
            else if (tile < 1184) { loc = tile - 928; src = P.xa_wq; ldn = 1024; dst = (bf16_t*)(ws + O_XAQT); ldk = 1024; KT = 16; gain = P.norm_xa_g; }
            else if (tile < 1440) { loc = tile - 1184; src = P.xa_wk; ldn = 1024; dst = (bf16_t*)(ws + O_XAKVT); ldk = 1024; KT = 16; gain = P.norm_mem_g; }
            else if (tile < 1696) { loc = tile - 1440; src = P.xa_wv; ldn = 1024; dst = (bf16_t*)(ws + O_XAKVT); ldk = 1024; KT = 16; gain = P.norm_mem_g; drow_add = 1024; }
            else if (tile < 1952) { loc = tile - 1696; src = P.xa_wo; ldn = 1024; dst = (bf16_t*)(ws + O_XAOT); ldk = 1024; KT = 16; }
            else { loc = tile - 1952; src = P.peer_wq; ldn = 2048; dst = (bf16_t*)(ws + O_PWQT); ldk = 1024; KT = 16; gain = P.norm_ffn_g; }
            const int kt = loc % KT, ntile = loc / KT;
            int n0 = ntile * 64, drow0 = n0 + drow_add;
            if (ukv) {
                const int h = n0 >> 8, part = (n0 >> 7) & 1, d0 = n0 & 127;
                if (part) dst = (bf16_t*)(ws + O_WUVT);
                drow0 = h * 128 + d0;
            }
            tr_tile(src, ldn, dst, ldk, kt * 64, n0, drow0, gain, tileS);
        }
        bf16_t* xb = (bf16_t*)(ws + O_XB);
        bf16_t* memb = (bf16_t*)(ws + O_MEMB);
        for (int r = bid * 4 + wid; r < T + 2048; r += nb * 4) {
            const float* srow = (r < T) ? (P.x + (size_t)r * 1024) : (P.mem + (size_t)(r - T) * 1024);
            bf16_t* drow = (r < T) ? (xb + (size_t)r * 1024) : (memb + (size_t)(r - T) * 1024);
            float ss = 0.f;
#pragma unroll
            for (int i = 0; i < 4; ++i) {
                const f32x4 v = *(const f32x4*)(srow + i * 256 + lane * 4);
                ss += v[0] * v[0] + v[1] * v[1] + v[2] * v[2] + v[3] * v[3];
                u32x2 w; w.x = cvt_pk_bf16(v[0], v[1]); w.y = cvt_pk_bf16(v[2], v[3]);
                *(u32x2*)(drow + i * 256 + lane * 4) = w;
            }
            ss = wave_sum(ss);
            if (lane == 0) { if (r < T) ssq0[r] = ss; else ssqm[r - T] = ss; }
        }
        for (int i = gtid; i < T * 32; i += gsz) {
            const int row = i >> 5, f = i & 31;
            const float inv = exp2f(-(float)f * (13.287712379549449f / 32.0f));
            const float ang = (float)P.pos[row] * inv;
            ropetab[i] = make_float2(cosf(ang), sinf(ang));
        }
        for (int i = gtid; i < T; i += gsz) { ssqq[i] = 0.f; ssqkv[i] = 0.f; ssq1[i] = 0.f; ssq2[i] = 0.f; }
        if (gtid < 64) counters[gtid] = 0;
        {
            bf16_t* keysb = (bf16_t*)(ws + O_KEYS);
            for (int i = gtid; i < 16 * 128 * 128 / 4; i += gsz) {
                const f32x4 v = *(const f32x4*)(P.peer_keys + (size_t)i * 4);
                u32x2 w; w.x = cvt_pk_bf16(v[0], v[1]); w.y = cvt_pk_bf16(v[2], v[3]);
                *(u32x2*)(keysb + (size_t)i * 4) = w;
            }
        }
        {
            u32x4* z = (u32x4*)(ws + O_WINT + (size_t)2240 * 1024 * 2);
            for (int i = gtid; i < 64 * 1024 * 2 / 16; i += gsz) z[i] = (u32x4){0u, 0u, 0u, 0u};
        }
    }
    GRID_SYNC();

    if (PH & (1 << 1)) {
        PHASE_IDS
        const bf16_t* xb = (const bf16_t*)(ws + O_XB);
        const bf16_t* memb = (const bf16_t*)(ws + O_MEMB);
        const bf16_t* winT = (const bf16_t*)(ws + O_WINT);
        const bf16_t* xakvT = (const bf16_t*)(ws + O_XAKVT);
        bf16_t* km = (bf16_t*)(ws + O_KM);
        bf16_t* vmT = (bf16_t*)(ws + O_VMT);
        const int NP = 128 * 18, NKV = 16 * 16;
        for (int item = bid; item < NP + NKV; item += nb) {
            if (item < NP) {
                const int tm = item / 18, tn = item % 18;
                gemm_tile<true>(PlainA{xb, 1024}, winT, 1024, 1024, tm * 128, tn * 128, smem,
                    [&](const f32x4 (&acc)[4][4], int rbase, int cbase, int fr, int fq) {
#pragma unroll
                        for (int m = 0; m < 4; ++m) {
                            const int row = rbase + m * 16 + fr;
                            const float rs = rsqrtf(ssq0[row] * (1.0f / 1024.0f) + EPS);
                            float ss = 0.f;
#pragma unroll
                            for (int n = 0; n < 4; ++n) {
                                const f32x4 v = acc[m][n] * rs;
                                ss += v[0] * v[0] + v[1] * v[1] + v[2] * v[2] + v[3] * v[3];
                                u32x2 w; w.x = cvt_pk_bf16(v[0], v[1]); w.y = cvt_pk_bf16(v[2], v[3]);
                                *(u32x2*)(p + (size_t)row * 2304 + cbase + n * 16 + fq * 4) = w;
                            }
                            if (cbase < 384) {
                                ss += __shfl_xor(ss, 16); ss += __shfl_xor(ss, 32);
                                if (fq == 0) atomicAdd((cbase < 256) ? &ssqq[row] : &ssqkv[row], ss);
                            }
                        }
                    });
            } else {
                const int it = item - NP, tm = it >> 4, tn = it & 15;
                if (tn < 8) {
                    gemm_tile<true>(PlainA{memb, 1024}, xakvT, 1024, 1024, tm * 128, tn * 128, smem,
                        [&](const f32x4 (&acc)[4][4], int rbase, int cbase, int fr, int fq) {
#pragma unroll
                            for (int m = 0; m < 4; ++m) {
                                const int row = rbase + m * 16 + fr;
                                const float rs = rsqrtf(ssqm[row] * (1.0f / 1024.0f) + EPS);
#pragma unroll
                                for (int n = 0; n < 4; ++n) {
                                    const f32x4 v = acc[m][n] * rs;
                                    u32x2 w; w.x = cvt_pk_bf16(v[0], v[1]); w.y = cvt_pk_bf16(v[2], v[3]);
                                    *(u32x2*)(km + (size_t)row * 1024 + cbase + n * 16 + fq * 4) = w;
                                }
                            }
                        });
                } else {
                    gemm_tile<false>(PlainA{memb, 1024}, xakvT, 1024, 1024, tm * 128, tn * 128, smem,
                        [&](const f32x4 (&acc)[4][4], int rbase, int cbase, int fr, int fq) {
#pragma unroll
                            for (int m = 0; m < 4; ++m) {
                                const int row = rbase + m * 16 + fq * 4;
                                const f32x4 sq = *(const f32x4*)(ssqm + row);
                                f32x4 rs;
#pragma unroll
                                for (int j = 0; j < 4; ++j) rs[j] = rsqrtf(sq[j] * (1.0f / 1024.0f) + EPS);
                                const int b = row >> 8, mi = row & 255;
#pragma unroll
                                for (int n = 0; n < 4; ++n) {
                                    const int col = cbase + n * 16 + fr - 1024;
                                    const f32x4 v = acc[m][n] * rs;
                                    u32x2 w; w.x = cvt_pk_bf16(v[0], v[1]); w.y = cvt_pk_bf16(v[2], v[3]);
                                    *(u32x2*)(vmT + ((size_t)(b * 1024 + col)) * 256 + mi) = w;
                                }
                            }
                        });
                }
            }
        }
    }
    GRID_SYNC();

    if (PH & (1 << 2)) {
        PHASE_IDS
        const bf16_t* wuqT = (const bf16_t*)(ws + O_WUQT);
        const bf16_t* wukT = (const bf16_t*)(ws + O_WUKT);
        const bf16_t* wuvT = (const bf16_t*)(ws + O_WUVT);
        const bf16_t* wupT = (const bf16_t*)(ws + O_WUPT);
        const bf16_t* aupT = (const bf16_t*)(ws + O_AUPT);
        const bf16_t* gupT = (const bf16_t*)(ws + O_GUPT);
        bf16_t* gbuf = (bf16_t*)(ws + O_G);
        bf16_t* rwr = (bf16_t*)(ws + O_RW_R);
        bf16_t* rwk = (bf16_t*)(ws + O_RW_K);
        bf16_t* rwv = (bf16_t*)(ws + O_RW_V);
        bf16_t* rwkk = (bf16_t*)(ws + O_RW_KK);
        bf16_t* rwka = (bf16_t*)(ws + O_RW_KA);
        float* decay = (float*)(ws + O_DECAY);
        const float QSCALE = 0.07216878364870322f * 1.4426950408889634f;
        const int N0 = 128 * 6, N1 = N0 + 512, N2 = N1 + 512, N3 = N2 + 512, N4 = N3 + 512, N5 = N4 + 512;
        auto shifted8 = [&](int row, int pc, int j0, float (&o)[8]) {
            const u32x4 cur = *(const u32x4*)(p + (size_t)row * 2304 + pc);
            u32x4 prv = (u32x4){0u, 0u, 0u, 0u};
            if (row & 2047) prv = *(const u32x4*)(p + (size_t)(row - 1) * 2304 + pc);
            const f32x4 m0 = *(const f32x4*)(P.shift_mu + j0), m1 = *(const f32x4*)(P.shift_mu + j0 + 4);
            const unsigned cu[4] = {cur.x, cur.y, cur.z, cur.w}, pu[4] = {prv.x, prv.y, prv.z, prv.w};
#pragma unroll
            for (int i = 0; i < 4; ++i) {
                const float c0 = bf_lo(cu[i]), c1 = bf_hi(cu[i]), p0 = bf_lo(pu[i]), p1 = bf_hi(pu[i]);
                const float mu0 = (i < 2) ? m0[2 * i] : m1[2 * i - 4], mu1 = (i < 2) ? m0[2 * i + 1] : m1[2 * i - 3];
                o[2 * i] = c0 + (p0 - c0) * mu0; o[2 * i + 1] = c1 + (p1 - c1) * mu1;
            }
        };
        auto shifted4 = [&](int row, int pc, int j0, f32x4& o) {
            const u32x2 cur = *(const u32x2*)(p + (size_t)row * 2304 + pc);
            u32x2 prv = (u32x2){0u, 0u};
            if (row & 2047) prv = *(const u32x2*)(p + (size_t)(row - 1) * 2304 + pc);
            const f32x4 mu = *(const f32x4*)(P.shift_mu + j0);
            const float c0 = bf_lo(cur.x), c1 = bf_hi(cur.x), c2 = bf_lo(cur.y), c3 = bf_hi(cur.y);
            const float p0 = bf_lo(prv.x), p1 = bf_hi(prv.x), p2 = bf_lo(prv.y), p3 = bf_hi(prv.y);
            o[0] = c0 + (p0 - c0) * mu[0]; o[1] = c1 + (p1 - c1) * mu[1]; o[2] = c2 + (p2 - c2) * mu[2]; o[3] = c3 + (p3 - c3) * mu[3];
        };
        for (int item = bid; item < N5; item += nb) {
            if (item < N0) {
                const int tm = item / 6, tn = item % 6;
                gemm_tile<true>(PlainA{p, 2304}, wuqT, 256, 256, tm * 128, tn * 128, smem,
                    [&](const f32x4 (&acc)[4][4], int rbase, int cbase, int fr, int fq) {
                        const bool rope = (cbase % 192) == 128;
#pragma unroll
                        for (int m = 0; m < 4; ++m) {
                            const int row = rbase + m * 16 + fr;
                            const float rs = rsqrtf(ssqq[row] * (1.0f / 256.0f) + EPS) * QSCALE;
                            f32x4 v[4];
#pragma unroll
                            for (int n = 0; n < 4; ++n) v[n] = acc[m][n] * rs;
                            if (rope) {
#pragma unroll
                                for (int n = 0; n < 2; ++n)
#pragma unroll
                                    for (int j = 0; j < 4; ++j) {
                                        const float2 cs = ropetab[row * 32 + n * 16 + fq * 4 + j];
                                        const float t1 = v[n][j], t2 = v[n + 2][j];
                                        v[n][j] = t1 * cs.x - t2 * cs.y; v[n + 2][j] = t1 * cs.y + t2 * cs.x;
                                    }
                            }
#pragma unroll
                            for (int n = 0; n < 4; ++n) {
                                u32x2 w; w.x = cvt_pk_bf16(v[n][0], v[n][1]); w.y = cvt_pk_bf16(v[n][2], v[n][3]);
                                *(u32x2*)(qmla + (size_t)row * 768 + cbase + n * 16 + fq * 4) = w;
                            }
                        }
                    });
            } else if (item < N1) {
                const int it = item - N0, tm = it >> 2, tn = it & 3;
                gemm_tile<true>(PlainA{p + 256, 2304}, wukT, 128, 128, tm * 128, tn * 128, smem,
                    [&](const f32x4 (&acc)[4][4], int rbase, int cbase, int fr, int fq) {
#pragma unroll
                        for (int m = 0; m < 4; ++m) {
                            const int row = rbase + m * 16 + fr;
                            const float rs = rsqrtf(ssqkv[row] * (1.0f / 128.0f) + EPS);
#pragma unroll
                            for (int n = 0; n < 4; ++n) {
                                const int col = cbase + n * 16 + fq * 4, h = col >> 7, d = col & 127;
                                const f32x4 v = acc[m][n] * rs;
                                u32x2 w; w.x = cvt_pk_bf16(v[0], v[1]); w.y = cvt_pk_bf16(v[2], v[3]);
                                *(u32x2*)(kfull + (size_t)row * 768 + h * 192 + d) = w;
                            }
                        }
                    });
            } else if (item < N2) {
                const int it = item - N1, tm = it >> 2, tn = it & 3;
                gemm_tile<false>(PlainA{p + 256, 2304}, wuvT, 128, 128, tm * 128, tn * 128, smem,
                    [&](const f32x4 (&acc)[4][4], int rbase, int cbase, int fr, int fq) {
#pragma unroll
                        for (int m = 0; m < 4; ++m) {
                            const int row = rbase + m * 16 + fq * 4;
                            const f32x4 sq = *(const f32x4*)(ssqkv + row);
                            f32x4 rs;
#pragma unroll
                            for (int j = 0; j < 4; ++j) rs[j] = rsqrtf(sq[j] * (1.0f / 128.0f) + EPS);
                            const int b = row >> 11, s = row & 2047;
#pragma unroll
                            for (int n = 0; n < 4; ++n) {
                                const int col = cbase + n * 16 + fr;
                                const f32x4 v = acc[m][n] * rs;
                                u32x2 w; w.x = cvt_pk_bf16(v[0], v[1]); w.y = cvt_pk_bf16(v[2], v[3]);
                                *(u32x2*)(vTm + ((size_t)(b * 512 + col)) * 2048 + s) = w;
                            }
                        }
                    });
            } else if (item < N3) {
                const int it = item - N2, tm = it >> 2, tn = it & 3;
                auto al = [&](int row, int k) -> u32x4 {
                    float o[8]; shifted8(row, 1984 + k, 1536 + k, o);
                    u32x4 w;
                    w.x = cvt_pk_bf16(tanhf(o[0]), tanhf(o[1])); w.y = cvt_pk_bf16(tanhf(o[2]), tanhf(o[3]));
                    w.z = cvt_pk_bf16(tanhf(o[4]), tanhf(o[5])); w.w = cvt_pk_bf16(tanhf(o[6]), tanhf(o[7]));
                    return w;
                };
                gemm_tile<true>(al, wupT, 64, 64, tm * 128, tn * 128, smem,
                    [&](const f32x4 (&acc)[4][4], int rbase, int cbase, int fr, int fq) {
#pragma unroll
                        for (int m = 0; m < 4; ++m) {
                            const int row = rbase + m * 16 + fr;
#pragma unroll
                            for (int n = 0; n < 4; ++n) {
                                const int col = cbase + n * 16 + fq * 4;
                                const f32x4 w0 = *(const f32x4*)(P.rw_w0 + col);
                                f32x4 dv;
#pragma unroll
                                for (int j = 0; j < 4; ++j) {
                                    const float wp = w0[j] + acc[m][n][j];
                                    const float z = -wp;
                                    const float sp = fmaxf(z, 0.f) + log1pf(__expf(-fabsf(z)));
                                    dv[j] = __expf(-__expf(-sp - 0.5f));
                                }
                                *(f32x4*)(decay + (size_t)row * 512 + col) = dv;
                            }
                        }
                    });
            } else if (item < N4) {
                const int it = item - N3, tm = it >> 2, tn = it & 3;
                auto al = [&](int row, int k) -> u32x4 {
                    float o[8]; shifted8(row, 2048 + k, 1600 + k, o);
                    u32x4 w;
                    w.x = cvt_pk_bf16(o[0], o[1]); w.y = cvt_pk_bf16(o[2], o[3]); w.z = cvt_pk_bf16(o[4], o[5]); w.w = cvt_pk_bf16(o[6], o[7]);
                    return w;
                };
                gemm_tile<true>(al, aupT, 64, 64, tm * 128, tn * 128, smem,
                    [&](const f32x4 (&acc)[4][4], int rbase, int cbase, int fr, int fq) {
#pragma unroll
                        for (int m = 0; m < 4; ++m) {
                            const int row = rbase + m * 16 + fr;
                            f32x4 kv[4], kkr[4], av[4];
                            float ss = 0.f;
#pragma unroll
                            for (int n = 0; n < 4; ++n) {
                                const int col = cbase + n * 16 + fq * 4;
                                shifted4(row, 960 + col, 512 + col, kv[n]);
                                const f32x4 kkw = *(const f32x4*)(P.rw_k_k + col);
                                const f32x4 a0 = *(const f32x4*)(P.rw_a0 + col);
#pragma unroll
                                for (int j = 0; j < 4; ++j) {
                                    kkr[n][j] = kv[n][j] * kkw[j]; ss += kkr[n][j] * kkr[n][j];
                                    av[n][j] = sigmoidf_(a0[j] + acc[m][n][j]);
                                }
                            }
                            ss += __shfl_xor(ss, 16); ss += __shfl_xor(ss, 32);
                            const float inv = 1.0f / fmaxf(sqrtf(ss), 1e-12f);
#pragma unroll
                            for (int n = 0; n < 4; ++n) {
                                const int col = cbase + n * 16 + fq * 4;
                                const f32x4 ka = *(const f32x4*)(P.rw_k_a + col);
                                f32x4 rv, vv, kk, k2, kka;
                                shifted4(row, 448 + col, col, rv);
                                shifted4(row, 1472 + col, 1024 + col, vv);
#pragma unroll
                                for (int j = 0; j < 4; ++j) {
                                    kk[j] = kkr[n][j] * inv;
                                    k2[j] = kv[n][j] * (1.0f + (av[n][j] - 1.0f) * ka[j]);
                                    kka[j] = kk[j] * av[n][j];
                                }
                                const size_t o = (size_t)row * 512 + col;
                                u32x2 w;
                                w.x = cvt_pk_bf16(rv[0], rv[1]); w.y = cvt_pk_bf16(rv[2], rv[3]); *(u32x2*)(rwr + o) = w;
                                w.x = cvt_pk_bf16(k2[0], k2[1]); w.y = cvt_pk_bf16(k2[2], k2[3]); *(u32x2*)(rwk + o) = w;
                                w.x = cvt_pk_bf16(vv[0], vv[1]); w.y = cvt_pk_bf16(vv[2], vv[3]); *(u32x2*)(rwv + o) = w;
                                w.x = cvt_pk_bf16(kk[0], kk[1]); w.y = cvt_pk_bf16(kk[2], kk[3]); *(u32x2*)(rwkk + o) = w;
                                w.x = cvt_pk_bf16(kka[0], kka[1]); w.y = cvt_pk_bf16(kka[2], kka[3]); *(u32x2*)(rwka + o) = w;
                            }
                        }
                    });
            } else {
                const int it = item - N4, tm = it >> 2, tn = it & 3;
                auto al = [&](int row, int k) -> u32x4 {
                    float o[8]; shifted8(row, 2112 + k, 1664 + k, o);
                    u32x4 w;
                    w.x = cvt_pk_bf16(sigmoidf_(o[0]), sigmoidf_(o[1])); w.y = cvt_pk_bf16(sigmoidf_(o[2]), sigmoidf_(o[3]));
                    w.z = cvt_pk_bf16(sigmoidf_(o[4]), sigmoidf_(o[5])); w.w = cvt_pk_bf16(sigmoidf_(o[6]), sigmoidf_(o[7]));
                    return w;
                };
                gemm_tile<true>(al, gupT, 128, 128, tm * 128, tn * 128, smem,
                    [&](const f32x4 (&acc)[4][4], int rbase, int cbase, int fr, int fq) {
#pragma unroll
                        for (int m = 0; m < 4; ++m) {
                            const int row = rbase + m * 16 + fr;
#pragma unroll
                            for (int n = 0; n < 4; ++n) {
                                const f32x4 v = acc[m][n];
                                u32x2 w; w.x = cvt_pk_bf16(v[0], v[1]); w.y = cvt_pk_bf16(v[2], v[3]);
                                *(u32x2*)(gbuf + (size_t)row * 512 + cbase + n * 16 + fq * 4) = w;
                            }
                        }
                    });
            }
        }
        for (int i = gtid; i < T * 32; i += gsz) {
            const int row = i >> 5, f = i & 31;
            const float t1 = __uint_as_float((unsigned)p[(size_t)row * 2304 + 384 + f] << 16);
            const float t2 = __uint_as_float((unsigned)p[(size_t)row * 2304 + 416 + f] << 16);
            const float2 cs = ropetab[i];
            const bf16_t o1 = (bf16_t)(cvt_pk_bf16(t1 * cs.x - t2 * cs.y, 0.f) & 0xffffu);
            const bf16_t o2 = (bf16_t)(cvt_pk_bf16(t1 * cs.y + t2 * cs.x, 0.f) & 0xffffu);
#pragma unroll
            for (int h = 0; h < 4; ++h) { kfull[(size_t)row * 768 + h * 192 + 128 + f] = o1; kfull[(size_t)row * 768 + h * 192 + 160 + f] = o2; }
        }
    }
    GRID_SYNC();

    if (PH & (1 << 3)) {
        PHASE_IDS
        const bf16_t* rwr = (const bf16_t*)(ws + O_RW_R);
        const bf16_t* rwk = (const bf16_t*)(ws + O_RW_K);
        const bf16_t* rwv = (const bf16_t*)(ws + O_RW_V);
        const bf16_t* rwkk = (const bf16_t*)(ws + O_RW_KK);
        const bf16_t* rwka = (const bf16_t*)(ws + O_RW_KA);
        const float* decay = (const float*)(ws + O_DECAY);
        float* yraw = (float*)(ws + O_YRAW);
        bf16_t* mix = (bf16_t*)(ws + O_MIX);
        for (;;) {
            __syncthreads();
            if (tid == 0) s_item = atomicAdd(&counters[0], 1);
            __syncthreads();
            const int item = s_item;
            if (item >= 128 + 1024) break;
            if (item < 128) {
                const int b = item >> 4, h = (item >> 1) & 7, half = item & 1;
                float* opnd = (float*)smem;
                float* vbuf = (float*)(smem + 40960);
                float* ybuf = (float*)(smem + 40960 + 4096);
                const int seg = lane & 7, rl = wid * 8 + (lane >> 3);
                const int lstep = tid >> 4, lc4 = (tid & 15) * 4;
                const int vstep = (tid & 127) >> 3, vc4 = (tid & 7) * 4;
                const size_t gbase = ((size_t)b * 2048) * 512 + h * 64;
                u32x2 pr_kk, pr_k, pr_r, pr_ka, pr_v; f32x4 pr_w;
                auto prefetch = [&](int ch) {
                    const size_t o = gbase + (size_t)(ch * 16 + lstep) * 512 + lc4;
                    pr_kk = *(const u32x2*)(rwkk + o); pr_k = *(const u32x2*)(rwk + o); pr_r = *(const u32x2*)(rwr + o); pr_ka = *(const u32x2*)(rwka + o);
                    pr_w = *(const f32x4*)(decay + o);
                    if (tid < 128) pr_v = *(const u32x2*)(rwv + gbase + (size_t)(ch * 16 + vstep) * 512 + half * 32 + vc4);
                };
                auto commit = [&](int buf) {
                    float* ob = opnd + buf * 5120 + lstep * 64 + lc4;
                    *(f32x4*)(ob + 0 * 1024) = (f32x4){bf_lo(pr_kk.x), bf_hi(pr_kk.x), bf_lo(pr_kk.y), bf_hi(pr_kk.y)};
                    *(f32x4*)(ob + 1 * 1024) = pr_w;
                    *(f32x4*)(ob + 2 * 1024) = (f32x4){bf_lo(pr_k.x), bf_hi(pr_k.x), bf_lo(pr_k.y), bf_hi(pr_k.y)};
                    *(f32x4*)(ob + 3 * 1024) = (f32x4){bf_lo(pr_r.x), bf_hi(pr_r.x), bf_lo(pr_r.y), bf_hi(pr_r.y)};
                    *(f32x4*)(ob + 4 * 1024) = (f32x4){bf_lo(pr_ka.x), bf_hi(pr_ka.x), bf_lo(pr_ka.y), bf_hi(pr_ka.y)};
                    if (tid < 128) *(f32x4*)(vbuf + buf * 512 + vstep * 32 + vc4) = (f32x4){bf_lo(pr_v.x), bf_hi(pr_v.x), bf_lo(pr_v.y), bf_hi(pr_v.y)};
                };
                float S[8];
#pragma unroll
                for (int c = 0; c < 8; ++c) S[c] = 0.f;
                prefetch(0); commit(0);
                __syncthreads();
                for (int ch = 0; ch < 128; ++ch) {
                    if (ch + 1 < 128) prefetch(ch + 1);
                    const float* ob = opnd + (ch & 1) * 5120 + seg * 8;
                    const float* vb = vbuf + (ch & 1) * 512 + rl;
#pragma unroll 4
                    for (int s = 0; s < 16; ++s) {
                        const f32x4 kk0 = *(const f32x4*)(ob + 0 * 1024 + s * 64), kk1 = *(const f32x4*)(ob + 0 * 1024 + s * 64 + 4);
                        const f32x4 w0 = *(const f32x4*)(ob + 1 * 1024 + s * 64), w1 = *(const f32x4*)(ob + 1 * 1024 + s * 64 + 4);
                        const f32x4 k0 = *(const f32x4*)(ob + 2 * 1024 + s * 64), k1 = *(const f32x4*)(ob + 2 * 1024 + s * 64 + 4);
                        const f32x4 r0 = *(const f32x4*)(ob + 3 * 1024 + s * 64), r1 = *(const f32x4*)(ob + 3 * 1024 + s * 64 + 4);
                        const f32x4 a0 = *(const f32x4*)(ob + 4 * 1024 + s * 64), a1 = *(const f32x4*)(ob + 4 * 1024 + s * 64 + 4);
                        const float vv = vb[s * 32];
                        float sa = 0.f;
#pragma unroll
                        for (int c = 0; c < 4; ++c) { sa += S[c] * kk0[c]; sa += S[c + 4] * kk1[c]; }
                        sa = allreduce8(sa);
                        float y = 0.f;
#pragma unroll
                        for (int c = 0; c < 4; ++c) {
                            S[c] = S[c] * w0[c] + (vv * k0[c] - sa * a0[c]);
                            S[c + 4] = S[c + 4] * w1[c] + (vv * k1[c] - sa * a1[c]);
                            y += S[c] * r0[c]; y += S[c + 4] * r1[c];
                        }
                        y = allreduce8(y);
                        if (seg == 0) ybuf[s * 32 + rl] = y;
                    }
                    __syncthreads();
                    {
#pragma unroll
                        for (int i = 0; i < 2; ++i) {
                            const int e = tid + i * 256, st = e >> 5, r = e & 31;
                            yraw[gbase + (size_t)(ch * 16 + st) * 512 + half * 32 + r] = ybuf[e];
                        }
                    }
                    if (ch + 1 < 128) commit((ch + 1) & 1);
                    __syncthreads();
                }
            } else {
                const int a = item - 128, c = 31 - (a >> 5), bh = a & 31, b = bh >> 2, h = bh & 3;
                const size_t row0 = (size_t)b * 2048 + c * 64;
                attn_item<192, 128, true>(qmla + row0 * 768 + h * 192, 768,
                                    kfull + ((size_t)b * 2048) * 768 + h * 192, 768,
                                    vTm + ((size_t)(b * 4 + h) * 128) * 2048, 2048, c + 1,
                                    mix + row0 * 1024 + h * 128, 1024, smem);
            }
        }
    }
    GRID_SYNC();

    if (PH & (1 << 4)) {
        PHASE_IDS
        const bf16_t* rwr = (const bf16_t*)(ws + O_RW_R);
        const bf16_t* rwk = (const bf16_t*)(ws + O_RW_K);
        const bf16_t* rwv = (const bf16_t*)(ws + O_RW_V);
        const bf16_t* gbuf = (const bf16_t*)(ws + O_G);
        const float* yraw = (const float*)(ws + O_YRAW);
        bf16_t* mix = (bf16_t*)(ws + O_MIX);
        for (int i = gtid; i < T * 128; i += gsz) {
            const int row = i >> 7, c4 = (i & 127) * 4;
            const size_t o = (size_t)row * 512 + c4;
            const f32x4 y = *(const f32x4*)(yraw + o);
            float s1 = y[0] + y[1] + y[2] + y[3];
#pragma unroll
            for (int d = 1; d < 16; d <<= 1) s1 += __shfl_xor(s1, d);
            const float mu = s1 * (1.0f / 64.0f);
            const f32x4 dy = y - mu;
            float s2 = dy[0] * dy[0] + dy[1] * dy[1] + dy[2] * dy[2] + dy[3] * dy[3];
            const u32x2 ru = *(const u32x2*)(rwr + o), ku = *(const u32x2*)(rwk + o), vu = *(const u32x2*)(rwv + o), gu = *(const u32x2*)(gbuf + o);
            const f32x4 rk = *(const f32x4*)(P.rw_r_k + c4);
            const f32x4 rv = (f32x4){bf_lo(ru.x), bf_hi(ru.x), bf_lo(ru.y), bf_hi(ru.y)};
            const f32x4 kv = (f32x4){bf_lo(ku.x), bf_hi(ku.x), bf_lo(ku.y), bf_hi(ku.y)};
            const f32x4 vv = (f32x4){bf_lo(vu.x), bf_hi(vu.x), bf_lo(vu.y), bf_hi(vu.y)};
            const f32x4 gv = (f32x4){bf_lo(gu.x), bf_hi(gu.x), bf_lo(gu.y), bf_hi(gu.y)};
            float s3 = rv[0] * kv[0] * rk[0] + rv[1] * kv[1] * rk[1] + rv[2] * kv[2] * rk[2] + rv[3] * kv[3] * rk[3];
#pragma unroll
            for (int d = 1; d < 16; d <<= 1) { s2 += __shfl_xor(s2, d); s3 += __shfl_xor(s3, d); }
            const float rstd = rsqrtf(s2 * (1.0f / 64.0f) + 64e-5f);
            const f32x4 lw = *(const f32x4*)(P.rw_lnx_w + c4), lb = *(const f32x4*)(P.rw_lnx_b + c4);
            f32x4 r;
#pragma unroll
            for (int j = 0; j < 4; ++j) {
#ifdef DBG_NOY
                r[j] = (lb[j] + s3 * vv[j]) * gv[j];
#else
                r[j] = (dy[j] * rstd * lw[j] + lb[j] + s3 * vv[j]) * gv[j];
#endif
            }
            u32x2 w; w.x = cvt_pk_bf16(r[0], r[1]); w.y = cvt_pk_bf16(r[2], r[3]);
            *(u32x2*)(mix + (size_t)row * 1024 + 512 + c4) = w;
        }
    }
    GRID_SYNC();

    if (PH & (1 << 5)) {
        PHASE_IDS
        const bf16_t* mix = (const bf16_t*)(ws + O_MIX);
        const bf16_t* woutT = (const bf16_t*)(ws + O_WOUTT);
        bf16_t* h1b = (bf16_t*)(ws + O_H1B);
        for (int item = bid; item < 128 * 8; item += nb) {
            const int tm = item >> 3, tn = item & 7;
            auto almix = [&](int row, int k) -> u32x4 {
#ifdef DBG_ZERO_RWKV
                if (k >= 512) return (u32x4){0u, 0u, 0u, 0u};
#endif
#ifdef DBG_ZERO_MLA
                if (k < 512) return (u32x4){0u, 0u, 0u, 0u};
#endif
                return *(const u32x4*)(mix + (size_t)row * 1024 + k);
            };
            gemm_tile<true>(almix, woutT, 1024, 1024, tm * 128, tn * 128, smem,
                [&](const f32x4 (&acc)[4][4], int rbase, int cbase, int fr, int fq) {
#pragma unroll
                    for (int m = 0; m < 4; ++m) {
                        const int row = rbase + m * 16 + fr;
                        float ss = 0.f;
#pragma unroll
                        for (int n = 0; n < 4; ++n) {
                            const size_t o = (size_t)row * 1024 + cbase + n * 16 + fq * 4;
                            const f32x4 v = *(const f32x4*)(P.x + o) + acc[m][n];
                            ss += v[0] * v[0] + v[1] * v[1] + v[2] * v[2] + v[3] * v[3];
                            *(f32x4*)(P.out + o) = v;
                            u32x2 w; w.x = cvt_pk_bf16(v[0], v[1]); w.y = cvt_pk_bf16(v[2], v[3]);
                            *(u32x2*)(h1b + o) = w;
                        }
                        ss += __shfl_xor(ss, 16); ss += __shfl_xor(ss, 32);
                        if (fq == 0) atomicAdd(&ssq1[row], ss);
                    }
                });
        }
        bf16_t* eub = (bf16_t*)(ws + O_EUB);
        bf16_t* evb = (bf16_t*)(ws + O_EVB);
        for (int i = gtid; i < 16384 * 1024 / 8; i += gsz) {
            const f32x4 a0 = *(const f32x4*)(P.expert_u + (size_t)i * 8), a1 = *(const f32x4*)(P.expert_u + (size_t)i * 8 + 4);
            const f32x4 b0 = *(const f32x4*)(P.expert_v + (size_t)i * 8), b1 = *(const f32x4*)(P.expert_v + (size_t)i * 8 + 4);
            u32x4 w;
            w.x = cvt_pk_bf16(a0[0], a0[1]); w.y = cvt_pk_bf16(a0[2], a0[3]); w.z = cvt_pk_bf16(a1[0], a1[1]); w.w = cvt_pk_bf16(a1[2], a1[3]);
            *(u32x4*)(eub + (size_t)i * 8) = w;
            w.x = cvt_pk_bf16(b0[0], b0[1]); w.y = cvt_pk_bf16(b0[2], b0[3]); w.z = cvt_pk_bf16(b1[0], b1[1]); w.w = cvt_pk_bf16(b1[2], b1[3]);
            *(u32x4*)(evb + (size_t)i * 8) = w;
        }
    }
    GRID_SYNC();

    if (PH & (1 << 6)) {
        PHASE_IDS
        const bf16_t* h1b = (const bf16_t*)(ws + O_H1B);
        const bf16_t* xaqT = (const bf16_t*)(ws + O_XAQT);
        bf16_t* qxa = (bf16_t*)(ws + O_QXA);
        const float XSCALE = 0.0625f * 1.4426950408889634f;
        for (int item = bid; item < 128 * 8; item += nb) {
            const int tm = item >> 3, tn = item & 7;
            gemm_tile<true>(PlainA{h1b, 1024}, xaqT, 1024, 1024, tm * 128, tn * 128, smem,
                [&](const f32x4 (&acc)[4][4], int rbase, int cbase, int fr, int fq) {
#pragma unroll
                    for (int m = 0; m < 4; ++m) {
                        const int row = rbase + m * 16 + fr;
                        const float rs = rsqrtf(ssq1[row] * (1.0f / 1024.0f) + EPS) * XSCALE;
#pragma unroll
                        for (int n = 0; n < 4; ++n) {
                            const f32x4 v = acc[m][n] * rs;
                            u32x2 w; w.x = cvt_pk_bf16(v[0], v[1]); w.y = cvt_pk_bf16(v[2], v[3]);
                            *(u32x2*)(qxa + (size_t)row * 1024 + cbase + n * 16 + fq * 4) = w;
                        }
                    }
                });
        }
    }
    GRID_SYNC();

    if (PH & (1 << 7)) {
        PHASE_IDS
        const bf16_t* qxa = (const bf16_t*)(ws + O_QXA);
        const bf16_t* km = (const bf16_t*)(ws + O_KM);
        const bf16_t* vmT = (const bf16_t*)(ws + O_VMT);
        bf16_t* oxa = (bf16_t*)(ws + O_OXA);
        for (int item = bid; item < 8 * 4 * 32; item += nb) {
            const int qt = item >> 5 & 31, bh = item & 31;
            const int b = bh >> 2, h = bh & 3;
            const size_t row0 = (size_t)b * 2048 + qt * 64;
            attn_item<256, 256, false>(qxa + row0 * 1024 + h * 256, 1024,
                                km + ((size_t)b * 256) * 1024 + h * 256, 1024,
                                vmT + ((size_t)(b * 4 + h) * 256) * 256, 256, 4,
                                oxa + row0 * 1024 + h * 256, 1024, smem);
        }
    }
    GRID_SYNC();

    if (PH & (1 << 8)) {
        PHASE_IDS
        const bf16_t* oxa = (const bf16_t*)(ws + O_OXA);
        const bf16_t* xaoT = (const bf16_t*)(ws + O_XAOT);
        bf16_t* h2b = (bf16_t*)(ws + O_H2B);
        for (int item = bid; item < 128 * 8; item += nb) {
            const int tm = item >> 3, tn = item & 7;
            gemm_tile<true>(PlainA{oxa, 1024}, xaoT, 1024, 1024, tm * 128, tn * 128, smem,
                [&](const f32x4 (&acc)[4][4], int rbase, int cbase, int fr, int fq) {
#pragma unroll
                    for (int m = 0; m < 4; ++m) {
                        const int row = rbase + m * 16 + fr;
                        float ss = 0.f;
#pragma unroll
                        for (int n = 0; n < 4; ++n) {
                            const size_t o = (size_t)row * 1024 + cbase + n * 16 + fq * 4;
                            const f32x4 v = *(const f32x4*)(P.out + o) + acc[m][n];
                            ss += v[0] * v[0] + v[1] * v[1] + v[2] * v[2] + v[3] * v[3];
                            *(f32x4*)(P.out + o) = v;
                            u32x2 w; w.x = cvt_pk_bf16(v[0], v[1]); w.y = cvt_pk_bf16(v[2], v[3]);
                            *(u32x2*)(h2b + o) = w;
                        }
                        ss += __shfl_xor(ss, 16); ss += __shfl_xor(ss, 32);
                        if (fq == 0) atomicAdd(&ssq2[row], ss);
                    }
                });
        }
    }
    GRID_SYNC();

    if (PH & (1 << 9)) {
        PHASE_IDS
        const bf16_t* h2b = (const bf16_t*)(ws + O_H2B);
        const bf16_t* pwqT = (const bf16_t*)(ws + O_PWQT);
        bf16_t* pq = (bf16_t*)(ws + O_PQ);
        for (int item = bid; item < 128 * 16; item += nb) {
            const int tm = item >> 4, tn = item & 15;
            gemm_tile<true>(PlainA{h2b, 1024}, pwqT, 1024, 1024, tm * 128, tn * 128, smem,
                [&](const f32x4 (&acc)[4][4], int rbase, int cbase, int fr, int fq) {
#pragma unroll
                    for (int m = 0; m < 4; ++m) {
                        const int row = rbase + m * 16 + fr;
                        const float rs = rsqrtf(ssq2[row] * (1.0f / 1024.0f) + EPS);
#pragma unroll
                        for (int n = 0; n < 4; ++n) {
                            const f32x4 v = acc[m][n] * rs;
                            u32x2 w; w.x = cvt_pk_bf16(v[0], v[1]); w.y = cvt_pk_bf16(v[2], v[3]);
                            *(u32x2*)(pq + (size_t)row * 2048 + cbase + n * 16 + fq * 4) = w;
                        }
                    }
                });
        }
    }
    GRID_SYNC();

    if (PH & (1 << 10)) {
        PHASE_IDS
        const bf16_t* pq = (const bf16_t*)(ws + O_PQ);
        const bf16_t* keysb = (const bf16_t*)(ws + O_KEYS);
        bf16_t* scores = (bf16_t*)(ws + O_SCORES);
        for (int item = bid; item < 128 * 16; item += nb) {
            const int tm = item >> 4, g = item & 15;
            gemm_tile<true>(PlainA{pq + g * 128, 2048}, keysb, 128, 128, tm * 128, g * 128, smem,
                [&](const f32x4 (&acc)[4][4], int rbase, int cbase, int fr, int fq) {
#pragma unroll
                    for (int m = 0; m < 4; ++m) {
                        const int row = rbase + m * 16 + fr;
#pragma unroll
                        for (int n = 0; n < 4; ++n) {
                            const f32x4 v = acc[m][n];
                            u32x2 w; w.x = cvt_pk_bf16(v[0], v[1]); w.y = cvt_pk_bf16(v[2], v[3]);
                            *(u32x2*)(scores + (size_t)row * 2048 + cbase + n * 16 + fq * 4) = w;
                        }
                    }
                });
        }
    }
    GRID_SYNC();

    if (PH & (1 << 11)) {
        PHASE_IDS
        const bf16_t* scores = (const bf16_t*)(ws + O_SCORES);
        const bf16_t* eub = (const bf16_t*)(ws + O_EUB);
        const bf16_t* evb = (const bf16_t*)(ws + O_EVB);
        char* wsm = smem + wid * 10752;
        int* eidx = (int*)wsm;
        float* egate = (float*)(wsm + 4096);
        bf16_t* xs = (bf16_t*)(wsm + 8192);
        float* acts = (float*)(wsm + 10240);
        const int fr = lane & 15, fq = lane >> 4;
        for (int witem = bid * 4 + wid; witem < T / 8; witem += nb * 4) {
            const int t0 = witem * 8;
            {
                const int tt = lane >> 3, h = lane & 7;
                const bf16_t* sp = scores + (size_t)(t0 + tt) * 2048 + h * 256;
                unsigned L1[16], L2[16];
#pragma unroll
                for (int s = 0; s < 16; ++s) { L1[s] = 0u; L2[s] = 0u; }
                for (int i = 0; i < 128; i += 8) {
                    const u32x4 a = *(const u32x4*)(sp + i);
                    const u32x4 b = *(const u32x4*)(sp + 128 + i);
                    const unsigned au[4] = {a.x, a.y, a.z, a.w}, bu[4] = {b.x, b.y, b.z, b.w};
#pragma unroll
                    for (int e = 0; e < 4; ++e) {
                        const unsigned id0 = 127u - (unsigned)(i + 2 * e), id1 = id0 - 1u;
                        TOPK_INSERT(L1, (ordkey(bf_lo(au[e])) & ~127u) | id0);
                        TOPK_INSERT(L1, (ordkey(bf_hi(au[e])) & ~127u) | id1);
                        TOPK_INSERT(L2, (ordkey(bf_lo(bu[e])) & ~127u) | id0);
                        TOPK_INSERT(L2, (ordkey(bf_hi(bu[e])) & ~127u) | id1);
                    }
                }
                float v1[16], v2[16];
                unsigned pa0 = 0u, pa1 = 0u, pa2 = 0u, pa3 = 0u, pb0 = 0u, pb1 = 0u, pb2 = 0u, pb3 = 0u;
#pragma unroll
                for (int s = 0; s < 16; ++s) {
                    v1[s] = unordkey(L1[s] & ~127u); v2[s] = unordkey(L2[s] & ~127u);
                    const unsigned i1_ = (127u - (L1[s] & 127u)) << ((s & 3) * 8), i2_ = (127u - (L2[s] & 127u)) << ((s & 3) * 8);
                    if ((s >> 2) == 0) { pa0 |= i1_; pb0 |= i2_; } else if ((s >> 2) == 1) { pa1 |= i1_; pb1 |= i2_; }
                    else if ((s >> 2) == 2) { pa2 |= i1_; pb2 |= i2_; } else { pa3 |= i1_; pb3 |= i2_; }
                }
                unsigned C[16];
#pragma unroll
                for (int s = 0; s < 16; ++s) C[s] = 0u;
#pragma unroll
                for (int a = 0; a < 16; ++a)
#pragma unroll
                    for (int b = 0; b < 16; ++b)
                        if ((a + 1) * (b + 1) <= 16) { TOPK_INSERT(C, (ordkey(v1[a] + v2[b]) & ~255u) | (255u - (unsigned)(a * 16 + b))); }
                float cv[16], sum = 0.f;
                {
                    const float mxv = unordkey(C[0] & ~255u);
                    sum = 0.f;
#pragma unroll
                    for (int s = 0; s < 16; ++s) { cv[s] = __expf(unordkey(C[s] & ~255u) - mxv); sum += cv[s]; }
                }
                const float isum = 1.0f / sum;
#pragma unroll
                for (int s = 0; s < 16; ++s) {
                    const int ab = 255 - (int)(C[s] & 255u), a = ab >> 4, b = ab & 15;
                    const int e = (int)(byte_lookup(pa0, pa1, pa2, pa3, a) * 128u + byte_lookup(pb0, pb1, pb2, pb3, b));
                    eidx[tt * 128 + h * 16 + s] = e;
                    egate[tt * 128 + h * 16 + s] = cv[s] * isum;
                }
            }
            __builtin_amdgcn_wave_barrier();
            for (int tt = 0; tt < 8; ++tt) {
                const int row = t0 + tt;
                const float* hrow = P.out + (size_t)row * 1024;
                f32x4 hv[4];
                hv[0] = *(const f32x4*)(hrow + lane * 8); hv[1] = *(const f32x4*)(hrow + lane * 8 + 4);
                hv[2] = *(const f32x4*)(hrow + 512 + lane * 8); hv[3] = *(const f32x4*)(hrow + 512 + lane * 8 + 4);
                const float rs2 = rsqrtf(ssq2[row] * (1.0f / 1024.0f) + EPS);
                {
                    const f32x4 g0 = *(const f32x4*)(P.norm_ffn_g + lane * 8), g1 = *(const f32x4*)(P.norm_ffn_g + lane * 8 + 4);
                    const f32x4 g2 = *(const f32x4*)(P.norm_ffn_g + 512 + lane * 8), g3 = *(const f32x4*)(P.norm_ffn_g + 512 + lane * 8 + 4);
                    const f32x4 a0 = hv[0] * g0 * rs2, a1 = hv[1] * g1 * rs2, a2 = hv[2] * g2 * rs2, a3 = hv[3] * g3 * rs2;
                    u32x4 w;
                    w.x = cvt_pk_bf16(a0[0], a0[1]); w.y = cvt_pk_bf16(a0[2], a0[3]); w.z = cvt_pk_bf16(a1[0], a1[1]); w.w = cvt_pk_bf16(a1[2], a1[3]);
                    *(u32x4*)(xs + lane * 8) = w;
                    w.x = cvt_pk_bf16(a2[0], a2[1]); w.y = cvt_pk_bf16(a2[2], a2[3]); w.z = cvt_pk_bf16(a3[0], a3[1]); w.w = cvt_pk_bf16(a3[2], a3[3]);
                    *(u32x4*)(xs + 512 + lane * 8) = w;
                }
                __builtin_amdgcn_wave_barrier();
                int er[8];
#pragma unroll
                for (int eg = 0; eg < 8; ++eg) er[eg] = eidx[tt * 128 + eg * 16 + fr];
                f32x4 acc[8];
#pragma unroll
                for (int eg = 0; eg < 8; ++eg) acc[eg] = (f32x4){0.f, 0.f, 0.f, 0.f};
#pragma unroll 2
                for (int it = 0; it < 16; ++it) {
                    const bf16x8 xb0 = *(const bf16x8*)(xs + it * 64 + fq * 16);
                    const bf16x8 xb1 = *(const bf16x8*)(xs + it * 64 + fq * 16 + 8);
#pragma unroll
                    for (int eg = 0; eg < 8; ++eg) {
                        const bf16_t* up = eub + (size_t)er[eg] * 1024 + it * 64 + fq * 16;
                        const bf16x8 a0 = *(const bf16x8*)up, a1 = *(const bf16x8*)(up + 8);
                        acc[eg] = mfma16(a0, xb0, acc[eg]);
                        acc[eg] = mfma16(a1, xb1, acc[eg]);
                    }
                }
#pragma unroll
                for (int eg = 0; eg < 8; ++eg) {
                    const f32x4 gt = *(const f32x4*)(egate + tt * 128 + eg * 16 + fq * 4);
                    f32x4 av;
#pragma unroll
                    for (int j = 0; j < 4; ++j) { const float pre = acc[eg][j]; av[j] = 0.5f * pre * (1.0f + erff(pre * 0.70710678118654752f)) * gt[j]; }
                    if (fr == 0) *(f32x4*)(acts + eg * 16 + fq * 4) = av;
                }
                __builtin_amdgcn_wave_barrier();
                f32x4 oa[4];
#pragma unroll
                for (int i = 0; i < 4; ++i) oa[i] = (f32x4){0.f, 0.f, 0.f, 0.f};
                for (int j0 = 0; j0 < 128; j0 += 4) {
                    const f32x4 a4 = *(const f32x4*)(acts + j0);
                    const int e0 = eidx[tt * 128 + j0], e1 = eidx[tt * 128 + j0 + 1], e2 = eidx[tt * 128 + j0 + 2], e3 = eidx[tt * 128 + j0 + 3];
                    const int es[4] = {e0, e1, e2, e3};
                    u32x4 va[4], vb[4];
#pragma unroll
                    for (int jj = 0; jj < 4; ++jj) {
                        const bf16_t* vp = evb + (size_t)es[jj] * 1024 + lane * 8;
                        va[jj] = *(const u32x4*)vp; vb[jj] = *(const u32x4*)(vp + 512);
                    }
#pragma unroll
                    for (int jj = 0; jj < 4; ++jj) {
                        const float a = a4[jj];
                        oa[0][0] += a * bf_lo(va[jj].x); oa[0][1] += a * bf_hi(va[jj].x); oa[0][2] += a * bf_lo(va[jj].y); oa[0][3] += a * bf_hi(va[jj].y);
                        oa[1][0] += a * bf_lo(va[jj].z); oa[1][1] += a * bf_hi(va[jj].z); oa[1][2] += a * bf_lo(va[jj].w); oa[1][3] += a * bf_hi(va[jj].w);
                        oa[2][0] += a * bf_lo(vb[jj].x); oa[2][1] += a * bf_hi(vb[jj].x); oa[2][2] += a * bf_lo(vb[jj].y); oa[2][3] += a * bf_hi(vb[jj].y);
                        oa[3][0] += a * bf_lo(vb[jj].z); oa[3][1] += a * bf_hi(vb[jj].z); oa[3][2] += a * bf_lo(vb[jj].w); oa[3][3] += a * bf_hi(vb[jj].w);
                    }
                }
                float ss = 0.f;
#pragma unroll
                for (int i = 0; i < 4; ++i) { hv[i] = hv[i] + oa[i]; ss += hv[i][0] * hv[i][0] + hv[i][1] * hv[i][1] + hv[i][2] * hv[i][2] + hv[i][3] * hv[i][3]; }
                ss = wave_sum(ss);
                const float rs3 = rsqrtf(ss * (1.0f / 1024.0f) + EPS);
                float* orow = P.out + (size_t)row * 1024;
                *(f32x4*)(orow + lane * 8) = hv[0] * rs3 * *(const f32x4*)(P.final_norm_g + lane * 8);
                *(f32x4*)(orow + lane * 8 + 4) = hv[1] * rs3 * *(const f32x4*)(P.final_norm_g + lane * 8 + 4);
                *(f32x4*)(orow + 512 + lane * 8) = hv[2] * rs3 * *(const f32x4*)(P.final_norm_g + 512 + lane * 8);
                *(f32x4*)(orow + 512 + lane * 8 + 4) = hv[3] * rs3 * *(const f32x4*)(P.final_norm_g + 512 + lane * 8 + 4);
                __builtin_amdgcn_wave_barrier();
            }
        }
    }

    if (PH & (1 << 12)) {
        PHASE_IDS
        GRID_SYNC();
        const float* src = (PH & (1 << 5)) ? (const float*)P.out : P.x;
        for (int r = bid * 4 + wid; r < T; r += nb * 4) {
            const float* srow = src + (size_t)r * 1024;
            f32x4 v[4]; float ss = 0.f;
#pragma unroll
            for (int i = 0; i < 4; ++i) { v[i] = *(const f32x4*)(srow + i * 256 + lane * 4); ss += v[i][0] * v[i][0] + v[i][1] * v[i][1] + v[i][2] * v[i][2] + v[i][3] * v[i][3]; }
            ss = wave_sum(ss);
            const float rs = rsqrtf(ss * (1.0f / 1024.0f) + EPS);
#pragma unroll
            for (int i = 0; i < 4; ++i) *(f32x4*)(P.out + (size_t)r * 1024 + i * 256 + lane * 4) = v[i] * rs * *(const f32x4*)(P.final_norm_g + i * 256 + lane * 4);
        }
    }
}

extern "C" void kernel_launch(void* const* d_in, const int* in_sizes, int n_in, void* d_out, int out_size, void* d_ws, size_t ws_size,
                              hipStream_t stream) {
    (void)in_sizes; (void)n_in; (void)out_size;
    if (ws_size < WS_NEED) { fprintf(stderr, "workspace too small: %zu\n", ws_size); return; }
    static int grid_blocks = 0;
    if (!grid_blocks) {
        int dev = 0, cus = 0, per_cu = 0;
        hipGetDevice(&dev);
        hipDeviceGetAttribute(&cus, hipDeviceAttributeMultiprocessorCount, dev);
        hipOccupancyMaxActiveBlocksPerMultiprocessor(&per_cu, fwd_megakernel, 256, 0);
        if (per_cu > 2) per_cu = 2;
        grid_blocks = cus * per_cu;
    }
    Params p{};
    const float** fp = (const float**)&p;
    (void)fp;
    p.x = (const float*)d_in[0]; p.mem = (const float*)d_in[1]; p.pos = (const int*)d_in[2];
    p.norm_mix_g = (const float*)d_in[3]; p.w_in = (const float*)d_in[4]; p.shift_mu = (const float*)d_in[5];
    p.q_norm_g = (const float*)d_in[6]; p.kv_norm_g = (const float*)d_in[7]; p.w_uq = (const float*)d_in[8]; p.w_ukv = (const float*)d_in[9];
    p.rw_w0 = (const float*)d_in[10]; p.rw_w_up = (const float*)d_in[11]; p.rw_a0 = (const float*)d_in[12]; p.rw_a_up = (const float*)d_in[13];
    p.rw_g_up = (const float*)d_in[14]; p.rw_k_k = (const float*)d_in[15]; p.rw_k_a = (const float*)d_in[16]; p.rw_r_k = (const float*)d_in[17];
    p.rw_lnx_w = (const float*)d_in[18]; p.rw_lnx_b = (const float*)d_in[19]; p.w_out = (const float*)d_in[20];
    p.norm_xa_g = (const float*)d_in[21]; p.norm_mem_g = (const float*)d_in[22]; p.xa_wq = (const float*)d_in[23]; p.xa_wk = (const float*)d_in[24];
    p.xa_wv = (const float*)d_in[25]; p.xa_wo = (const float*)d_in[26]; p.norm_ffn_g = (const float*)d_in[27]; p.peer_wq = (const float*)d_in[28];
    p.peer_keys = (const float*)d_in[29]; p.expert_u = (const float*)d_in[30]; p.expert_v = (const float*)d_in[31]; p.final_norm_g = (const float*)d_in[32];
    p.out = (float*)d_out; p.ws = (char*)d_ws;
    void* args[] = {&p};
    hipError_t e = hipLaunchCooperativeKernel((void*)fwd_megakernel, dim3(grid_blocks), dim3(256), args, 0, stream);
    if (e != hipSuccess) fprintf(stderr, "cooperative launch failed: %s (grid %d)\n", hipGetErrorString(e), grid_blocks);
}
```

```cpp
#include <hip/hip_runtime.h>
#include <hip/hip_cooperative_groups.h>
#include <cstdio>
namespace cg = cooperative_groups;

typedef unsigned short bf16_t;
typedef short bf16x8 __attribute__((ext_vector_type(8)));
typedef float f32x4 __attribute__((ext_vector_type(4)));
typedef unsigned u32x4 __attribute__((ext_vector_type(4)));
typedef unsigned u32x2 __attribute__((ext_vector_type(2)));
typedef long i64x2 __attribute__((ext_vector_type(2)));

#define DEV __device__ __forceinline__

constexpr int T = 16384;
constexpr float EPS = 1e-6f;
constexpr size_t MB = 1u << 20;
constexpr size_t XCD_BAR_WORDS_BYTES = 3456 * 4;

constexpr size_t O_WINT  = 0;
constexpr size_t O_WUQT  = O_WINT  + (size_t)2304 * 1024 * 2;
constexpr size_t O_WUKT  = O_WUQT  + (size_t)768 * 256 * 2;
constexpr size_t O_WUVT  = O_WUKT  + (size_t)512 * 128 * 2;
constexpr size_t O_WUPT  = O_WUVT  + (size_t)512 * 128 * 2;
constexpr size_t O_AUPT  = O_WUPT  + (size_t)512 * 64 * 2;
constexpr size_t O_GUPT  = O_AUPT  + (size_t)512 * 64 * 2;
constexpr size_t O_WOUTT = O_GUPT  + (size_t)512 * 128 * 2;
constexpr size_t O_XAQT  = O_WOUTT + (size_t)1024 * 1024 * 2;
constexpr size_t O_XAKVT = O_XAQT  + (size_t)1024 * 1024 * 2;
constexpr size_t O_XAOT  = O_XAKVT + (size_t)2048 * 1024 * 2;
constexpr size_t O_PWQT  = O_XAOT  + (size_t)1024 * 1024 * 2;
constexpr size_t O_KEYS  = O_PWQT  + (size_t)2048 * 1024 * 2;
constexpr size_t O_SSQ   = O_KEYS  + (size_t)16 * 128 * 128 * 2;
constexpr size_t O_CNT   = O_SSQ   + (size_t)8 * 65536;
constexpr size_t O_ROPE  = O_CNT   + 4096;
constexpr size_t O_KM    = O_ROPE  + (size_t)T * 32 * 8;
constexpr size_t O_VMT   = O_KM    + (size_t)2048 * 1024 * 2;
constexpr size_t O_MEMB  = O_VMT   + (size_t)2048 * 1024 * 2;
constexpr size_t O_PERSIST_END = O_MEMB + (size_t)2048 * 1024 * 2;
constexpr size_t O_XBAR = O_PERSIST_END;
static_assert(O_XBAR + XCD_BAR_WORDS_BYTES <= 40 * MB, "persistent region too large");
constexpr size_t O_P     = 40 * MB;
constexpr size_t O_YRAW  = 40 * MB;
constexpr size_t O_MIX   = 72 * MB;
constexpr size_t O_OXA   = 144 * MB;
constexpr size_t O_H2B   = 72 * MB;
constexpr size_t O_SCORES= 144 * MB;
constexpr size_t O_SCORES_OLD_UNUSED = 40 * MB;
constexpr size_t O_XB    = 112 * MB;
constexpr size_t O_G     = 112 * MB;
constexpr size_t O_QXA   = 72 * MB;
constexpr size_t O_RW_R  = 144 * MB;
constexpr size_t O_RW_K  = 160 * MB;
constexpr size_t O_RW_V  = 176 * MB;
constexpr size_t O_RW_KK = 192 * MB;
constexpr size_t O_RW_KA = 208 * MB;
constexpr size_t O_DECAY = 224 * MB;
constexpr size_t O_H1B   = 144 * MB;
constexpr size_t O_EUB   = 128 * MB;
constexpr size_t O_EUB_OLD = 176 * MB;
constexpr size_t O_EVB   = 56 * MB;
constexpr size_t O_EVB_OLD = 208 * MB;
constexpr size_t O_PQ    = 104 * MB;
constexpr size_t WS_NEED = 256 * MB;

struct Params {
    const float *x, *mem; const int* pos;
    const float *norm_mix_g, *w_in, *shift_mu, *q_norm_g, *kv_norm_g, *w_uq, *w_ukv;
    const float *rw_w0, *rw_w_up, *rw_a0, *rw_a_up, *rw_g_up, *rw_k_k, *rw_k_a, *rw_r_k, *rw_lnx_w, *rw_lnx_b;
    const float *w_out, *norm_xa_g, *norm_mem_g, *xa_wq, *xa_wk, *xa_wv, *xa_wo;
    const float *norm_ffn_g, *peer_wq, *peer_keys, *expert_u, *expert_v, *final_norm_g;
    float* out; char* ws;
};

typedef __bf16 bf16x2_t __attribute__((ext_vector_type(2)));
typedef float f32x2_t __attribute__((ext_vector_type(2)));
DEV unsigned cvt_pk_bf16(float lo, float hi) { const f32x2_t f = {lo, hi}; const bf16x2_t b = __builtin_convertvector(f, bf16x2_t); unsigned r; __builtin_memcpy(&r, &b, 4); return r; }
DEV float bf_lo(unsigned u) { return __uint_as_float(u << 16); }
DEV float bf_hi(unsigned u) { return __uint_as_float(u & 0xffff0000u); }
DEV f32x4 mfma16(bf16x8 a, bf16x8 b, f32x4 c) { return __builtin_amdgcn_mfma_f32_16x16x32_bf16(a, b, c, 0, 0, 0); }
DEV float sigmoidf_(float v) { return 1.0f / (1.0f + __expf(-v)); }
DEV float wave_sum(float v) {
#pragma unroll
    for (int o = 32; o >= 1; o >>= 1) v += __shfl_xor(v, o);
    return v;
}
DEV float allreduce8(float x) {
    x += __int_as_float(__builtin_amdgcn_update_dpp(0, __float_as_int(x), 0xB1, 0xF, 0xF, true));
    x += __int_as_float(__builtin_amdgcn_update_dpp(0, __float_as_int(x), 0x4E, 0xF, 0xF, true));
    x += __int_as_float(__builtin_amdgcn_update_dpp(0, __float_as_int(x), 0x141, 0xF, 0xF, true));
    return x;
}
DEV float opq(float x) { asm("" : "+v"(x)); return x; }
DEV void lds_barrier() { asm volatile("s_waitcnt lgkmcnt(0)\n\ts_barrier" ::: "memory"); }
DEV float allreduce16(float x) {
    x += __int_as_float(__builtin_amdgcn_update_dpp(0, __float_as_int(x), 0xB1, 0xF, 0xF, true));
    x += __int_as_float(__builtin_amdgcn_update_dpp(0, __float_as_int(x), 0x4E, 0xF, 0xF, true));
    x += __int_as_float(__builtin_amdgcn_update_dpp(0, __float_as_int(x), 0x141, 0xF, 0xF, true));
    x += __int_as_float(__builtin_amdgcn_update_dpp(0, __float_as_int(x), 0x140, 0xF, 0xF, true));
    return x;
}
DEV void allreduce16_pair(float& a, float& b) {
    a += __int_as_float(__builtin_amdgcn_update_dpp(0, __float_as_int(a), 0xB1, 0xF, 0xF, true));
    b += __int_as_float(__builtin_amdgcn_update_dpp(0, __float_as_int(b), 0xB1, 0xF, 0xF, true));
    a += __int_as_float(__builtin_amdgcn_update_dpp(0, __float_as_int(a), 0x4E, 0xF, 0xF, true));
    b += __int_as_float(__builtin_amdgcn_update_dpp(0, __float_as_int(b), 0x4E, 0xF, 0xF, true));
    a += __int_as_float(__builtin_amdgcn_update_dpp(0, __float_as_int(a), 0x141, 0xF, 0xF, true));
    b += __int_as_float(__builtin_amdgcn_update_dpp(0, __float_as_int(b), 0x141, 0xF, 0xF, true));
    a += __int_as_float(__builtin_amdgcn_update_dpp(0, __float_as_int(a), 0x140, 0xF, 0xF, true));
    b += __int_as_float(__builtin_amdgcn_update_dpp(0, __float_as_int(b), 0x140, 0xF, 0xF, true));
}
DEV bf16x8 as_bf16x8(u32x4 v) { bf16x8 r; __builtin_memcpy(&r, &v, 16); return r; }

template <bool SWAP, class AL, class EP>
DEV void gemm_tile(AL aload, const bf16_t* __restrict__ Bt, int ldb, int K, int row0, int col0, char* smem, EP epi) {
    int tid = threadIdx.x; asm volatile("" : "+v"(tid));
    const int wid = __builtin_amdgcn_readfirstlane(tid >> 6), lane = tid & 63, wr = wid >> 1, wc = wid & 1, fr = lane & 15, fq = lane >> 4;
    constexpr int RS = 144;
    constexpr int TB = 128 * RS;
    char* sA = smem; char* sB = smem + 2 * TB;
    f32x4 acc[4][4];
#pragma unroll
    for (int m = 0; m < 4; ++m)
#pragma unroll
        for (int n = 0; n < 4; ++n) acc[m][n] = (f32x4){0.f, 0.f, 0.f, 0.f};
    const int lr = tid >> 3, lk = (tid & 7) * 8;
    const bf16_t* bp = Bt + (size_t)(col0 + lr) * ldb + lk;
    const int lo = lr * RS + (tid & 7) * 16;
    u32x4 ra[4], rb[4];
#pragma unroll
    for (int i = 0; i < 4; ++i) { ra[i] = aload(row0 + lr + 32 * i, lk); rb[i] = *(const u32x4*)(bp + (size_t)(32 * i) * ldb); }
#pragma unroll
    for (int i = 0; i < 4; ++i) { *(u32x4*)(sA + lo + i * 32 * RS) = ra[i]; *(u32x4*)(sB + lo + i * 32 * RS) = rb[i]; }
    __syncthreads();
    const int nt = K >> 6;
    for (int t = 0; t < nt; ++t) {
        const bool more = (t + 1 < nt);
        if (more) {
            const int kb = (t + 1) << 6;
#pragma unroll
            for (int i = 0; i < 4; ++i) { ra[i] = aload(row0 + lr + 32 * i, kb + lk); rb[i] = *(const u32x4*)(bp + (size_t)(32 * i) * ldb + kb); }
        }
        const char* a = sA + (t & 1) * TB; const char* b = sB + (t & 1) * TB;
#pragma unroll
        for (int kh = 0; kh < 2; ++kh) {
            bf16x8 af[4], bfr[4];
#pragma unroll
            for (int m = 0; m < 4; ++m) af[m] = *(const bf16x8*)(a + (wr * 64 + m * 16 + fr) * RS + kh * 64 + fq * 16);
#pragma unroll
            for (int n = 0; n < 4; ++n) bfr[n] = *(const bf16x8*)(b + (wc * 64 + n * 16 + fr) * RS + kh * 64 + fq * 16);
#pragma unroll
            for (int m = 0; m < 4; ++m)
#pragma unroll
                for (int n = 0; n < 4; ++n)
                    acc[m][n] = SWAP ? mfma16(bfr[n], af[m], acc[m][n]) : mfma16(af[m], bfr[n], acc[m][n]);
        }
        if (more) {
            const int o = ((t + 1) & 1) * TB;
#pragma unroll
            for (int i = 0; i < 4; ++i) { *(u32x4*)(sA + o + lo + i * 32 * RS) = ra[i]; *(u32x4*)(sB + o + lo + i * 32 * RS) = rb[i]; }
        }
        __syncthreads();
    }
    int rb_ = row0 + wr * 64, cb_ = col0 + wc * 64;
    asm volatile("" : "+s"(rb_), "+s"(cb_));
    epi(acc, rb_, cb_, fr, fq);
}

#define GLDS16(gp, lp) __builtin_amdgcn_global_load_lds((const unsigned*)(gp), (__attribute__((address_space(3))) unsigned*)(lp), 16, 0, 0)
template <bool SWAP, class EP>
DEV void gemm_tile_glds(const bf16_t* __restrict__ A, int lda, const bf16_t* __restrict__ Bt, int ldb, int K, int row0, int col0, char* smem, EP epi) {
    int tid = threadIdx.x; asm volatile("" : "+v"(tid));
    const int wid = __builtin_amdgcn_readfirstlane(tid >> 6), lane = tid & 63, wr = wid >> 1, wc = wid & 1, fr = lane & 15, fq = lane >> 4;
    constexpr int ST = 16384;
    f32x4 acc[4][4];
#pragma unroll
    for (int m = 0; m < 4; ++m)
#pragma unroll
        for (int n = 0; n < 4; ++n) acc[m][n] = (f32x4){0.f, 0.f, 0.f, 0.f};
    const int b0 = tid * 16, r0 = b0 >> 6, c0 = (b0 & 63) >> 1;
    const bf16_t* ap0 = A + (size_t)(row0 + r0) * lda + c0;
    const bf16_t* ap1 = ap0 + (size_t)64 * lda;
    const bf16_t* bp0 = Bt + (size_t)(col0 + r0) * ldb + c0;
    const bf16_t* bp1 = bp0 + (size_t)64 * ldb;
    auto issue = [&](int kt) {
        char* st = smem + (kt & 3) * ST + b0;
        GLDS16(ap0 + kt * 32, st); GLDS16(ap1 + kt * 32, st + 4096);
        GLDS16(bp0 + kt * 32, st + 8192); GLDS16(bp1 + kt * 32, st + 8192 + 4096);
    };
    const int nt = K >> 5;
    asm volatile("s_waitcnt vmcnt(0) lgkmcnt(0)\n\ts_barrier" ::: "memory");
    issue(0);
    if (nt > 1) issue(1);
    if (nt > 2) issue(2);
    for (int t = 0; t < nt; ++t) {
        if (t + 2 < nt) asm volatile("s_waitcnt vmcnt(8)" ::: "memory");
        else if (t + 1 < nt) asm volatile("s_waitcnt vmcnt(4)" ::: "memory");
        else asm volatile("s_waitcnt vmcnt(0)" ::: "memory");
        asm volatile("s_barrier" ::: "memory");
        if (t + 3 < nt) issue(t + 3);
        const char* a = smem + (t & 3) * ST; const char* b = a + 8192;
        bf16x8 af[4], bfr[4];
#pragma unroll
        for (int m = 0; m < 4; ++m) af[m] = *(const bf16x8*)(a + (wr * 64 + m * 16 + fr) * 64 + fq * 16);
#pragma unroll
        for (int n = 0; n < 4; ++n) bfr[n] = *(const bf16x8*)(b + (wc * 64 + n * 16 + fr) * 64 + fq * 16);
#pragma unroll
        for (int m = 0; m < 4; ++m)
#pragma unroll
            for (int n = 0; n < 4; ++n)
                acc[m][n] = SWAP ? mfma16(bfr[n], af[m], acc[m][n]) : mfma16(af[m], bfr[n], acc[m][n]);
    }
    int rb_ = row0 + wr * 64, cb_ = col0 + wc * 64;
    asm volatile("" : "+s"(rb_), "+s"(cb_));
    epi(acc, rb_, cb_, fr, fq);
}

template <bool SWAP, class EP>
DEV void gemm_tile_big(const bf16_t* __restrict__ A, int lda, const bf16_t* __restrict__ Bt, int ldb, int K, int row0, int col0, char* smem, EP epi) {
    int tid = threadIdx.x; asm volatile("" : "+v"(tid));
    const int wid = __builtin_amdgcn_readfirstlane(tid >> 6), lane = tid & 63, wr = wid >> 1, wc = wid & 1, fr = lane & 15, fq = lane >> 4;
    constexpr int ST = 24576;
    f32x4 acc[2][4][4];
#pragma unroll
    for (int h = 0; h < 2; ++h)
#pragma unroll
        for (int m = 0; m < 4; ++m)
#pragma unroll
            for (int n = 0; n < 4; ++n) acc[h][m][n] = (f32x4){0.f, 0.f, 0.f, 0.f};
    const int b0 = tid * 16, r0 = b0 >> 6, c0 = (b0 & 63) >> 1;
    const bf16_t* ap = A + (size_t)(row0 + r0) * lda + c0;
    const bf16_t* bp = Bt + (size_t)(col0 + r0) * ldb + c0;
    const size_t a64 = (size_t)64 * lda, b64 = (size_t)64 * ldb;
    auto issue = [&](int kt) {
        char* st = smem + (kt % 3) * ST + b0;
        GLDS16(ap + kt * 32, st); GLDS16(ap + a64 + kt * 32, st + 4096);
        GLDS16(ap + 2 * a64 + kt * 32, st + 8192); GLDS16(ap + 3 * a64 + kt * 32, st + 12288);
        GLDS16(bp + kt * 32, st + 16384); GLDS16(bp + b64 + kt * 32, st + 16384 + 4096);
    };
    const int nt = K >> 5;
    asm volatile("s_waitcnt vmcnt(0) lgkmcnt(0)\n\ts_barrier" ::: "memory");
    issue(0);
    if (nt > 1) issue(1);
    for (int t = 0; t < nt; ++t) {
        if (t + 1 < nt) asm volatile("s_waitcnt vmcnt(6)" ::: "memory");
        else asm volatile("s_waitcnt vmcnt(0)" ::: "memory");
        asm volatile("s_barrier" ::: "memory");
        if (t + 2 < nt) issue(t + 2);
        const char* a = smem + (t % 3) * ST; const char* b = a + 16384;
        bf16x8 bfr[4];
#pragma unroll
        for (int n = 0; n < 4; ++n) bfr[n] = *(const bf16x8*)(b + (wc * 64 + n * 16 + fr) * 64 + fq * 16);
#pragma unroll
        for (int h = 0; h < 2; ++h) {
            bf16x8 af[4];
#pragma unroll
            for (int m = 0; m < 4; ++m) af[m] = *(const bf16x8*)(a + (wr * 128 + h * 64 + m * 16 + fr) * 64 + fq * 16);
#pragma unroll
            for (int m = 0; m < 4; ++m)
#pragma unroll
                for (int n = 0; n < 4; ++n)
                    acc[h][m][n] = SWAP ? mfma16(bfr[n], af[m], acc[h][m][n]) : mfma16(af[m], bfr[n], acc[h][m][n]);
        }
    }
    int rb_ = row0 + wr * 128, cb_ = col0 + wc * 64;
    asm volatile("" : "+s"(rb_), "+s"(cb_));
    epi(acc[0], rb_, cb_, fr, fq);
    epi(acc[1], rb_ + 64, cb_, fr, fq);
}

DEV void pq_scores_tile(const bf16_t* __restrict__ A, int lda, const bf16_t* __restrict__ Bt, int ldb, int K, int row0, int g,
                        const float* __restrict__ ssq2, const bf16_t* __restrict__ keysb, bf16_t* __restrict__ scores, char* smem) {
    int tid = threadIdx.x; asm volatile("" : "+v"(tid));
    const int wid = __builtin_amdgcn_readfirstlane(tid >> 6), lane = tid & 63, wr = wid >> 1, wc = wid & 1, fr = lane & 15, fq = lane >> 4;
    constexpr int ST = 24576;
    const int col0 = g * 128;
    f32x4 acc[2][4][4];
#pragma unroll
    for (int h = 0; h < 2; ++h)
#pragma unroll
        for (int m = 0; m < 4; ++m)
#pragma unroll
            for (int n = 0; n < 4; ++n) acc[h][m][n] = (f32x4){0.f, 0.f, 0.f, 0.f};
    const int b0 = tid * 16, r0 = b0 >> 6, c0 = (b0 & 63) >> 1;
    const bf16_t* ap = A + (size_t)(row0 + r0) * lda + c0;
    const bf16_t* bp = Bt + (size_t)(col0 + r0) * ldb + c0;
    const size_t a64 = (size_t)64 * lda, b64 = (size_t)64 * ldb;
    auto issue = [&](int kt) {
        char* st = smem + (kt % 3) * ST + b0;
        GLDS16(ap + kt * 32, st); GLDS16(ap + a64 + kt * 32, st + 4096);
        GLDS16(ap + 2 * a64 + kt * 32, st + 8192); GLDS16(ap + 3 * a64 + kt * 32, st + 12288);
        GLDS16(bp + kt * 32, st + 16384); GLDS16(bp + b64 + kt * 32, st + 16384 + 4096);
    };
    const int nt = K >> 5;
    asm volatile("s_waitcnt vmcnt(0) lgkmcnt(0)\n\ts_barrier" ::: "memory");
    issue(0);
    if (nt > 1) issue(1);
    for (int t = 0; t < nt; ++t) {
        if (t + 1 < nt) asm volatile("s_waitcnt vmcnt(6)" ::: "memory");
        else asm volatile("s_waitcnt vmcnt(0)" ::: "memory");
        asm volatile("s_barrier" ::: "memory");
        if (t + 2 < nt) issue(t + 2);
        const char* a = smem + (t % 3) * ST; const char* b = a + 16384;
        bf16x8 bfr[4];
#pragma unroll
        for (int n = 0; n < 4; ++n) bfr[n] = *(const bf16x8*)(b + (wc * 64 + n * 16 + fr) * 64 + fq * 16);
#pragma unroll
        for (int h = 0; h < 2; ++h) {
            bf16x8 af[4];
#pragma unroll
            for (int m = 0; m < 4; ++m) af[m] = *(const bf16x8*)(a + (wr * 128 + h * 64 + m * 16 + fr) * 64 + fq * 16);
#pragma unroll
            for (int m = 0; m < 4; ++m)
#pragma unroll
                for (int n = 0; n < 4; ++n) acc[h][m][n] = mfma16(bfr[n], af[m], acc[h][m][n]);
        }
    }
    u32x2 pk[2][4][4];
#pragma unroll
    for (int h = 0; h < 2; ++h)
#pragma unroll
        for (int m = 0; m < 4; ++m) {
            const int row = row0 + wr * 128 + h * 64 + m * 16 + fr;
            const float rs = rsqrtf(ssq2[row] * (1.0f / 1024.0f) + EPS);
#pragma unroll
            for (int n = 0; n < 4; ++n) {
                const f32x4 v = acc[h][m][n] * rs;
                pk[h][m][n].x = cvt_pk_bf16(v[0], v[1]); pk[h][m][n].y = cvt_pk_bf16(v[2], v[3]);
            }
        }
    constexpr int RS2 = 272;
    char* sA2 = smem; char* sKy = smem + 128 * RS2;
    asm volatile("s_waitcnt lgkmcnt(0)\n\ts_barrier" ::: "memory");
    {
        const bf16_t* kg = keysb + (size_t)g * 128 * 128;
#pragma unroll
        for (int i = 0; i < 8; ++i) { const int c = tid + i * 256, key = c >> 4, cc = c & 15; *(u32x4*)(sKy + key * RS2 + cc * 16) = *(const u32x4*)(kg + (size_t)key * 128 + cc * 8); }
    }
#pragma unroll 1
    for (int half = 0; half < 2; ++half) {
        if (wr == half) {
#pragma unroll
            for (int h = 0; h < 2; ++h)
#pragma unroll
                for (int m = 0; m < 4; ++m)
#pragma unroll
                    for (int n = 0; n < 4; ++n)
                        *(u32x2*)(sA2 + (h * 64 + m * 16 + fr) * RS2 + (wc * 64 + n * 16 + fq * 4) * 2) = pk[h][m][n];
        }
        __syncthreads();
        f32x4 acc2[4][4];
#pragma unroll
        for (int m = 0; m < 4; ++m)
#pragma unroll
            for (int n = 0; n < 4; ++n) acc2[m][n] = (f32x4){0.f, 0.f, 0.f, 0.f};
#pragma unroll
        for (int ks = 0; ks < 4; ++ks) {
            bf16x8 af[4], bfr[4];
#pragma unroll
            for (int m = 0; m < 4; ++m) af[m] = *(const bf16x8*)(sA2 + (wr * 64 + m * 16 + fr) * RS2 + ks * 64 + fq * 16);
#pragma unroll
            for (int n = 0; n < 4; ++n) bfr[n] = *(const bf16x8*)(sKy + (wc * 64 + n * 16 + fr) * RS2 + ks * 64 + fq * 16);
#pragma unroll
            for (int m = 0; m < 4; ++m)
#pragma unroll
                for (int n = 0; n < 4; ++n) acc2[m][n] = mfma16(bfr[n], af[m], acc2[m][n]);
        }
#pragma unroll
        for (int m = 0; m < 4; ++m) {
            const int row = row0 + half * 128 + wr * 64 + m * 16 + fr;
#pragma unroll
            for (int n = 0; n < 4; ++n) {
                const f32x4 v = acc2[m][n];
                u32x2 w; w.x = cvt_pk_bf16(v[0], v[1]); w.y = cvt_pk_bf16(v[2], v[3]);
                *(u32x2*)(scores + (size_t)row * 2048 + col0 + wc * 64 + n * 16 + fq * 4) = w;
            }
        }
        __syncthreads();
    }
}

struct PlainA {
    const bf16_t* A; int lda;
    DEV u32x4 operator()(int row, int k) const { return *(const u32x4*)(A + (size_t)row * lda + k); }
};

DEV void tr_tile(const float* __restrict__ src, int ldn, bf16_t* __restrict__ dst, int ldk, int k0, int n0, int drow0,
                 const float* __restrict__ gain, float* tileS) {
    int tid = threadIdx.x; asm volatile("" : "+v"(tid));
    __syncthreads();
#pragma unroll 4
    for (int i = 0; i < 16; ++i) {
        const int kk = i * 4 + (tid >> 6), nn = tid & 63;
        float v = src[(size_t)(k0 + kk) * ldn + n0 + nn];
        if (gain) v *= gain[k0 + kk];
        tileS[kk * 65 + nn] = v;
    }
    __syncthreads();
#pragma unroll 4
    for (int i = 0; i < 16; ++i) {
        const int nn = i * 4 + (tid >> 6), kk = tid & 63;
        const float v = tileS[kk * 65 + nn];
        dst[(size_t)(drow0 + nn) * ldk + k0 + kk] = (bf16_t)(cvt_pk_bf16(v, 0.f) & 0xffffu);
    }
}

template <int DQK, int DV, bool PREF, int QB>
DEV void attn_item(const bf16_t* __restrict__ q, int ldq, const bf16_t* __restrict__ k, int ldk,
                   const bf16_t* __restrict__ vT, int ldv, int ntiles, int tiles_lo, bf16_t* __restrict__ out, int ldo, char* smem) {
    constexpr int KS = DQK / 32, DB = DV / 16;
    constexpr int KSTR = DQK * 2 + 16;
    constexpr int VSTR = 144;
    constexpr int KCH = 64 * DQK / 8 / 256, VCH = DV * 64 / 8 / 256, KCW = DQK / 8;
    char* sK = smem; char* sV = smem + 64 * KSTR;
    int tid = threadIdx.x; asm volatile("" : "+v"(tid));
    const int wid = __builtin_amdgcn_readfirstlane(tid >> 6), lane = tid & 63, fr = lane & 15, fq = lane >> 4;
    const int my_tiles = (wid < 2) ? tiles_lo : ntiles;
    bf16x8 qf[QB][KS];
#pragma unroll
    for (int qi = 0; qi < QB; ++qi) {
        const bf16_t* qrow = q + (size_t)(wid * 16 * QB + qi * 16 + fr) * ldq;
#pragma unroll
        for (int ks = 0; ks < KS; ++ks) qf[qi][ks] = *(const bf16x8*)(qrow + ks * 32 + fq * 8);
    }
    f32x4 o[QB][DB];
    float mrow[QB], lsum[QB];
#pragma unroll
    for (int qi = 0; qi < QB; ++qi) {
        mrow[qi] = -1e30f; lsum[qi] = 0.f;
#pragma unroll
        for (int db = 0; db < DB; ++db) o[qi][db] = (f32x4){0.f, 0.f, 0.f, 0.f};
    }
    constexpr bool PREFV = PREF && (DV <= 128);
    u32x4 kr[PREF ? KCH : 1], vr[PREFV ? VCH : 1];
    if (PREF) {
#pragma unroll
        for (int i = 0; i < KCH; ++i) { const int c = tid + i * 256, key = c / KCW, cc = c % KCW; kr[PREF ? i : 0] = *(const u32x4*)(k + (size_t)key * ldk + cc * 8); }
        if (PREFV) {
#pragma unroll
            for (int i = 0; i < VCH; ++i) { const int c = tid + i * 256, d = c >> 3, cc = c & 7; vr[PREFV ? i : 0] = *(const u32x4*)(vT + (size_t)d * ldv + cc * 8); }
        }
    }
    for (int kt = 0; kt < ntiles; ++kt) {
        __syncthreads();
        {
            const int kn = kt * 64;
            if (PREF) {
#pragma unroll
                for (int i = 0; i < KCH; ++i) { const int c = tid + i * 256, key = c / KCW, cc = c % KCW; *(u32x4*)(sK + key * KSTR + cc * 16) = kr[PREF ? i : 0]; }
            } else {
#pragma unroll 4
                for (int i = 0; i < KCH; ++i) { const int c = tid + i * 256, key = c / KCW, cc = c % KCW; *(u32x4*)(sK + key * KSTR + cc * 16) = *(const u32x4*)(k + (size_t)(kn + key) * ldk + cc * 8); }
            }
            if (PREFV) {
#pragma unroll
                for (int i = 0; i < VCH; ++i) { const int c = tid + i * 256, d = c >> 3, cc = c & 7; *(u32x4*)(sV + d * VSTR + cc * 16) = vr[PREFV ? i : 0]; }
            } else {
#pragma unroll 4
                for (int i = 0; i < VCH; ++i) { const int c = tid + i * 256, d = c >> 3, cc = c & 7; *(u32x4*)(sV + d * VSTR + cc * 16) = *(const u32x4*)(vT + (size_t)d * ldv + kn + cc * 8); }
            }
        }
        __syncthreads();
        if (PREF && kt + 1 < ntiles) {
            const int kn = (kt + 1) * 64;
#pragma unroll
            for (int i = 0; i < KCH; ++i) { const int c = tid + i * 256, key = c / KCW, cc = c % KCW; kr[PREF ? i : 0] = *(const u32x4*)(k + (size_t)(kn + key) * ldk + cc * 8); }
            if (PREFV) {
#pragma unroll
                for (int i = 0; i < VCH; ++i) { const int c = tid + i * 256, d = c >> 3, cc = c & 7; vr[PREFV ? i : 0] = *(const u32x4*)(vT + (size_t)d * ldv + kn + cc * 8); }
            }
        }
        if (kt < my_tiles) {
            f32x4 s[QB][4];
#pragma unroll
            for (int kb = 0; kb < 4; ++kb) {
#pragma unroll
                for (int qi = 0; qi < QB; ++qi) s[qi][kb] = (f32x4){0.f, 0.f, 0.f, 0.f};
#pragma unroll
                for (int ks = 0; ks < KS; ++ks) {
                    const bf16x8 kf = *(const bf16x8*)(sK + (kb * 16 + fr) * KSTR + ks * 64 + fq * 16);
#pragma unroll
                    for (int qi = 0; qi < QB; ++qi) s[qi][kb] = mfma16(kf, qf[qi][ks], s[qi][kb]);
                }
            }
            bf16x8 pf[QB][2];
#pragma unroll
            for (int qi = 0; qi < QB; ++qi) {
                float mx = -1e30f;
#pragma unroll
                for (int kb = 0; kb < 4; ++kb)
#pragma unroll
                    for (int j = 0; j < 4; ++j) mx = fmaxf(mx, s[qi][kb][j]);
                mx = fmaxf(mx, __shfl_xor(mx, 16)); mx = fmaxf(mx, __shfl_xor(mx, 32));
                const float mnew = fmaxf(mrow[qi], mx);
                const float alpha = __builtin_amdgcn_exp2f(mrow[qi] - mnew);
                mrow[qi] = mnew;
                float ps = 0.f;
#pragma unroll
                for (int kb = 0; kb < 4; ++kb)
#pragma unroll
                    for (int j = 0; j < 4; ++j) { const float e = __builtin_amdgcn_exp2f(s[qi][kb][j] - mnew); s[qi][kb][j] = e; ps += e; }
                lsum[qi] = lsum[qi] * alpha + ps;
#pragma unroll
                for (int db = 0; db < DB; ++db) o[qi][db] *= alpha;
#pragma unroll
                for (int g = 0; g < 2; ++g) {
                    u32x4 w;
                    w.x = cvt_pk_bf16(s[qi][2 * g][0], s[qi][2 * g][1]); w.y = cvt_pk_bf16(s[qi][2 * g][2], s[qi][2 * g][3]);
                    w.z = cvt_pk_bf16(s[qi][2 * g + 1][0], s[qi][2 * g + 1][1]); w.w = cvt_pk_bf16(s[qi][2 * g + 1][2], s[qi][2 * g + 1][3]);
                    pf[qi][g] = as_bf16x8(w);
                }
            }
#pragma unroll
            for (int db = 0; db < DB; ++db) {
#pragma unroll
                for (int g = 0; g < 2; ++g) {
                    const u32x2 v0 = *(const u32x2*)(sV + (db * 16 + fr) * VSTR + ((2 * g) * 16 + fq * 4) * 2);
                    const u32x2 v1 = *(const u32x2*)(sV + (db * 16 + fr) * VSTR + ((2 * g + 1) * 16 + fq * 4) * 2);
                    u32x4 w; w.x = v0.x; w.y = v0.y; w.z = v1.x; w.w = v1.y;
#pragma unroll
                    for (int qi = 0; qi < QB; ++qi) o[qi][db] = mfma16(as_bf16x8(w), pf[qi][g], o[qi][db]);
                }
            }
        }
    }
#pragma unroll
    for (int qi = 0; qi < QB; ++qi) {
        float l = lsum[qi];
        l += __shfl_xor(l, 16); l += __shfl_xor(l, 32);
        const float inv = 1.0f / l;
        bf16_t* orow = out + (size_t)(wid * 16 * QB + qi * 16 + fr) * ldo + fq * 4;
#pragma unroll
        for (int db = 0; db < DB; ++db) {
            u32x2 w; w.x = cvt_pk_bf16(o[qi][db][0] * inv, o[qi][db][1] * inv); w.y = cvt_pk_bf16(o[qi][db][2] * inv, o[qi][db][3] * inv);
            *(u32x2*)(orow + db * 16) = w;
        }
    }
}

#define XB_TMO      128
#define XB_XCNT(j)  (256  + 64 * (j))
#define XB_XSUB(j)  (1280 + 64 * (j))
#define XB_XGEN(j)  (2304 + 64 * (j))
#define XB_TOP      3328
#define XB_TOPGEN   3392
#define XCD_BAR_WORDS 3456
#define XB_SPIN_CAP (1u << 18)
#define LAS __attribute__((address_space(3)))
DEV unsigned xb_ld(unsigned* p)              { return __hip_atomic_load(p, __ATOMIC_RELAXED, __HIP_MEMORY_SCOPE_AGENT); }
DEV unsigned xb_add(unsigned* p, unsigned v) { return __hip_atomic_fetch_add(p, v, __ATOMIC_RELAXED, __HIP_MEMORY_SCOPE_AGENT); }
DEV unsigned xb_xcc_id() { return (unsigned)__builtin_amdgcn_s_getreg((3 << 11) | 20) & 0xFu; }
#define XB_SPIN(cond, bar) do { unsigned _sp = 0; while (cond) { __builtin_amdgcn_s_sleep(1); \
    if ((++_sp & 255u) == 0u) { if (xb_ld(&(bar)[XB_TMO])) break; if (_sp > XB_SPIN_CAP) { atomicAdd(&(bar)[XB_TMO], 1u); break; } } } } while (0)
struct XcdBarrier { unsigned* bar; unsigned x; volatile LAS unsigned* st; };
DEV XcdBarrier xcd_barrier_post(unsigned* bar, volatile LAS unsigned* st) {
    XcdBarrier b; b.bar = bar; b.x = xb_xcc_id(); b.st = st;
    if (threadIdx.x == 0) (void)xb_add(&bar[XB_XCNT(b.x)], 1u);
    return b;
}
DEV void xcd_barrier_complete(unsigned* bar, unsigned x, unsigned& nloc, unsigned& nx) {
    const unsigned G = gridDim.x * gridDim.y * gridDim.z;
    unsigned sum, cnt, mine, sp = 0u;
    for (;;) {
        sum = 0u; cnt = 0u; mine = 0u;
#pragma unroll
        for (unsigned j = 0; j < 16; ++j) { const unsigned c = xb_ld(&bar[XB_XCNT(j)]); sum += c; cnt += (c > 0u) ? 1u : 0u; mine = (j == x) ? c : mine; }
        if (sum == G) break;
        __builtin_amdgcn_s_sleep(1);
        if ((++sp & 255u) == 0u) { if (xb_ld(&bar[XB_TMO])) break; if (sp > XB_SPIN_CAP) { atomicAdd(&bar[XB_TMO], 1u); break; } }
    }
    nloc = mine > 0u ? mine : 1u; nx = cnt > 0u ? cnt : 1u;
}
DEV void xcd_barrier(const XcdBarrier& b) {
    asm volatile("s_waitcnt vmcnt(0)" ::: "memory");
    __syncthreads();
    if (threadIdx.x == 0) {
        unsigned* bar = b.bar;
        __builtin_amdgcn_s_waitcnt(0);
        unsigned nloc = b.st[0], nx = b.st[1];
        if (nloc == 0u) { xcd_barrier_complete(bar, b.x, nloc, nx); b.st[0] = nloc; b.st[1] = nx; }
        const unsigned old = xb_add(&bar[XB_XSUB(b.x)], 1u);
        const unsigned gen = old / nloc;
        if (old + 1u == (gen + 1u) * nloc) {
            __builtin_amdgcn_fence(__ATOMIC_RELEASE, "agent");
            asm volatile("s_waitcnt vmcnt(0)" ::: "memory");
            const unsigned og = xb_add(&bar[XB_TOP], 1u);
            const unsigned tg = og / nx;
            if (og + 1u == (tg + 1u) * nx) xb_add(&bar[XB_TOPGEN], 1u);
            else XB_SPIN(xb_ld(&bar[XB_TOPGEN]) == tg, bar);
            __builtin_amdgcn_fence(__ATOMIC_ACQUIRE, "agent");
            xb_add(&bar[XB_XGEN(b.x)], 1u);
            asm volatile("s_waitcnt vmcnt(0)" ::: "memory");
        } else {
            XB_SPIN(xb_ld(&bar[XB_XGEN(b.x)]) == gen, bar);
            __builtin_amdgcn_fence(__ATOMIC_ACQUIRE, "agent");
            asm volatile("s_waitcnt vmcnt(0)" ::: "memory");
        }
    }
    __syncthreads();
}

DEV unsigned ordkey(float f) { const unsigned u = __float_as_uint(f); return (u & 0x80000000u) ? ~u : (u | 0x80000000u); }
DEV float unordkey(unsigned k) { const unsigned u = (k & 0x80000000u) ? (k & 0x7fffffffu) : ~k; return __uint_as_float(u); }
#define TOPK_INSERT(L, xk) { unsigned x_ = (xk); _Pragma("unroll") for (int s_ = 0; s_ < 16; ++s_) { const unsigned hi_ = max(L[s_], x_); x_ = min(L[s_], x_); L[s_] = hi_; } }
DEV unsigned byte_lookup(unsigned p0, unsigned p1, unsigned p2, unsigned p3, int a) {
    const unsigned w = (a < 8) ? ((a < 4) ? p0 : p1) : ((a < 12) ? p2 : p3);
    return (w >> ((a & 3) * 8)) & 0xffu;
}

DEV void grid_barrier(unsigned* bar, unsigned nblocks, unsigned& gen) {
    __threadfence();
    __syncthreads();
    gen += 1;
    if (threadIdx.x == 0) {
        const unsigned target = gen * nblocks;
        __hip_atomic_fetch_add(bar, 1u, __ATOMIC_RELEASE, __HIP_MEMORY_SCOPE_AGENT);
        while (__hip_atomic_load(bar, __ATOMIC_ACQUIRE, __HIP_MEMORY_SCOPE_AGENT) < target) __builtin_amdgcn_s_sleep(2);
    }
    __syncthreads();
    __threadfence();
}
#ifdef TIMED_MASK
#define GRID_SYNC() do { xcd_barrier(xb); { const long long tn_ = (long long)__builtin_amdgcn_s_memrealtime(); if ((TIMED_MASK >> ph_idx) & 1) t_acc += tn_ - t_last; t_last = tn_; ph_idx++; } } while (0)
#else
#define GRID_SYNC() xcd_barrier(xb)
#endif
#ifndef PH
#define PH 0x0FFF
#endif
constexpr int SMEM_BYTES = 4 * 128 * 144;

__global__ void __launch_bounds__(256, 2) fwd_megakernel(Params P) {
    cg::grid_group grid = cg::this_grid();
    __shared__ __attribute__((aligned(16))) char smem[SMEM_BYTES];
    __shared__ int s_item;
    const int nb = gridDim.x, bid = blockIdx.x;
    const int gsz = nb * 256;
    __shared__ uint4 xb_words;
    if (threadIdx.x == 0) xb_words = make_uint4(0u, 0u, 0u, 0u);
    __syncthreads();
    if (P.ws == nullptr) grid.sync();
    XcdBarrier xb = xcd_barrier_post((unsigned*)(P.ws + O_XBAR), (volatile LAS unsigned*)&xb_words);
#ifdef TIMED_MASK
    long long t_acc = 0, t_last = (long long)__builtin_amdgcn_s_memrealtime(); int ph_idx = 0;
#endif
#define XCD_TILE_LOOP(NM, NN, tm, tn) \
    for (int q_ = (bid % (nb >> 3)), R_ = (NM) >> 3, tm, tn; q_ < R_ * (NN) && ((tn = q_ / R_), (tm = (bid / (nb >> 3)) * R_ + q_ % R_), true); q_ += (nb >> 3))
#define PHASE_IDS int tid = threadIdx.x; asm volatile("" : "+v"(tid)); const int wid = __builtin_amdgcn_readfirstlane(tid >> 6), lane = tid & 63; const int gtid = bid * 256 + tid; (void)wid; (void)lane; (void)gtid;
    char* ws = P.ws;
    float* ssq0 = (float*)(ws + O_SSQ);
    float* ssqm = (float*)(ws + O_SSQ + 65536);
    float* ssqq = (float*)(ws + O_SSQ + 2 * 65536);
    float* ssqkv = (float*)(ws + O_SSQ + 3 * 65536);
    float* ssq1 = (float*)(ws + O_SSQ + 4 * 65536);
    float* ssq2 = (float*)(ws + O_SSQ + 5 * 65536);
    int* counters = (int*)(ws + O_CNT);
    float2* ropetab = (float2*)(ws + O_ROPE);
    bf16_t* p = (bf16_t*)(ws + O_P);
    bf16_t* qmla = (bf16_t*)P.out;
    bf16_t* kfull = (bf16_t*)((char*)P.out + 24 * MB);
    bf16_t* vTm = (bf16_t*)((char*)P.out + 48 * MB);

    auto do_tr = [&](int tile) {
        float* tileS = (float*)smem;

            const float* src; int ldn; bf16_t* dst; int ldk; int KT; int loc; const float* gain = nullptr; int drow_add = 0;
            bool ukv = false;
            if (tile < 560) { loc = tile; src = P.w_in; ldn = 2240; dst = (bf16_t*)(ws + O_WINT); ldk = 1024; KT = 16; gain = P.norm_mix_g; }
            else if (tile < 608) { loc = tile - 560; src = P.w_uq; ldn = 768; dst = (bf16_t*)(ws + O_WUQT); ldk = 256; KT = 4; gain = P.q_norm_g; }
            else if (tile < 640) { loc = tile - 608; src = P.w_ukv; ldn = 1024; dst = (bf16_t*)(ws + O_WUKT); ldk = 128; KT = 2; gain = P.kv_norm_g; ukv = true; }
            else if (tile < 648) { loc = tile - 640; src = P.rw_w_up; ldn = 512; dst = (bf16_t*)(ws + O_WUPT); ldk = 64; KT = 1; }
            else if (tile < 656) { loc = tile - 648; src = P.rw_a_up; ldn = 512; dst = (bf16_t*)(ws + O_AUPT); ldk = 64; KT = 1; }
            else if (tile < 672) { loc = tile - 656; src = P.rw_g_up; ldn = 512; dst = (bf16_t*)(ws + O_GUPT); ldk = 128; KT = 2; }
            else if (tile < 928) { loc = tile - 672; src = P.w_out; ldn = 1024; dst = (bf16_t*)(ws + O_WOUTT); ldk = 1024; KT = 16; }
            else if (tile < 1184) { loc = tile - 928; src = P.xa_wq; ldn = 1024; dst = (bf16_t*)(ws + O_XAQT); ldk = 1024; KT = 16; gain = P.norm_xa_g; }
            else if (tile < 1440) { loc = tile - 1184; src = P.xa_wk; ldn = 1024; dst = (bf16_t*)(ws + O_XAKVT); ldk = 1024; KT = 16; gain = P.norm_mem_g; }
            else if (tile < 1696) { loc = tile - 1440; src = P.xa_wv; ldn = 1024; dst = (bf16_t*)(ws + O_XAKVT); ldk = 1024; KT = 16; gain = P.norm_mem_g; drow_add = 1024; }
            else if (tile < 1952) { loc = tile - 1696; src = P.xa_wo; ldn = 1024; dst = (bf16_t*)(ws + O_XAOT); ldk = 1024; KT = 16; }
            else { loc = tile - 1952; src = P.peer_wq; ldn = 2048; dst = (bf16_t*)(ws + O_PWQT); ldk = 1024; KT = 16; gain = P.norm_ffn_g; }
            const int kt = loc % KT, ntile = loc / KT;
            int n0 = ntile * 64, drow0 = n0 + drow_add;
            if (ukv) {
                const int h = n0 >> 8, part = (n0 >> 7) & 1, d0 = n0 & 127;
                if (part) dst = (bf16_t*)(ws + O_WUVT);
                drow0 = h * 128 + d0;
            }
            tr_tile(src, ldn, dst, ldk, kt * 64, n0, drow0, gain, tileS);
            };
    auto convert_experts = [&](int r0, int r1, int wid, int lane) {
        unsigned char* e8u = (unsigned char*)(ws + O_EUB);
        unsigned char* e8v = (unsigned char*)(ws + O_EVB);
        float* esinv = (float*)(ws + O_SSQ + 6 * 65536);
        for (int r = r0 + wid; r < r1; r += 4) {
            const float* src = (r < 16384) ? (P.expert_u + (size_t)r * 1024) : (P.expert_v + (size_t)(r - 16384) * 1024);
            unsigned char* dst = (r < 16384) ? (e8u + (size_t)r * 1024) : (e8v + (size_t)(r - 16384) * 1024);
            f32x4 v[4]; float amax = 0.f;
#pragma unroll
            for (int i = 0; i < 4; ++i) {
                v[i] = *(const f32x4*)(src + i * 256 + lane * 4);
                amax = fmaxf(amax, fmaxf(fmaxf(fabsf(v[i][0]), fabsf(v[i][1])), fmaxf(fabsf(v[i][2]), fabsf(v[i][3]))));
            }
#pragma unroll
            for (int o = 32; o >= 1; o >>= 1) amax = fmaxf(amax, __shfl_xor(amax, o));
            amax = fmaxf(amax, 1e-30f);
            const float sc = 240.0f / amax;
#pragma unroll
            for (int i = 0; i < 4; ++i) {
                int w = 0;
                w = __builtin_amdgcn_cvt_pk_fp8_f32(v[i][0] * sc, v[i][1] * sc, w, false);
                w = __builtin_amdgcn_cvt_pk_fp8_f32(v[i][2] * sc, v[i][3] * sc, w, true);
                *(int*)(dst + i * 256 + lane * 4) = w;
            }
            if (lane == 0) esinv[r] = amax * (1.0f / 240.0f);
        }
    };
    if (PH & (1 << 0)) {
        PHASE_IDS
        for (int tile = bid; tile < 672 + 512; tile += nb) do_tr(tile < 672 ? tile : tile + 512);
        bf16_t* xb = (bf16_t*)(ws + O_XB);
        bf16_t* memb = (bf16_t*)(ws + O_MEMB);
        for (int r = bid * 4 + wid; r < T + 2048; r += nb * 4) {
            const float* srow = (r < T) ? (P.x + (size_t)r * 1024) : (P.mem + (size_t)(r - T) * 1024);
            bf16_t* drow = (r < T) ? (xb + (size_t)r * 1024) : (memb + (size_t)(r - T) * 1024);
            float ss = 0.f;
#pragma unroll
            for (int i = 0; i < 4; ++i) {
                const f32x4 v = *(const f32x4*)(srow + i * 256 + lane * 4);
                ss += v[0] * v[0] + v[1] * v[1] + v[2] * v[2] + v[3] * v[3];
                u32x2 w; w.x = cvt_pk_bf16(v[0], v[1]); w.y = cvt_pk_bf16(v[2], v[3]);
                *(u32x2*)(drow + i * 256 + lane * 4) = w;
            }
            ss = wave_sum(ss);
            if (lane == 0) { if (r < T) ssq0[r] = ss; else ssqm[r - T] = ss; }
        }
        for (int i = gtid; i < T * 32; i += gsz) {
            const int row = i >> 5, f = i & 31;
            const float inv = exp2f(-(float)f * (13.287712379549449f / 32.0f));
            const float ang = (float)P.pos[row] * inv;
            ropetab[i] = make_float2(cosf(ang), sinf(ang));
        }
        for (int i = gtid; i < T; i += gsz) { ssqq[i] = 0.f; ssqkv[i] = 0.f; ssq1[i] = 0.f; ssq2[i] = 0.f; }
        if (gtid < 64) counters[gtid] = 0;
        {
            bf16_t* keysb = (bf16_t*)(ws + O_KEYS);
            for (int i = gtid; i < 16 * 128 * 128 / 4; i += gsz) {
                const f32x4 v = *(const f32x4*)(P.peer_keys + (size_t)i * 4);
                u32x2 w; w.x = cvt_pk_bf16(v[0], v[1]); w.y = cvt_pk_bf16(v[2], v[3]);
                *(u32x2*)(keysb + (size_t)i * 4) = w;
            }
        }
        {
            u32x4* z = (u32x4*)(ws + O_WINT + (size_t)2240 * 1024 * 2);
            for (int i = gtid; i < 64 * 1024 * 2 / 16; i += gsz) z[i] = (u32x4){0u, 0u, 0u, 0u};
        }
    }
    GRID_SYNC();

    if (PH & (1 << 1)) {
        PHASE_IDS
        const bf16_t* xb = (const bf16_t*)(ws + O_XB);
        const bf16_t* memb = (const bf16_t*)(ws + O_MEMB);
        const bf16_t* winT = (const bf16_t*)(ws + O_WINT);
        const bf16_t* xakvT = (const bf16_t*)(ws + O_XAKVT);
        bf16_t* km = (bf16_t*)(ws + O_KM);
        bf16_t* vmT = (bf16_t*)(ws + O_VMT);
        auto p_epi = [&](const f32x4 (&acc)[4][4], int rbase, int cbase, int fr, int fq) {
#pragma unroll
                        for (int m = 0; m < 4; ++m) {
                            const int row = rbase + m * 16 + fr;
                            const float rs = rsqrtf(ssq0[row] * (1.0f / 1024.0f) + EPS);
                            float ss = 0.f;
#pragma unroll
                            for (int n = 0; n < 4; ++n) {
                                const f32x4 v = acc[m][n] * rs;
                                ss += v[0] * v[0] + v[1] * v[1] + v[2] * v[2] + v[3] * v[3];
                                u32x2 w; w.x = cvt_pk_bf16(v[0], v[1]); w.y = cvt_pk_bf16(v[2], v[3]);
                                *(u32x2*)(p + (size_t)row * 2304 + cbase + n * 16 + fq * 4) = w;
                            }
                            if (cbase < 384) {
                                ss += __shfl_xor(ss, 16); ss += __shfl_xor(ss, 32);
                                if (fq == 0) atomicAdd((cbase < 256) ? &ssqq[row] : &ssqkv[row], ss);
                            }
                        }
                    };
        XCD_TILE_LOOP(64, 16, tm, tn) { gemm_tile_big<true>(xb, 1024, winT, 1024, 1024, tm * 256, tn * 128, smem, p_epi); }
        for (int item = bid; item < 256; item += nb) { const int tm = item >> 1, tn = 16 + (item & 1); gemm_tile_glds<true>(xb, 1024, winT, 1024, 1024, tm * 128, tn * 128, smem, p_epi); }
    }
    GRID_SYNC();

    if (PH & (1 << 2)) {
        PHASE_IDS
        const bf16_t* wuqT = (const bf16_t*)(ws + O_WUQT);
        const bf16_t* wukT = (const bf16_t*)(ws + O_WUKT);
        const bf16_t* wuvT = (const bf16_t*)(ws + O_WUVT);
        const bf16_t* wupT = (const bf16_t*)(ws + O_WUPT);
        const bf16_t* aupT = (const bf16_t*)(ws + O_AUPT);
        const bf16_t* gupT = (const bf16_t*)(ws + O_GUPT);
        bf16_t* gbuf = (bf16_t*)(ws + O_G);
        bf16_t* rwr = (bf16_t*)(ws + O_RW_R);
        bf16_t* rwk = (bf16_t*)(ws + O_RW_K);
        bf16_t* rwv = (bf16_t*)(ws + O_RW_V);
        bf16_t* rwkk = (bf16_t*)(ws + O_RW_KK);
        bf16_t* rwka = (bf16_t*)(ws + O_RW_KA);
        float* decay = (float*)(ws + O_DECAY);
        const float QSCALE = 0.07216878364870322f * 1.4426950408889634f;
        const int N0 = 64 * 6, N1 = N0 + 256, N2 = N1 + 256, N3 = N2 + 512, N4 = N3 + 512, N5 = N4 + 512;
        auto shifted8 = [&](int row, int pc, int j0, float (&o)[8]) {
            const u32x4 cur = *(const u32x4*)(p + (size_t)row * 2304 + pc);
            u32x4 prv = (u32x4){0u, 0u, 0u, 0u};
            if (row & 2047) prv = *(const u32x4*)(p + (size_t)(row - 1) * 2304 + pc);
            const f32x4 m0 = *(const f32x4*)(P.shift_mu + j0), m1 = *(const f32x4*)(P.shift_mu + j0 + 4);
            const unsigned cu[4] = {cur.x, cur.y, cur.z, cur.w}, pu[4] = {prv.x, prv.y, prv.z, prv.w};
#pragma unroll
            for (int i = 0; i < 4; ++i) {
                const float c0 = bf_lo(cu[i]), c1 = bf_hi(cu[i]), p0 = bf_lo(pu[i]), p1 = bf_hi(pu[i]);
                const float mu0 = (i < 2) ? m0[2 * i] : m1[2 * i - 4], mu1 = (i < 2) ? m0[2 * i + 1] : m1[2 * i - 3];
                o[2 * i] = c0 + (p0 - c0) * mu0; o[2 * i + 1] = c1 + (p1 - c1) * mu1;
            }
        };
        auto shifted4 = [&](int row, int pc, int j0, f32x4& o) {
            const u32x2 cur = *(const u32x2*)(p + (size_t)row * 2304 + pc);
            u32x2 prv = (u32x2){0u, 0u};
            if (row & 2047) prv = *(const u32x2*)(p + (size_t)(row - 1) * 2304 + pc);
            const f32x4 mu = *(const f32x4*)(P.shift_mu + j0);
            const float c0 = bf_lo(cur.x), c1 = bf_hi(cur.x), c2 = bf_lo(cur.y), c3 = bf_hi(cur.y);
            const float p0 = bf_lo(prv.x), p1 = bf_hi(prv.x), p2 = bf_lo(prv.y), p3 = bf_hi(prv.y);
            o[0] = c0 + (p0 - c0) * mu[0]; o[1] = c1 + (p1 - c1) * mu[1]; o[2] = c2 + (p2 - c2) * mu[2]; o[3] = c3 + (p3 - c3) * mu[3];
        };
        for (;;) {
            __syncthreads();
            if (tid == 0) s_item = atomicAdd(&counters[1], 1);
            __syncthreads();
            const int item = s_item;
            if (item >= N5) break;
            if (item < N0) {
                const int tm = item / 6, tn = item % 6;
                gemm_tile_big<true>(p, 2304, wuqT, 256, 256, tm * 256, tn * 128, smem,
                    [&](const f32x4 (&acc)[4][4], int rbase, int cbase, int fr, int fq) {
                        const bool rope = (cbase % 192) == 128;
#pragma unroll
                        for (int m = 0; m < 4; ++m) {
                            const int row = rbase + m * 16 + fr;
                            const float rs = rsqrtf(ssqq[row] * (1.0f / 256.0f) + EPS) * QSCALE;
                            f32x4 v[4];
#pragma unroll
                            for (int n = 0; n < 4; ++n) v[n] = acc[m][n] * rs;
                            if (rope) {
#pragma unroll
                                for (int n = 0; n < 2; ++n)
#pragma unroll
                                    for (int j = 0; j < 4; ++j) {
                                        const float2 cs = ropetab[row * 32 + n * 16 + fq * 4 + j];
                                        const float t1 = v[n][j], t2 = v[n + 2][j];
                                        v[n][j] = t1 * cs.x - t2 * cs.y; v[n + 2][j] = t1 * cs.y + t2 * cs.x;
                                    }
                            }
#pragma unroll
                            for (int n = 0; n < 4; ++n) {
                                u32x2 w; w.x = cvt_pk_bf16(v[n][0], v[n][1]); w.y = cvt_pk_bf16(v[n][2], v[n][3]);
                                *(u32x2*)(qmla + (size_t)row * 768 + cbase + n * 16 + fq * 4) = w;
                            }
                        }
                    });
            } else if (item < N1) {
                const int it = item - N0, tm = it >> 2, tn = it & 3;
                gemm_tile_big<true>(p + 256, 2304, wukT, 128, 128, tm * 256, tn * 128, smem,
                    [&](const f32x4 (&acc)[4][4], int rbase, int cbase, int fr, int fq) {
#pragma unroll
                        for (int m = 0; m < 4; ++m) {
                            const int row = rbase + m * 16 + fr;
                            const float rs = rsqrtf(ssqkv[row] * (1.0f / 128.0f) + EPS);
#pragma unroll
                            for (int n = 0; n < 4; ++n) {
                                const int col = cbase + n * 16 + fq * 4, h = col >> 7, d = col & 127;
                                const f32x4 v = acc[m][n] * rs;
                                u32x2 w; w.x = cvt_pk_bf16(v[0], v[1]); w.y = cvt_pk_bf16(v[2], v[3]);
                                *(u32x2*)(kfull + (size_t)row * 768 + h * 192 + d) = w;
                            }
                        }
                    });
            } else if (item < N2) {
                const int it = item - N1, tm = it >> 2, tn = it & 3;
                gemm_tile_big<false>(p + 256, 2304, wuvT, 128, 128, tm * 256, tn * 128, smem,
                    [&](const f32x4 (&acc)[4][4], int rbase, int cbase, int fr, int fq) {
#pragma unroll
                        for (int m = 0; m < 4; ++m) {
                            const int row = rbase + m * 16 + fq * 4;
                            const f32x4 sq = *(const f32x4*)(ssqkv + row);
                            f32x4 rs;
#pragma unroll
                            for (int j = 0; j < 4; ++j) rs[j] = rsqrtf(sq[j] * (1.0f / 128.0f) + EPS);
                            const int b = row >> 11, s = row & 2047;
#pragma unroll
                            for (int n = 0; n < 4; ++n) {
                                const int col = cbase + n * 16 + fr;
                                const f32x4 v = acc[m][n] * rs;
                                u32x2 w; w.x = cvt_pk_bf16(v[0], v[1]); w.y = cvt_pk_bf16(v[2], v[3]);
                                *(u32x2*)(vTm + ((size_t)(b * 512 + col)) * 2048 + s) = w;
                            }
                        }
                    });
            } else if (item < N3) {
                const int it = item - N2, tm = it >> 2, tn = it & 3;
                auto al = [&](int row, int k) -> u32x4 {
                    float o[8]; shifted8(row, 1984 + k, 1536 + k, o);
                    u32x4 w;
                    w.x = cvt_pk_bf16(tanhf(o[0]), tanhf(o[1])); w.y = cvt_pk_bf16(tanhf(o[2]), tanhf(o[3]));
                    w.z = cvt_pk_bf16(tanhf(o[4]), tanhf(o[5])); w.w = cvt_pk_bf16(tanhf(o[6]), tanhf(o[7]));
                    return w;
                };
                gemm_tile<true>(al, wupT, 64, 64, tm * 128, tn * 128, smem,
                    [&](const f32x4 (&acc)[4][4], int rbase, int cbase, int fr, int fq) {
#pragma unroll
                        for (int m = 0; m < 4; ++m) {
                            const int row = rbase + m * 16 + fr;
#pragma unroll
                            for (int n = 0; n < 4; ++n) {
                                const int col = cbase + n * 16 + fq * 4;
                                const f32x4 w0 = *(const f32x4*)(P.rw_w0 + col);
                                f32x4 dv;
#pragma unroll
                                for (int j = 0; j < 4; ++j) {
                                    const float wp = w0[j] + acc[m][n][j];
                                    const float z = -wp;
                                    const float sp = fmaxf(z, 0.f) + log1pf(__expf(-fabsf(z)));
                                    dv[j] = __expf(-__expf(-sp - 0.5f));
                                }
                                *(f32x4*)(decay + (size_t)row * 512 + col) = dv;
                            }
                        }
                    });
            } else if (item < N4) {
                const int it = item - N3, tm = it >> 2, tn = it & 3;
                auto al = [&](int row, int k) -> u32x4 {
                    float o[8]; shifted8(row, 2048 + k, 1600 + k, o);
                    u32x4 w;
                    w.x = cvt_pk_bf16(o[0], o[1]); w.y = cvt_pk_bf16(o[2], o[3]); w.z = cvt_pk_bf16(o[4], o[5]); w.w = cvt_pk_bf16(o[6], o[7]);
                    return w;
                };
                gemm_tile<true>(al, aupT, 64, 64, tm * 128, tn * 128, smem,
                    [&](const f32x4 (&acc)[4][4], int rbase, int cbase, int fr, int fq) {
#pragma unroll
                        for (int m = 0; m < 4; ++m) {
                            const int row = rbase + m * 16 + fr;
                            f32x4 kv[4], kkr[4], av[4];
                            float ss = 0.f;
#pragma unroll
                            for (int n = 0; n < 4; ++n) {
                                const int col = cbase + n * 16 + fq * 4;
                                shifted4(row, 960 + col, 512 + col, kv[n]);
                                const f32x4 kkw = *(const f32x4*)(P.rw_k_k + col);
                                const f32x4 a0 = *(const f32x4*)(P.rw_a0 + col);
#pragma unroll
                                for (int j = 0; j < 4; ++j) {
                                    kkr[n][j] = kv[n][j] * kkw[j]; ss += kkr[n][j] * kkr[n][j];
                                    av[n][j] = sigmoidf_(a0[j] + acc[m][n][j]);
                                }
                            }
                            ss += __shfl_xor(ss, 16); ss += __shfl_xor(ss, 32);
                            const float inv = 1.0f / fmaxf(sqrtf(ss), 1e-12f);
#pragma unroll
                            for (int n = 0; n < 4; ++n) {
                                const int col = cbase + n * 16 + fq * 4;
                                const f32x4 ka = *(const f32x4*)(P.rw_k_a + col);
                                f32x4 rv, vv, kk, k2, kka;
                                shifted4(row, 448 + col, col, rv);
                                shifted4(row, 1472 + col, 1024 + col, vv);
#pragma unroll
                                for (int j = 0; j < 4; ++j) {
                                    kk[j] = kkr[n][j] * inv;
                                    k2[j] = kv[n][j] * (1.0f + (av[n][j] - 1.0f) * ka[j]);
                                    kka[j] = kk[j] * av[n][j];
                                }
                                const size_t o = (size_t)row * 512 + col;
                                u32x2 w;
                                w.x = cvt_pk_bf16(rv[0], rv[1]); w.y = cvt_pk_bf16(rv[2], rv[3]); *(u32x2*)(rwr + o) = w;
                                w.x = cvt_pk_bf16(k2[0], k2[1]); w.y = cvt_pk_bf16(k2[2], k2[3]); *(u32x2*)(rwk + o) = w;
                                w.x = cvt_pk_bf16(vv[0], vv[1]); w.y = cvt_pk_bf16(vv[2], vv[3]); *(u32x2*)(rwv + o) = w;
                                w.x = cvt_pk_bf16(kk[0], kk[1]); w.y = cvt_pk_bf16(kk[2], kk[3]); *(u32x2*)(rwkk + o) = w;
                                w.x = cvt_pk_bf16(kka[0], kka[1]); w.y = cvt_pk_bf16(kka[2], kka[3]); *(u32x2*)(rwka + o) = w;
                            }
                        }
                    });
            } else {
                const int it = item - N4, tm = it >> 2, tn = it & 3;
                auto al = [&](int row, int k) -> u32x4 {
                    float o[8]; shifted8(row, 2112 + k, 1664 + k, o);
                    u32x4 w;
                    w.x = cvt_pk_bf16(sigmoidf_(o[0]), sigmoidf_(o[1])); w.y = cvt_pk_bf16(sigmoidf_(o[2]), sigmoidf_(o[3]));
                    w.z = cvt_pk_bf16(sigmoidf_(o[4]), sigmoidf_(o[5])); w.w = cvt_pk_bf16(sigmoidf_(o[6]), sigmoidf_(o[7]));
                    return w;
                };
                gemm_tile<true>(al, gupT, 128, 128, tm * 128, tn * 128, smem,
                    [&](const f32x4 (&acc)[4][4], int rbase, int cbase, int fr, int fq) {
#pragma unroll
                        for (int m = 0; m < 4; ++m) {
                            const int row = rbase + m * 16 + fr;
#pragma unroll
                            for (int n = 0; n < 4; ++n) {
                                const f32x4 v = acc[m][n];
                                u32x2 w; w.x = cvt_pk_bf16(v[0], v[1]); w.y = cvt_pk_bf16(v[2], v[3]);
                                *(u32x2*)(gbuf + (size_t)row * 512 + cbase + n * 16 + fq * 4) = w;
                            }
                        }
                    });
            }
        }
        for (int i = gtid; i < T * 32; i += gsz) {
            const int row = i >> 5, f = i & 31;
            const float t1 = __uint_as_float((unsigned)p[(size_t)row * 2304 + 384 + f] << 16);
            const float t2 = __uint_as_float((unsigned)p[(size_t)row * 2304 + 416 + f] << 16);
            const float2 cs = ropetab[i];
            const bf16_t o1 = (bf16_t)(cvt_pk_bf16(t1 * cs.x - t2 * cs.y, 0.f) & 0xffffu);
            const bf16_t o2 = (bf16_t)(cvt_pk_bf16(t1 * cs.y + t2 * cs.x, 0.f) & 0xffffu);
#pragma unroll
            for (int h = 0; h < 4; ++h) { kfull[(size_t)row * 768 + h * 192 + 128 + f] = o1; kfull[(size_t)row * 768 + h * 192 + 160 + f] = o2; }
        }
    }
    GRID_SYNC();

    if (PH & (1 << 3)) {
        PHASE_IDS
        const bf16_t* rwr = (const bf16_t*)(ws + O_RW_R);
        const bf16_t* rwk = (const bf16_t*)(ws + O_RW_K);
        const bf16_t* rwv = (const bf16_t*)(ws + O_RW_V);
        const bf16_t* rwkk = (const bf16_t*)(ws + O_RW_KK);
        const bf16_t* rwka = (const bf16_t*)(ws + O_RW_KA);
        const float* decay = (const float*)(ws + O_DECAY);
        bf16_t* yraw = (bf16_t*)(ws + O_YRAW);
        bf16_t* mix = (bf16_t*)(ws + O_MIX);
        for (;;) {
            __syncthreads();
            if (tid == 0) s_item = atomicAdd(&counters[0], 1);
            __syncthreads();
            const int item = s_item;
            if (item >= 256 + 512 + 128 + 320 + 512) break;
            if (item < 256) {
                const int b = item >> 5, h = (item >> 2) & 7, qr = item & 3;
                float* opnd = (float*)smem;
                float* vbuf = (float*)(smem + 40960);
                float* ybuf = (float*)(smem + 40960 + 2048);
                const int seg = lane & 15, rl = wid * 4 + (lane >> 4);
                const int lstep = tid >> 4, lc4 = (tid & 15) * 4;
                const int vstep = (tid & 63) >> 2, vc4 = (tid & 3) * 4;
                const size_t gbase = ((size_t)b * 2048) * 512 + h * 64;
                u32x2 pr_kk, pr_k, pr_r, pr_ka, pr_v; f32x4 pr_w;
                auto prefetch = [&](int ch) {
                    const size_t o = gbase + (size_t)(ch * 16 + lstep) * 512 + lc4;
                    pr_kk = *(const u32x2*)(rwkk + o); pr_k = *(const u32x2*)(rwk + o); pr_r = *(const u32x2*)(rwr + o); pr_ka = *(const u32x2*)(rwka + o);
                    pr_w = *(const f32x4*)(decay + o);
                    if (tid < 64) pr_v = *(const u32x2*)(rwv + gbase + (size_t)(ch * 16 + vstep) * 512 + qr * 16 + vc4);
                };
                auto commit = [&](int buf) {
                    float* ob = opnd + buf * 5120 + lstep * 64 + lc4;
                    *(f32x4*)(ob + 0 * 1024) = (f32x4){bf_lo(pr_kk.x), bf_hi(pr_kk.x), bf_lo(pr_kk.y), bf_hi(pr_kk.y)};
                    *(f32x4*)(ob + 1 * 1024) = pr_w;
                    *(f32x4*)(ob + 2 * 1024) = (f32x4){bf_lo(pr_k.x), bf_hi(pr_k.x), bf_lo(pr_k.y), bf_hi(pr_k.y)};
                    *(f32x4*)(ob + 3 * 1024) = (f32x4){bf_lo(pr_r.x), bf_hi(pr_r.x), bf_lo(pr_r.y), bf_hi(pr_r.y)};
                    *(f32x4*)(ob + 4 * 1024) = (f32x4){bf_lo(pr_ka.x), bf_hi(pr_ka.x), bf_lo(pr_ka.y), bf_hi(pr_ka.y)};
                    if (tid < 64) *(f32x4*)(vbuf + buf * 256 + vstep * 16 + vc4) = (f32x4){bf_lo(pr_v.x), bf_hi(pr_v.x), bf_lo(pr_v.y), bf_hi(pr_v.y)};
                };
                float s0 = 0.f, s1 = 0.f, s2 = 0.f, s3 = 0.f;
                prefetch(0); commit(0);
                __syncthreads();
                for (int ch = 0; ch < 128; ++ch) {
                    if (ch + 1 < 128) prefetch(ch + 1);
                    const float* ob = opnd + (ch & 1) * 5120 + seg * 4;
                    const float* vb = vbuf + (ch & 1) * 256 + rl;
                    float ykeep = 0.f;
                    f32x4 c_kk = *(const f32x4*)(ob + 0 * 1024), c_w = *(const f32x4*)(ob + 1 * 1024), c_k = *(const f32x4*)(ob + 2 * 1024);
                    f32x4 c_r = *(const f32x4*)(ob + 3 * 1024), c_a = *(const f32x4*)(ob + 4 * 1024);
                    float c_v = vb[0];
                    f32x4 r_prev = c_r;
#pragma unroll
                    for (int s = 0; s < 16; ++s) {
                        f32x4 n_kk = c_kk, n_w = c_w, n_k = c_k, n_r = c_r, n_a = c_a; float n_v = c_v;
                        if (s + 1 < 16) {
                            n_kk = *(const f32x4*)(ob + 0 * 1024 + (s + 1) * 64); n_w = *(const f32x4*)(ob + 1 * 1024 + (s + 1) * 64);
                            n_k = *(const f32x4*)(ob + 2 * 1024 + (s + 1) * 64); n_r = *(const f32x4*)(ob + 3 * 1024 + (s + 1) * 64);
                            n_a = *(const f32x4*)(ob + 4 * 1024 + (s + 1) * 64); n_v = vb[(s + 1) * 16];
                        }
                        __builtin_amdgcn_sched_barrier(0);
                        float t0 = opq(s0 * c_kk[0]), u0 = opq(s0 * r_prev[0]);
                        float t1 = opq(s1 * c_kk[1]), u1 = opq(s1 * r_prev[1]);
                        t0 = opq(__builtin_fmaf(s2, c_kk[2], t0)); u0 = opq(__builtin_fmaf(s2, r_prev[2], u0));
                        t1 = opq(__builtin_fmaf(s3, c_kk[3], t1)); u1 = opq(__builtin_fmaf(s3, r_prev[3], u1));
                        float sa = opq(t0 + t1), y = opq(u0 + u1);
                        const float kv0 = opq(c_k[0] * c_v), kv1 = opq(c_k[1] * c_v), kv2 = opq(c_k[2] * c_v), kv3 = opq(c_k[3] * c_v);
                        allreduce16_pair(sa, y);
                        if (s > 0 && (s - 1) == seg) ykeep = y;
                        const float nsa = -sa;
                        s0 = opq(__builtin_fmaf(s0, c_w[0], opq(__builtin_fmaf(c_a[0], nsa, kv0))));
                        s1 = opq(__builtin_fmaf(s1, c_w[1], opq(__builtin_fmaf(c_a[1], nsa, kv1))));
                        s2 = opq(__builtin_fmaf(s2, c_w[2], opq(__builtin_fmaf(c_a[2], nsa, kv2))));
                        s3 = opq(__builtin_fmaf(s3, c_w[3], opq(__builtin_fmaf(c_a[3], nsa, kv3))));
                        r_prev = c_r;
                        c_kk = n_kk; c_w = n_w; c_k = n_k; c_r = n_r; c_a = n_a; c_v = n_v;
                    }
                    {
                        float u0 = opq(s0 * r_prev[0]), u1 = opq(s1 * r_prev[1]);
                        u0 = opq(__builtin_fmaf(s2, r_prev[2], u0)); u1 = opq(__builtin_fmaf(s3, r_prev[3], u1));
                        float y = u0 + u1;
                        y = allreduce16(y);
                        if (seg == 15) ykeep = y;
                    }
                    ybuf[seg * 16 + rl] = ykeep;
                    lds_barrier();
                    yraw[gbase + (size_t)(ch * 16 + (tid >> 4)) * 512 + qr * 16 + (tid & 15)] = (bf16_t)(cvt_pk_bf16(ybuf[tid], 0.f) & 0xffffu);
                    if (ch + 1 < 128) commit((ch + 1) & 1);
                    lds_barrier();
                }
            } else if (item < 768) {
                const int a = item - 256, qb = 15 - (a >> 5), bh = a & 31, b = bh >> 2, h = bh & 3;
                const size_t row0 = (size_t)b * 2048 + qb * 128;
                attn_item<192, 128, false, 2>(qmla + row0 * 768 + h * 192, 768,
                                    kfull + ((size_t)b * 2048) * 768 + h * 192, 768,
                                    vTm + ((size_t)(b * 4 + h) * 128) * 2048, 2048, 2 * qb + 2, 2 * qb + 1,
                                    mix + row0 * 1024 + h * 128, 1024, smem);
            } else if (item < 896) {
                const int i_ = item - 768, tm = i_ >> 4, tn = i_ & 15;
                const bf16_t* memb = (const bf16_t*)(ws + O_MEMB);
                const bf16_t* xakvT = (const bf16_t*)(ws + O_XAKVT);
                bf16_t* km = (bf16_t*)(ws + O_KM);
                bf16_t* vmT = (bf16_t*)(ws + O_VMT);
                if (tn < 8) {
                    gemm_tile_big<true>(memb, 1024, xakvT, 1024, 1024, tm * 256, tn * 128, smem,
                        [&](const f32x4 (&acc)[4][4], int rbase, int cbase, int fr, int fq) {
#pragma unroll
                            for (int m = 0; m < 4; ++m) {
                                const int row = rbase + m * 16 + fr;
                                const float rs = rsqrtf(ssqm[row] * (1.0f / 1024.0f) + EPS);
#pragma unroll
                                for (int n = 0; n < 4; ++n) {
                                    const f32x4 v = acc[m][n] * rs;
                                    u32x2 w; w.x = cvt_pk_bf16(v[0], v[1]); w.y = cvt_pk_bf16(v[2], v[3]);
                                    *(u32x2*)(km + (size_t)row * 1024 + cbase + n * 16 + fq * 4) = w;
                                }
                            }
                        });
                } else {
                    gemm_tile_big<false>(memb, 1024, xakvT, 1024, 1024, tm * 256, tn * 128, smem,
                        [&](const f32x4 (&acc)[4][4], int rbase, int cbase, int fr, int fq) {
#pragma unroll
                            for (int m = 0; m < 4; ++m) {
                                const int row = rbase + m * 16 + fq * 4;
                                const f32x4 sq = *(const f32x4*)(ssqm + row);
                                f32x4 rs;
#pragma unroll
                                for (int j = 0; j < 4; ++j) rs[j] = rsqrtf(sq[j] * (1.0f / 1024.0f) + EPS);
                                const int b = row >> 8, mi = row & 255;
#pragma unroll
                                for (int n = 0; n < 4; ++n) {
                                    const int col = cbase + n * 16 + fr - 1024;
                                    const f32x4 v = acc[m][n] * rs;
                                    u32x2 w; w.x = cvt_pk_bf16(v[0], v[1]); w.y = cvt_pk_bf16(v[2], v[3]);
                                    *(u32x2*)(vmT + ((size_t)(b * 1024 + col)) * 256 + mi) = w;
                                }
                            }
                        });
                }
            } else {
                const int i_ = item - 896;
                if (i_ < 320) { for (int t_ = 0; t_ < 4; ++t_) { const int tl_ = i_ * 4 + t_; do_tr(tl_ < 512 ? 672 + tl_ : 1696 + (tl_ - 512)); } }
                else { const int r0_ = (i_ - 320) * 64; convert_experts(r0_, r0_ + 64, wid, lane); }
            }
        }
    }
    GRID_SYNC();

    if (PH & (1 << 4)) {
        PHASE_IDS
        const bf16_t* rwr = (const bf16_t*)(ws + O_RW_R);
        const bf16_t* rwk = (const bf16_t*)(ws + O_RW_K);
        const bf16_t* rwv = (const bf16_t*)(ws + O_RW_V);
        const bf16_t* gbuf = (const bf16_t*)(ws + O_G);
        const bf16_t* yraw = (const bf16_t*)(ws + O_YRAW);
        bf16_t* mix = (bf16_t*)(ws + O_MIX);
        for (int i = gtid; i < T * 128; i += gsz) {
            const int row = i >> 7, c4 = (i & 127) * 4;
            const size_t o = (size_t)row * 512 + c4;
            const u32x2 yu = *(const u32x2*)(yraw + o);
            const f32x4 y = (f32x4){bf_lo(yu.x), bf_hi(yu.x), bf_lo(yu.y), bf_hi(yu.y)};
            float s1 = y[0] + y[1] + y[2] + y[3];
#pragma unroll
            for (int d = 1; d < 16; d <<= 1) s1 += __shfl_xor(s1, d);
            const float mu = s1 * (1.0f / 64.0f);
            const f32x4 dy = y - mu;
            float s2 = dy[0] * dy[0] + dy[1] * dy[1] + dy[2] * dy[2] + dy[3] * dy[3];
            const u32x2 ru = *(const u32x2*)(rwr + o), ku = *(const u32x2*)(rwk + o), vu = *(const u32x2*)(rwv + o), gu = *(const u32x2*)(gbuf + o);
            const f32x4 rk = *(const f32x4*)(P.rw_r_k + c4);
            const f32x4 rv = (f32x4){bf_lo(ru.x), bf_hi(ru.x), bf_lo(ru.y), bf_hi(ru.y)};
            const f32x4 kv = (f32x4){bf_lo(ku.x), bf_hi(ku.x), bf_lo(ku.y), bf_hi(ku.y)};
            const f32x4 vv = (f32x4){bf_lo(vu.x), bf_hi(vu.x), bf_lo(vu.y), bf_hi(vu.y)};
            const f32x4 gv = (f32x4){bf_lo(gu.x), bf_hi(gu.x), bf_lo(gu.y), bf_hi(gu.y)};
            float s3 = rv[0] * kv[0] * rk[0] + rv[1] * kv[1] * rk[1] + rv[2] * kv[2] * rk[2] + rv[3] * kv[3] * rk[3];
#pragma unroll
            for (int d = 1; d < 16; d <<= 1) { s2 += __shfl_xor(s2, d); s3 += __shfl_xor(s3, d); }
            const float rstd = rsqrtf(s2 * (1.0f / 64.0f) + 64e-5f);
            const f32x4 lw = *(const f32x4*)(P.rw_lnx_w + c4), lb = *(const f32x4*)(P.rw_lnx_b + c4);
            f32x4 r;
#pragma unroll
            for (int j = 0; j < 4; ++j) {
#ifdef DBG_NOY
                r[j] = (lb[j] + s3 * vv[j]) * gv[j];
#else
                r[j] = (dy[j] * rstd * lw[j] + lb[j] + s3 * vv[j]) * gv[j];
#endif
            }
            u32x2 w; w.x = cvt_pk_bf16(r[0], r[1]); w.y = cvt_pk_bf16(r[2], r[3]);
            *(u32x2*)(mix + (size_t)row * 1024 + 512 + c4) = w;
        }
    }
    GRID_SYNC();

    if (PH & (1 << 5)) {
        PHASE_IDS
        const bf16_t* mix = (const bf16_t*)(ws + O_MIX);
        const bf16_t* woutT = (const bf16_t*)(ws + O_WOUTT);
        bf16_t* h1b = (bf16_t*)(ws + O_H1B);
        XCD_TILE_LOOP(64, 8, tm, tn) {
            auto almix = [&](int row, int k) -> u32x4 {
#ifdef DBG_ZERO_RWKV
                if (k >= 512) return (u32x4){0u, 0u, 0u, 0u};
#endif
#ifdef DBG_ZERO_MLA
                if (k < 512) return (u32x4){0u, 0u, 0u, 0u};
#endif
                return *(const u32x4*)(mix + (size_t)row * 1024 + k);
            };
            (void)almix; gemm_tile_big<true>(mix, 1024, woutT, 1024, 1024, tm * 256, tn * 128, smem,
                [&](const f32x4 (&acc)[4][4], int rbase, int cbase, int fr, int fq) {
#pragma unroll
                    for (int m = 0; m < 4; ++m) {
                        const int row = rbase + m * 16 + fr;
                        float ss = 0.f;
#pragma unroll
                        for (int n = 0; n < 4; ++n) {
                            const size_t o = (size_t)row * 1024 + cbase + n * 16 + fq * 4;
                            const f32x4 v = *(const f32x4*)(P.x + o) + acc[m][n];
                            ss += v[0] * v[0] + v[1] * v[1] + v[2] * v[2] + v[3] * v[3];
                            *(f32x4*)(P.out + o) = v;
                            u32x2 w; w.x = cvt_pk_bf16(v[0], v[1]); w.y = cvt_pk_bf16(v[2], v[3]);
                            *(u32x2*)(h1b + o) = w;
                        }
                        ss += __shfl_xor(ss, 16); ss += __shfl_xor(ss, 32);
                        if (fq == 0) atomicAdd(&ssq1[row], ss);
                    }
                });
        }
    }
    GRID_SYNC();

    if (PH & (1 << 6)) {
        PHASE_IDS
        const bf16_t* h1b = (const bf16_t*)(ws + O_H1B);
        const bf16_t* xaqT = (const bf16_t*)(ws + O_XAQT);
        bf16_t* qxa = (bf16_t*)(ws + O_QXA);
        const float XSCALE = 0.0625f * 1.4426950408889634f;
        XCD_TILE_LOOP(64, 8, tm, tn) {
            gemm_tile_big<true>(h1b, 1024, xaqT, 1024, 1024, tm * 256, tn * 128, smem,
                [&](const f32x4 (&acc)[4][4], int rbase, int cbase, int fr, int fq) {
#pragma unroll
                    for (int m = 0; m < 4; ++m) {
                        const int row = rbase + m * 16 + fr;
                        const float rs = rsqrtf(ssq1[row] * (1.0f / 1024.0f) + EPS) * XSCALE;
#pragma unroll
                        for (int n = 0; n < 4; ++n) {
                            const f32x4 v = acc[m][n] * rs;
                            u32x2 w; w.x = cvt_pk_bf16(v[0], v[1]); w.y = cvt_pk_bf16(v[2], v[3]);
                            *(u32x2*)(qxa + (size_t)row * 1024 + cbase + n * 16 + fq * 4) = w;
                        }
                    }
                });
        }
    }
    GRID_SYNC();

    if (PH & (1 << 7)) {
        PHASE_IDS
        const bf16_t* qxa = (const bf16_t*)(ws + O_QXA);
        const bf16_t* km = (const bf16_t*)(ws + O_KM);
        const bf16_t* vmT = (const bf16_t*)(ws + O_VMT);
        bf16_t* oxa = (bf16_t*)(ws + O_OXA);
        for (int item = bid; item < 8 * 4 * 32; item += nb) {
            const int qt = item >> 5 & 31, bh = item & 31;
            const int b = bh >> 2, h = bh & 3;
            const size_t row0 = (size_t)b * 2048 + qt * 64;
            attn_item<256, 256, true, 1>(qxa + row0 * 1024 + h * 256, 1024,
                                km + ((size_t)b * 256) * 1024 + h * 256, 1024,
                                vmT + ((size_t)(b * 4 + h) * 256) * 256, 256, 4, 4,
                                oxa + row0 * 1024 + h * 256, 1024, smem);
        }
    }
    GRID_SYNC();

    if (PH & (1 << 8)) {
        PHASE_IDS
        const bf16_t* oxa = (const bf16_t*)(ws + O_OXA);
        const bf16_t* xaoT = (const bf16_t*)(ws + O_XAOT);
        bf16_t* h2b = (bf16_t*)(ws + O_H2B);
        XCD_TILE_LOOP(64, 8, tm, tn) {
            gemm_tile_big<true>(oxa, 1024, xaoT, 1024, 1024, tm * 256, tn * 128, smem,
                [&](const f32x4 (&acc)[4][4], int rbase, int cbase, int fr, int fq) {
#pragma unroll
                    for (int m = 0; m < 4; ++m) {
                        const int row = rbase + m * 16 + fr;
                        float ss = 0.f;
#pragma unroll
                        for (int n = 0; n < 4; ++n) {
                            const size_t o = (size_t)row * 1024 + cbase + n * 16 + fq * 4;
                            const f32x4 v = *(const f32x4*)(P.out + o) + acc[m][n];
                            ss += v[0] * v[0] + v[1] * v[1] + v[2] * v[2] + v[3] * v[3];
                            *(f32x4*)(P.out + o) = v;
                            u32x2 w; w.x = cvt_pk_bf16(v[0], v[1]); w.y = cvt_pk_bf16(v[2], v[3]);
                            *(u32x2*)(h2b + o) = w;
                        }
                        ss += __shfl_xor(ss, 16); ss += __shfl_xor(ss, 32);
                        if (fq == 0) atomicAdd(&ssq2[row], ss);
                    }
                });
        }
    }
    GRID_SYNC();

    if (PH & (1 << 9)) {
        PHASE_IDS
        const bf16_t* h2b = (const bf16_t*)(ws + O_H2B);
        const bf16_t* pwqT = (const bf16_t*)(ws + O_PWQT);
        bf16_t* pq = (bf16_t*)(ws + O_PQ);
        const bf16_t* keysb = (const bf16_t*)(ws + O_KEYS);
        bf16_t* scores = (bf16_t*)(ws + O_SCORES);
        (void)pq;
        XCD_TILE_LOOP(64, 16, tm, g) { pq_scores_tile(h2b, 1024, pwqT, 1024, 1024, tm * 256, g, ssq2, keysb, scores, smem); }
    }
    GRID_SYNC();

    if (PH & (1 << 11)) {
        PHASE_IDS
        const bf16_t* scores = (const bf16_t*)(ws + O_SCORES);
        const unsigned char* eu8 = (const unsigned char*)(ws + O_EUB);
        const unsigned char* ev8 = (const unsigned char*)(ws + O_EVB);
        const float* esinv = (const float*)(ws + O_SSQ + 6 * 65536);
        char* wsm = smem + wid * 13824;
        int* eidx = (int*)wsm;
        float* egate = (float*)(wsm + 4096);
        float* esu = (float*)(wsm + 8192);
        unsigned char* xs = (unsigned char*)(wsm + 12288);
        float* acts = (float*)(wsm + 13312);
        const int fr = lane & 15, fq = lane >> 4;
        for (int witem = bid * 4 + wid; witem < T / 8; witem += nb * 4) {
            const int t0 = witem * 8;
            {
                const int tt = lane >> 3, h = lane & 7;
                const bf16_t* sp = scores + (size_t)(t0 + tt) * 2048 + h * 256;
                unsigned L1[16], L2[16];
#pragma unroll
                for (int s = 0; s < 16; ++s) { L1[s] = 0u; L2[s] = 0u; }
                for (int i = 0; i < 128; i += 8) {
                    const u32x4 a = *(const u32x4*)(sp + i);
                    const u32x4 b = *(const u32x4*)(sp + 128 + i);
                    const unsigned au[4] = {a.x, a.y, a.z, a.w}, bu[4] = {b.x, b.y, b.z, b.w};
#pragma unroll
                    for (int e = 0; e < 4; ++e) {
                        const unsigned id0 = 127u - (unsigned)(i + 2 * e), id1 = id0 - 1u;
                        TOPK_INSERT(L1, (ordkey(bf_lo(au[e])) & ~127u) | id0);
                        TOPK_INSERT(L1, (ordkey(bf_hi(au[e])) & ~127u) | id1);
                        TOPK_INSERT(L2, (ordkey(bf_lo(bu[e])) & ~127u) | id0);
                        TOPK_INSERT(L2, (ordkey(bf_hi(bu[e])) & ~127u) | id1);
                    }
                }
                float v1[16], v2[16];
                unsigned pa0 = 0u, pa1 = 0u, pa2 = 0u, pa3 = 0u, pb0 = 0u, pb1 = 0u, pb2 = 0u, pb3 = 0u;
#pragma unroll
                for (int s = 0; s < 16; ++s) {
                    v1[s] = unordkey(L1[s] & ~127u); v2[s] = unordkey(L2[s] & ~127u);
                    const unsigned i1_ = (127u - (L1[s] & 127u)) << ((s & 3) * 8), i2_ = (127u - (L2[s] & 127u)) << ((s & 3) * 8);
                    if ((s >> 2) == 0) { pa0 |= i1_; pb0 |= i2_; } else if ((s >> 2) == 1) { pa1 |= i1_; pb1 |= i2_; }
                    else if ((s >> 2) == 2) { pa2 |= i1_; pb2 |= i2_; } else { pa3 |= i1_; pb3 |= i2_; }
                }
                unsigned C[16];
#pragma unroll
                for (int s = 0; s < 16; ++s) C[s] = 0u;
#pragma unroll
                for (int a = 0; a < 16; ++a)
#pragma unroll
                    for (int b = 0; b < 16; ++b)
                        if ((a + 1) * (b + 1) <= 16) { TOPK_INSERT(C, (ordkey(v1[a] + v2[b]) & ~255u) | (255u - (unsigned)(a * 16 + b))); }
                float cv[16], sum = 0.f;
                {
                    const float mxv = unordkey(C[0] & ~255u);
                    sum = 0.f;
#pragma unroll
                    for (int s = 0; s < 16; ++s) { cv[s] = __expf(unordkey(C[s] & ~255u) - mxv); sum += cv[s]; }
                }
                const float isum = 1.0f / sum;
#pragma unroll
                for (int s = 0; s < 16; ++s) {
                    const int ab = 255 - (int)(C[s] & 255u), a = ab >> 4, b = ab & 15;
                    const int e = (int)(byte_lookup(pa0, pa1, pa2, pa3, a) * 128u + byte_lookup(pb0, pb1, pb2, pb3, b));
                    eidx[tt * 128 + h * 16 + s] = e;
                    egate[tt * 128 + h * 16 + s] = cv[s] * isum * esinv[16384 + e];
                    esu[tt * 128 + h * 16 + s] = esinv[e];
                }
            }
            __builtin_amdgcn_wave_barrier();
            for (int tt = 0; tt < 8; ++tt) {
                const int row = t0 + tt;
                const float* hrow = P.out + (size_t)row * 1024 + lane * 16;
                f32x4 hv[4];
#pragma unroll
                for (int i = 0; i < 4; ++i) hv[i] = *(const f32x4*)(hrow + i * 4);
                const float rs2 = rsqrtf(ssq2[row] * (1.0f / 1024.0f) + EPS);
                float sxinv;
                {
                    f32x4 a[4]; float amax = 0.f;
#pragma unroll
                    for (int i = 0; i < 4; ++i) {
                        a[i] = hv[i] * *(const f32x4*)(P.norm_ffn_g + lane * 16 + i * 4) * rs2;
                        amax = fmaxf(amax, fmaxf(fmaxf(fabsf(a[i][0]), fabsf(a[i][1])), fmaxf(fabsf(a[i][2]), fabsf(a[i][3]))));
                    }
#pragma unroll
                    for (int o = 32; o >= 1; o >>= 1) amax = fmaxf(amax, __shfl_xor(amax, o));
                    amax = fmaxf(amax, 1e-30f);
                    const float sc = 240.0f / amax; sxinv = amax * (1.0f / 240.0f);
                    int w[4];
#pragma unroll
                    for (int i = 0; i < 4; ++i) {
                        w[i] = __builtin_amdgcn_cvt_pk_fp8_f32(a[i][0] * sc, a[i][1] * sc, 0, false);
                        w[i] = __builtin_amdgcn_cvt_pk_fp8_f32(a[i][2] * sc, a[i][3] * sc, w[i], true);
                    }
                    *(u32x4*)(xs + lane * 16) = (u32x4){(unsigned)w[0], (unsigned)w[1], (unsigned)w[2], (unsigned)w[3]};
                }
                __builtin_amdgcn_wave_barrier();
                int er[8];
#pragma unroll
                for (int eg = 0; eg < 8; ++eg) er[eg] = eidx[tt * 128 + eg * 16 + fr];
                f32x4 acc[8];
#pragma unroll
                for (int eg = 0; eg < 8; ++eg) acc[eg] = (f32x4){0.f, 0.f, 0.f, 0.f};
#pragma unroll 2
                for (int it = 0; it < 16; ++it) {
                    const i64x2 xq = *(const i64x2*)(xs + it * 64 + fq * 16);
#pragma unroll
                    for (int eg = 0; eg < 8; ++eg) {
                        const i64x2 uq = *(const i64x2*)(eu8 + (size_t)er[eg] * 1024 + it * 64 + fq * 16);
                        acc[eg] = __builtin_amdgcn_mfma_f32_16x16x32_fp8_fp8(uq.x, xq.x, acc[eg], 0, 0, 0);
                        acc[eg] = __builtin_amdgcn_mfma_f32_16x16x32_fp8_fp8(uq.y, xq.y, acc[eg], 0, 0, 0);
                    }
                }
#pragma unroll
                for (int eg = 0; eg < 8; ++eg) {
                    const f32x4 gt = *(const f32x4*)(egate + tt * 128 + eg * 16 + fq * 4);
                    const f32x4 su = *(const f32x4*)(esu + tt * 128 + eg * 16 + fq * 4);
                    f32x4 av;
#pragma unroll
                    for (int j = 0; j < 4; ++j) { const float pre = acc[eg][j] * su[j] * sxinv; av[j] = 0.5f * pre * (1.0f + erff(pre * 0.70710678118654752f)) * gt[j]; }
                    if (fr == 0) *(f32x4*)(acts + eg * 16 + fq * 4) = av;
                }
                __builtin_amdgcn_wave_barrier();
                f32x4 oa[4];
#pragma unroll
                for (int i = 0; i < 4; ++i) oa[i] = (f32x4){0.f, 0.f, 0.f, 0.f};
                for (int j0 = 0; j0 < 128; j0 += 8) {
                    const f32x4 a4 = *(const f32x4*)(acts + j0), a5 = *(const f32x4*)(acts + j0 + 4);
                    const float as[8] = {a4[0], a4[1], a4[2], a4[3], a5[0], a5[1], a5[2], a5[3]};
                    u32x4 vq[8];
#pragma unroll
                    for (int jj = 0; jj < 8; ++jj) vq[jj] = *(const u32x4*)(ev8 + (size_t)eidx[tt * 128 + j0 + jj] * 1024 + lane * 16);
#pragma unroll
                    for (int jj = 0; jj < 8; ++jj) {
                        const float a = as[jj];
                        const unsigned q4[4] = {vq[jj].x, vq[jj].y, vq[jj].z, vq[jj].w};
#pragma unroll
                        for (int i = 0; i < 4; ++i) {
                            const f32x2_t lo = __builtin_amdgcn_cvt_pk_f32_fp8((int)q4[i], false), hi = __builtin_amdgcn_cvt_pk_f32_fp8((int)q4[i], true);
                            oa[i][0] += a * lo[0]; oa[i][1] += a * lo[1]; oa[i][2] += a * hi[0]; oa[i][3] += a * hi[1];
                        }
                    }
                }
                float ss = 0.f;
#pragma unroll
                for (int i = 0; i < 4; ++i) { hv[i] = hv[i] + oa[i]; ss += hv[i][0] * hv[i][0] + hv[i][1] * hv[i][1] + hv[i][2] * hv[i][2] + hv[i][3] * hv[i][3]; }
                ss = wave_sum(ss);
                const float rs3 = rsqrtf(ss * (1.0f / 1024.0f) + EPS);
                float* orow = P.out + (size_t)row * 1024 + lane * 16;
#pragma unroll
                for (int i = 0; i < 4; ++i) *(f32x4*)(orow + i * 4) = hv[i] * rs3 * *(const f32x4*)(P.final_norm_g + lane * 16 + i * 4);
                __builtin_amdgcn_wave_barrier();
            }
        }
    }
#ifdef TIMED_MASK
    {
        xcd_barrier(xb);
        const long long tn_ = (long long)__builtin_amdgcn_s_memrealtime();
        if ((TIMED_MASK >> ph_idx) & 1) t_acc += tn_ - t_last;
        const long long t_end = tn_ + t_acc;
        while ((long long)__builtin_amdgcn_s_memrealtime() < t_end) __builtin_amdgcn_s_sleep(8);
    }
#endif
    if (PH & (1 << 12)) {
        PHASE_IDS
        GRID_SYNC();
        const float* src = (PH & (1 << 5)) ? (const float*)P.out : P.x;
        for (int r = bid * 4 + wid; r < T; r += nb * 4) {
            const float* srow = src + (size_t)r * 1024;
            f32x4 v[4]; float ss = 0.f;
#pragma unroll
            for (int i = 0; i < 4; ++i) { v[i] = *(const f32x4*)(srow + i * 256 + lane * 4); ss += v[i][0] * v[i][0] + v[i][1] * v[i][1] + v[i][2] * v[i][2] + v[i][3] * v[i][3]; }
            ss = wave_sum(ss);
            const float rs = rsqrtf(ss * (1.0f / 1024.0f) + EPS);
#pragma unroll
            for (int i = 0; i < 4; ++i) *(f32x4*)(P.out + (size_t)r * 1024 + i * 256 + lane * 4) = v[i] * rs * *(const f32x4*)(P.final_norm_g + i * 256 + lane * 4);
        }
    }
}

extern "C" void kernel_launch(void* const* d_in, const int* in_sizes, int n_in, void* d_out, int out_size, void* d_ws, size_t ws_size,
                              hipStream_t stream) {
    (void)in_sizes; (void)n_in; (void)out_size;
    if (ws_size < WS_NEED) { fprintf(stderr, "workspace too small: %zu\n", ws_size); return; }
    static int grid_blocks = 0;
    if (!grid_blocks) {
        int dev = 0, cus = 0, per_cu = 0;
        hipGetDevice(&dev);
        hipDeviceGetAttribute(&cus, hipDeviceAttributeMultiprocessorCount, dev);
        hipOccupancyMaxActiveBlocksPerMultiprocessor(&per_cu, fwd_megakernel, 256, 0);
        if (per_cu > 2) per_cu = 2;
        grid_blocks = cus * per_cu;
    }
    Params p{};
    const float** fp = (const float**)&p;
    (void)fp;
    p.x = (const float*)d_in[0]; p.mem = (const float*)d_in[1]; p.pos = (const int*)d_in[2];
    p.norm_mix_g = (const float*)d_in[3]; p.w_in = (const float*)d_in[4]; p.shift_mu = (const float*)d_in[5];
    p.q_norm_g = (const float*)d_in[6]; p.kv_norm_g = (const float*)d_in[7]; p.w_uq = (const float*)d_in[8]; p.w_ukv = (const float*)d_in[9];
    p.rw_w0 = (const float*)d_in[10]; p.rw_w_up = (const float*)d_in[11]; p.rw_a0 = (const float*)d_in[12]; p.rw_a_up = (const float*)d_in[13];
    p.rw_g_up = (const float*)d_in[14]; p.rw_k_k = (const float*)d_in[15]; p.rw_k_a = (const float*)d_in[16]; p.rw_r_k = (const float*)d_in[17];
    p.rw_lnx_w = (const float*)d_in[18]; p.rw_lnx_b = (const float*)d_in[19]; p.w_out = (const float*)d_in[20];
    p.norm_xa_g = (const float*)d_in[21]; p.norm_mem_g = (const float*)d_in[22]; p.xa_wq = (const float*)d_in[23]; p.xa_wk = (const float*)d_in[24];
    p.xa_wv = (const float*)d_in[25]; p.xa_wo = (const float*)d_in[26]; p.norm_ffn_g = (const float*)d_in[27]; p.peer_wq = (const float*)d_in[28];
    p.peer_keys = (const float*)d_in[29]; p.expert_u = (const float*)d_in[30]; p.expert_v = (const float*)d_in[31]; p.final_norm_g = (const float*)d_in[32];
    p.out = (float*)d_out; p.ws = (char*)d_ws;
    hipMemsetAsync((char*)d_ws + O_XBAR, 0, XCD_BAR_WORDS_BYTES, stream);
    void* args[] = {&p};
    hipError_t e = hipLaunchCooperativeKernel((void*)fwd_megakernel, dim3(grid_blocks), dim3(256), args, 0, stream);
    if (e != hipSuccess) fprintf(stderr, "cooperative launch failed: %s (grid %d)\n", hipGetErrorString(e), grid_blocks);
}
```

```cpp
#include <hip/hip_runtime.h>
#include <hip/hip_cooperative_groups.h>
#include <cstdio>
namespace cg = cooperative_groups;

typedef unsigned short bf16_t;
typedef short bf16x8 __attribute__((ext_vector_type(8)));
typedef float f32x4 __attribute__((ext_vector_type(4)));
typedef unsigned u32x4 __attribute__((ext_vector_type(4)));
typedef unsigned u32x2 __attribute__((ext_vector_type(2)));
typedef long i64x2 __attribute__((ext_vector_type(2)));

#define DEV __device__ __forceinline__

constexpr int T = 16384;
constexpr float EPS = 1e-6f;
constexpr size_t MB = 1u << 20;
constexpr size_t XCD_BAR_WORDS_BYTES = 3456 * 4;

constexpr size_t O_WINT  = 0;
constexpr size_t O_WUQT  = O_WINT  + (size_t)2304 * 1024 * 2;
constexpr size_t O_WUKT  = O_WUQT  + (size_t)768 * 256 * 2;
constexpr size_t O_WUVT  = O_WUKT  + (size_t)512 * 128 * 2;
constexpr size_t O_WUPT  = O_WUVT  + (size_t)512 * 128 * 2;
constexpr size_t O_AUPT  = O_WUPT  + (size_t)512 * 64 * 2;
constexpr size_t O_GUPT  = O_AUPT  + (size_t)512 * 64 * 2;
constexpr size_t O_WOUTT = O_GUPT  + (size_t)512 * 128 * 2;
constexpr size_t O_XAQT  = O_WOUTT + (size_t)1024 * 1024 * 2;
constexpr size_t O_XAKVT = O_XAQT  + (size_t)1024 * 1024 * 2;
constexpr size_t O_XAOT  = O_XAKVT + (size_t)2048 * 1024 * 2;
constexpr size_t O_PWQT  = O_XAOT  + (size_t)1024 * 1024 * 2;
constexpr size_t O_KEYS  = O_PWQT  + (size_t)2048 * 1024 * 2;
constexpr size_t O_SSQ   = O_KEYS  + (size_t)16 * 128 * 128 * 2;
constexpr size_t O_CNT   = O_SSQ   + (size_t)8 * 65536;
constexpr size_t O_ROPE  = O_CNT   + 4096;
constexpr size_t O_KM    = O_ROPE  + (size_t)T * 32 * 8;
constexpr size_t O_VMT   = O_KM    + (size_t)2048 * 1024 * 2;
constexpr size_t O_MEMB  = O_VMT   + (size_t)2048 * 1024 * 2;
constexpr size_t O_PERSIST_END = O_MEMB + (size_t)2048 * 1024 * 2;
constexpr size_t O_XBAR = O_PERSIST_END;
static_assert(O_XBAR + XCD_BAR_WORDS_BYTES <= 40 * MB, "persistent region too large");
constexpr size_t O_P     = 40 * MB;
constexpr size_t O_YRAW  = 40 * MB;
constexpr size_t O_MIX   = 72 * MB;
constexpr size_t O_OXA   = 144 * MB;
constexpr size_t O_H2B   = 72 * MB;
constexpr size_t O_SCORES= 144 * MB;
constexpr size_t O_SCORES_OLD_UNUSED = 40 * MB;
constexpr size_t O_XB    = 112 * MB;
constexpr size_t O_G     = 112 * MB;
constexpr size_t O_QXA   = 72 * MB;
constexpr size_t O_RW_R  = 144 * MB;
constexpr size_t O_RW_K  = 160 * MB;
constexpr size_t O_RW_V  = 176 * MB;
constexpr size_t O_RW_KK = 192 * MB;
constexpr size_t O_RW_KA = 208 * MB;
constexpr size_t O_DECAY = 224 * MB;
constexpr size_t O_H1B   = 144 * MB;
constexpr size_t O_EUB   = 128 * MB;
constexpr size_t O_EUB_OLD = 176 * MB;
constexpr size_t O_EVB   = 56 * MB;
constexpr size_t O_EVB_OLD = 208 * MB;
constexpr size_t O_PQ    = 104 * MB;
constexpr size_t WS_NEED = 256 * MB;

struct Params {
    const float *x, *mem; const int* pos;
    const float *norm_mix_g, *w_in, *shift_mu, *q_norm_g, *kv_norm_g, *w_uq, *w_ukv;
    const float *rw_w0, *rw_w_up, *rw_a0, *rw_a_up, *rw_g_up, *rw_k_k, *rw_k_a, *rw_r_k, *rw_lnx_w, *rw_lnx_b;
    const float *w_out, *norm_xa_g, *norm_mem_g, *xa_wq, *xa_wk, *xa_wv, *xa_wo;
    const float *norm_ffn_g, *peer_wq, *peer_keys, *expert_u, *expert_v, *final_norm_g;
    float* out; char* ws;
};

typedef __bf16 bf16x2_t __attribute__((ext_vector_type(2)));
typedef float f32x2_t __attribute__((ext_vector_type(2)));
DEV unsigned cvt_pk_bf16(float lo, float hi) { const f32x2_t f = {lo, hi}; const bf16x2_t b = __builtin_convertvector(f, bf16x2_t); unsigned r; __builtin_memcpy(&r, &b, 4); return r; }
DEV float bf_lo(unsigned u) { return __uint_as_float(u << 16); }
DEV float bf_hi(unsigned u) { return __uint_as_float(u & 0xffff0000u); }
DEV f32x4 mfma16(bf16x8 a, bf16x8 b, f32x4 c) { return __builtin_amdgcn_mfma_f32_16x16x32_bf16(a, b, c, 0, 0, 0); }
DEV float sigmoidf_(float v) { return 1.0f / (1.0f + __expf(-v)); }
DEV float wave_sum(float v) {
#pragma unroll
    for (int o = 32; o >= 1; o >>= 1) v += __shfl_xor(v, o);
    return v;
}
DEV float allreduce8(float x) {
    x += __int_as_float(__builtin_amdgcn_update_dpp(0, __float_as_int(x), 0xB1, 0xF, 0xF, true));
    x += __int_as_float(__builtin_amdgcn_update_dpp(0, __float_as_int(x), 0x4E, 0xF, 0xF, true));
    x += __int_as_float(__builtin_amdgcn_update_dpp(0, __float_as_int(x), 0x141, 0xF, 0xF, true));
    return x;
}
DEV float opq(float x) { asm("" : "+v"(x)); return x; }
DEV void lds_barrier() { asm volatile("s_waitcnt lgkmcnt(0)\n\ts_barrier" ::: "memory"); }
DEV float allreduce16(float x) {
    x += __int_as_float(__builtin_amdgcn_update_dpp(0, __float_as_int(x), 0xB1, 0xF, 0xF, true));
    x += __int_as_float(__builtin_amdgcn_update_dpp(0, __float_as_int(x), 0x4E, 0xF, 0xF, true));
    x += __int_as_float(__builtin_amdgcn_update_dpp(0, __float_as_int(x), 0x141, 0xF, 0xF, true));
    x += __int_as_float(__builtin_amdgcn_update_dpp(0, __float_as_int(x), 0x140, 0xF, 0xF, true));
    return x;
}
DEV void allreduce16_pair(float& a, float& b) {
    a += __int_as_float(__builtin_amdgcn_update_dpp(0, __float_as_int(a), 0xB1, 0xF, 0xF, true));
    b += __int_as_float(__builtin_amdgcn_update_dpp(0, __float_as_int(b), 0xB1, 0xF, 0xF, true));
    a += __int_as_float(__builtin_amdgcn_update_dpp(0, __float_as_int(a), 0x4E, 0xF, 0xF, true));
    b += __int_as_float(__builtin_amdgcn_update_dpp(0, __float_as_int(b), 0x4E, 0xF, 0xF, true));
    a += __int_as_float(__builtin_amdgcn_update_dpp(0, __float_as_int(a), 0x141, 0xF, 0xF, true));
    b += __int_as_float(__builtin_amdgcn_update_dpp(0, __float_as_int(b), 0x141, 0xF, 0xF, true));
    a += __int_as_float(__builtin_amdgcn_update_dpp(0, __float_as_int(a), 0x140, 0xF, 0xF, true));
    b += __int_as_float(__builtin_amdgcn_update_dpp(0, __float_as_int(b), 0x140, 0xF, 0xF, true));
}
DEV bf16x8 as_bf16x8(u32x4 v) { bf16x8 r; __builtin_memcpy(&r, &v, 16); return r; }

template <bool SWAP, class AL, class EP>
DEV void gemm_tile(AL aload, const bf16_t* __restrict__ Bt, int ldb, int K, int row0, int col0, char* smem, EP epi) {
    int tid = threadIdx.x; asm volatile("" : "+v"(tid));
    const int wid = __builtin_amdgcn_readfirstlane(tid >> 6), lane = tid & 63, wr = wid >> 1, wc = wid & 1, fr = lane & 15, fq = lane >> 4;
    constexpr int RS = 144;
    constexpr int TB = 128 * RS;
    char* sA = smem; char* sB = smem + 2 * TB;
    f32x4 acc[4][4];
#pragma unroll
    for (int m = 0; m < 4; ++m)
#pragma unroll
        for (int n = 0; n < 4; ++n) acc[m][n] = (f32x4){0.f, 0.f, 0.f, 0.f};
    const int lr = tid >> 3, lk = (tid & 7) * 8;
    const bf16_t* bp = Bt + (size_t)(col0 + lr) * ldb + lk;
    const int lo = lr * RS + (tid & 7) * 16;
    u32x4 ra[4], rb[4];
#pragma unroll
    for (int i = 0; i < 4; ++i) { ra[i] = aload(row0 + lr + 32 * i, lk); rb[i] = *(const u32x4*)(bp + (size_t)(32 * i) * ldb); }
#pragma unroll
    for (int i = 0; i < 4; ++i) { *(u32x4*)(sA + lo + i * 32 * RS) = ra[i]; *(u32x4*)(sB + lo + i * 32 * RS) = rb[i]; }
    __syncthreads();
    const int nt = K >> 6;
    for (int t = 0; t < nt; ++t) {
        const bool more = (t + 1 < nt);
        if (more) {
            const int kb = (t + 1) << 6;
#pragma unroll
            for (int i = 0; i < 4; ++i) { ra[i] = aload(row0 + lr + 32 * i, kb + lk); rb[i] = *(const u32x4*)(bp + (size_t)(32 * i) * ldb + kb); }
        }
        const char* a = sA + (t & 1) * TB; const char* b = sB + (t & 1) * TB;
#pragma unroll
        for (int kh = 0; kh < 2; ++kh) {
            bf16x8 af[4], bfr[4];
#pragma unroll
            for (int m = 0; m < 4; ++m) af[m] = *(const bf16x8*)(a + (wr * 64 + m * 16 + fr) * RS + kh * 64 + fq * 16);
#pragma unroll
            for (int n = 0; n < 4; ++n) bfr[n] = *(const bf16x8*)(b + (wc * 64 + n * 16 + fr) * RS + kh * 64 + fq * 16);
#pragma unroll
            for (int m = 0; m < 4; ++m)
#pragma unroll
                for (int n = 0; n < 4; ++n)
                    acc[m][n] = SWAP ? mfma16(bfr[n], af[m], acc[m][n]) : mfma16(af[m], bfr[n], acc[m][n]);
        }
        if (more) {
            const int o = ((t + 1) & 1) * TB;
#pragma unroll
            for (int i = 0; i < 4; ++i) { *(u32x4*)(sA + o + lo + i * 32 * RS) = ra[i]; *(u32x4*)(sB + o + lo + i * 32 * RS) = rb[i]; }
        }
        __syncthreads();
    }
    int rb_ = row0 + wr * 64, cb_ = col0 + wc * 64;
    asm volatile("" : "+s"(rb_), "+s"(cb_));
    epi(acc, rb_, cb_, fr, fq);
}

#define GLDS16(gp, lp) __builtin_amdgcn_global_load_lds((const unsigned*)(gp), (__attribute__((address_space(3))) unsigned*)(lp), 16, 0, 0)
template <bool SWAP, class EP>
DEV void gemm_tile_glds(const bf16_t* __restrict__ A, int lda, const bf16_t* __restrict__ Bt, int ldb, int K, int row0, int col0, char* smem, EP epi) {
    int tid = threadIdx.x; asm volatile("" : "+v"(tid));
    const int wid = __builtin_amdgcn_readfirstlane(tid >> 6), lane = tid & 63, wr = wid >> 1, wc = wid & 1, fr = lane & 15, fq = lane >> 4;
    constexpr int ST = 16384;
    f32x4 acc[4][4];
#pragma unroll
    for (int m = 0; m < 4; ++m)
#pragma unroll
        for (int n = 0; n < 4; ++n) acc[m][n] = (f32x4){0.f, 0.f, 0.f, 0.f};
    const int b0 = tid * 16, r0 = b0 >> 6, c0 = (b0 & 63) >> 1;
    const bf16_t* ap0 = A + (size_t)(row0 + r0) * lda + c0;
    const bf16_t* ap1 = ap0 + (size_t)64 * lda;
    const bf16_t* bp0 = Bt + (size_t)(col0 + r0) * ldb + c0;
    const bf16_t* bp1 = bp0 + (size_t)64 * ldb;
    auto issue = [&](int kt) {
        char* st = smem + (kt & 3) * ST + b0;
        GLDS16(ap0 + kt * 32, st); GLDS16(ap1 + kt * 32, st + 4096);
        GLDS16(bp0 + kt * 32, st + 8192); GLDS16(bp1 + kt * 32, st + 8192 + 4096);
    };
    const int nt = K >> 5;
    asm volatile("s_waitcnt vmcnt(0) lgkmcnt(0)\n\ts_barrier" ::: "memory");
    issue(0);
    if (nt > 1) issue(1);
    if (nt > 2) issue(2);
    for (int t = 0; t < nt; ++t) {
        if (t + 2 < nt) asm volatile("s_waitcnt vmcnt(8)" ::: "memory");
        else if (t + 1 < nt) asm volatile("s_waitcnt vmcnt(4)" ::: "memory");
        else asm volatile("s_waitcnt vmcnt(0)" ::: "memory");
        asm volatile("s_barrier" ::: "memory");
        if (t + 3 < nt) issue(t + 3);
        const char* a = smem + (t & 3) * ST; const char* b = a + 8192;
        bf16x8 af[4], bfr[4];
#pragma unroll
        for (int m = 0; m < 4; ++m) af[m] = *(const bf16x8*)(a + (wr * 64 + m * 16 + fr) * 64 + fq * 16);
#pragma unroll
        for (int n = 0; n < 4; ++n) bfr[n] = *(const bf16x8*)(b + (wc * 64 + n * 16 + fr) * 64 + fq * 16);
#pragma unroll
        for (int m = 0; m < 4; ++m)
#pragma unroll
            for (int n = 0; n < 4; ++n)
                acc[m][n] = SWAP ? mfma16(bfr[n], af[m], acc[m][n]) : mfma16(af[m], bfr[n], acc[m][n]);
    }
    int rb_ = row0 + wr * 64, cb_ = col0 + wc * 64;
    asm volatile("" : "+s"(rb_), "+s"(cb_));
    epi(acc, rb_, cb_, fr, fq);
}

template <bool SWAP, class EP>
DEV void gemm_tile_big(const bf16_t* __restrict__ A, int lda, const bf16_t* __restrict__ Bt, int ldb, int K, int row0, int col0, char* smem, EP epi) {
    int tid = threadIdx.x; asm volatile("" : "+v"(tid));
    const int wid = __builtin_amdgcn_readfirstlane(tid >> 6), lane = tid & 63, wr = wid >> 1, wc = wid & 1, fr = lane & 15, fq = lane >> 4;
    constexpr int ST = 24576;
    f32x4 acc[2][4][4];
#pragma unroll
    for (int h = 0; h < 2; ++h)
#pragma unroll
        for (int m = 0; m < 4; ++m)
#pragma unroll
            for (int n = 0; n < 4; ++n) acc[h][m][n] = (f32x4){0.f, 0.f, 0.f, 0.f};
    const int b0 = tid * 16, r0 = b0 >> 6, c0 = (b0 & 63) >> 1;
    const bf16_t* ap = A + (size_t)(row0 + r0) * lda + c0;
    const bf16_t* bp = Bt + (size_t)(col0 + r0) * ldb + c0;
    const size_t a64 = (size_t)64 * lda, b64 = (size_t)64 * ldb;
    auto issue = [&](int kt) {
        char* st = smem + (kt % 3) * ST + b0;
        GLDS16(ap + kt * 32, st); GLDS16(ap + a64 + kt * 32, st + 4096);
        GLDS16(ap + 2 * a64 + kt * 32, st + 8192); GLDS16(ap + 3 * a64 + kt * 32, st + 12288);
        GLDS16(bp + kt * 32, st + 16384); GLDS16(bp + b64 + kt * 32, st + 16384 + 4096);
    };
    const int nt = K >> 5;
    asm volatile("s_waitcnt vmcnt(0) lgkmcnt(0)\n\ts_barrier" ::: "memory");
    issue(0);
    if (nt > 1) issue(1);
    for (int t = 0; t < nt; ++t) {
        if (t + 1 < nt) asm volatile("s_waitcnt vmcnt(6)" ::: "memory");
        else asm volatile("s_waitcnt vmcnt(0)" ::: "memory");
        asm volatile("s_barrier" ::: "memory");
        if (t + 2 < nt) issue(t + 2);
        const char* a = smem + (t % 3) * ST; const char* b = a + 16384;
        bf16x8 bfr[4];
#pragma unroll
        for (int n = 0; n < 4; ++n) bfr[n] = *(const bf16x8*)(b + (wc * 64 + n * 16 + fr) * 64 + fq * 16);
#pragma unroll
        for (int h = 0; h < 2; ++h) {
            bf16x8 af[4];
#pragma unroll
            for (int m = 0; m < 4; ++m) af[m] = *(const bf16x8*)(a + (wr * 128 + h * 64 + m * 16 + fr) * 64 + fq * 16);
#pragma unroll
            for (int m = 0; m < 4; ++m)
#pragma unroll
                for (int n = 0; n < 4; ++n)
                    acc[h][m][n] = SWAP ? mfma16(bfr[n], af[m], acc[h][m][n]) : mfma16(af[m], bfr[n], acc[h][m][n]);
        }
    }
    int rb_ = row0 + wr * 128, cb_ = col0 + wc * 64;
    asm volatile("" : "+s"(rb_), "+s"(cb_));
    epi(acc[0], rb_, cb_, fr, fq);
    epi(acc[1], rb_ + 64, cb_, fr, fq);
}

DEV void pq_scores_tile(const bf16_t* __restrict__ A, int lda, const bf16_t* __restrict__ Bt, int ldb, int K, int row0, int g,
                        const float* __restrict__ ssq2, const bf16_t* __restrict__ keysb, bf16_t* __restrict__ scores, char* smem) {
    int tid = threadIdx.x; asm volatile("" : "+v"(tid));
    const int wid = __builtin_amdgcn_readfirstlane(tid >> 6), lane = tid & 63, wr = wid >> 1, wc = wid & 1, fr = lane & 15, fq = lane >> 4;
    constexpr int ST = 24576;
    const int col0 = g * 128;
    f32x4 acc[2][4][4];
#pragma unroll
    for (int h = 0; h < 2; ++h)
#pragma unroll
        for (int m = 0; m < 4; ++m)
#pragma unroll
            for (int n = 0; n < 4; ++n) acc[h][m][n] = (f32x4){0.f, 0.f, 0.f, 0.f};
    const int b0 = tid * 16, r0 = b0 >> 6, c0 = (b0 & 63) >> 1;
    const bf16_t* ap = A + (size_t)(row0 + r0) * lda + c0;
    const bf16_t* bp = Bt + (size_t)(col0 + r0) * ldb + c0;
    const size_t a64 = (size_t)64 * lda, b64 = (size_t)64 * ldb;
    auto issue = [&](int kt) {
        char* st = smem + (kt % 3) * ST + b0;
        GLDS16(ap + kt * 32, st); GLDS16(ap + a64 + kt * 32, st + 4096);
        GLDS16(ap + 2 * a64 + kt * 32, st + 8192); GLDS16(ap + 3 * a64 + kt * 32, st + 12288);
        GLDS16(bp + kt * 32, st + 16384); GLDS16(bp + b64 + kt * 32, st + 16384 + 4096);
    };
    const int nt = K >> 5;
    asm volatile("s_waitcnt vmcnt(0) lgkmcnt(0)\n\ts_barrier" ::: "memory");
    issue(0);
    if (nt > 1) issue(1);
    for (int t = 0; t < nt; ++t) {
        if (t + 1 < nt) asm volatile("s_waitcnt vmcnt(6)" ::: "memory");
        else asm volatile("s_waitcnt vmcnt(0)" ::: "memory");
        asm volatile("s_barrier" ::: "memory");
        if (t + 2 < nt) issue(t + 2);
        const char* a = smem + (t % 3) * ST; const char* b = a + 16384;
        bf16x8 bfr[4];
#pragma unroll
        for (int n = 0; n < 4; ++n) bfr[n] = *(const bf16x8*)(b + (wc * 64 + n * 16 + fr) * 64 + fq * 16);
#pragma unroll
        for (int h = 0; h < 2; ++h) {
            bf16x8 af[4];
#pragma unroll
            for (int m = 0; m < 4; ++m) af[m] = *(const bf16x8*)(a + (wr * 128 + h * 64 + m * 16 + fr) * 64 + fq * 16);
#pragma unroll
            for (int m = 0; m < 4; ++m)
#pragma unroll
                for (int n = 0; n < 4; ++n) acc[h][m][n] = mfma16(bfr[n], af[m], acc[h][m][n]);
        }
    }
    u32x2 pk[2][4][4];
#pragma unroll
    for (int h = 0; h < 2; ++h)
#pragma unroll
        for (int m = 0; m < 4; ++m) {
            const int row = row0 + wr * 128 + h * 64 + m * 16 + fr;
            const float rs = rsqrtf(ssq2[row] * (1.0f / 1024.0f) + EPS);
#pragma unroll
            for (int n = 0; n < 4; ++n) {
                const f32x4 v = acc[h][m][n] * rs;
                pk[h][m][n].x = cvt_pk_bf16(v[0], v[1]); pk[h][m][n].y = cvt_pk_bf16(v[2], v[3]);
            }
        }
    constexpr int RS2 = 272;
    char* sA2 = smem; char* sKy = smem + 128 * RS2;
    asm volatile("s_waitcnt lgkmcnt(0)\n\ts_barrier" ::: "memory");
    {
        const bf16_t* kg = keysb + (size_t)g * 128 * 128;
#pragma unroll
        for (int i = 0; i < 8; ++i) { const int c = tid + i * 256, key = c >> 4, cc = c & 15; *(u32x4*)(sKy + key * RS2 + cc * 16) = *(const u32x4*)(kg + (size_t)key * 128 + cc * 8); }
    }
#pragma unroll 1
    for (int half = 0; half < 2; ++half) {
        if (wr == half) {
#pragma unroll
            for (int h = 0; h < 2; ++h)
#pragma unroll
                for (int m = 0; m < 4; ++m)
#pragma unroll
                    for (int n = 0; n < 4; ++n)
                        *(u32x2*)(sA2 + (h * 64 + m * 16 + fr) * RS2 + (wc * 64 + n * 16 + fq * 4) * 2) = pk[h][m][n];
        }
        __syncthreads();
        f32x4 acc2[4][4];
#pragma unroll
        for (int m = 0; m < 4; ++m)
#pragma unroll
            for (int n = 0; n < 4; ++n) acc2[m][n] = (f32x4){0.f, 0.f, 0.f, 0.f};
#pragma unroll
        for (int ks = 0; ks < 4; ++ks) {
            bf16x8 af[4], bfr[4];
#pragma unroll
            for (int m = 0; m < 4; ++m) af[m] = *(const bf16x8*)(sA2 + (wr * 64 + m * 16 + fr) * RS2 + ks * 64 + fq * 16);
#pragma unroll
            for (int n = 0; n < 4; ++n) bfr[n] = *(const bf16x8*)(sKy + (wc * 64 + n * 16 + fr) * RS2 + ks * 64 + fq * 16);
#pragma unroll
            for (int m = 0; m < 4; ++m)
#pragma unroll
                for (int n = 0; n < 4; ++n) acc2[m][n] = mfma16(bfr[n], af[m], acc2[m][n]);
        }
#pragma unroll
        for (int m = 0; m < 4; ++m) {
            const int row = row0 + half * 128 + wr * 64 + m * 16 + fr;
#pragma unroll
            for (int n = 0; n < 4; ++n) {
                const f32x4 v = acc2[m][n];
                u32x2 w; w.x = cvt_pk_bf16(v[0], v[1]); w.y = cvt_pk_bf16(v[2], v[3]);
                *(u32x2*)(scores + (size_t)row * 2048 + col0 + wc * 64 + n * 16 + fq * 4) = w;
            }
        }
        __syncthreads();
    }
}

struct PlainA {
    const bf16_t* A; int lda;
    DEV u32x4 operator()(int row, int k) const { return *(const u32x4*)(A + (size_t)row * lda + k); }
};

DEV void tr_tile(const float* __restrict__ src, int ldn, bf16_t* __restrict__ dst, int ldk, int k0, int n0, int drow0,
                 const float* __restrict__ gain, float* tileS) {
    int tid = threadIdx.x; asm volatile("" : "+v"(tid));
    __syncthreads();
#pragma unroll 4
    for (int i = 0; i < 16; ++i) {
        const int kk = i * 4 + (tid >> 6), nn = tid & 63;
        float v = src[(size_t)(k0 + kk) * ldn + n0 + nn];
        if (gain) v *= gain[k0 + kk];
        tileS[kk * 65 + nn] = v;
    }
    __syncthreads();
#pragma unroll 4
    for (int i = 0; i < 16; ++i) {
        const int nn = i * 4 + (tid >> 6), kk = tid & 63;
        const float v = tileS[kk * 65 + nn];
        dst[(size_t)(drow0 + nn) * ldk + k0 + kk] = (bf16_t)(cvt_pk_bf16(v, 0.f) & 0xffffu);
    }
}

template <int DQK, int DV, bool PREF, int QB>
DEV void attn_item(const bf16_t* __restrict__ q, int ldq, const bf16_t* __restrict__ k, int ldk,
                   const bf16_t* __restrict__ vT, int ldv, int ntiles, int tiles_lo, bf16_t* __restrict__ out, int ldo, char* smem) {
    constexpr int KS = DQK / 32, DB = DV / 16;
    constexpr int KSTR = DQK * 2 + 16;
    constexpr int VSTR = 144;
    constexpr int KCH = 64 * DQK / 8 / 256, VCH = DV * 64 / 8 / 256, KCW = DQK / 8;
    char* sK = smem; char* sV = smem + 64 * KSTR;
    int tid = threadIdx.x; asm volatile("" : "+v"(tid));
    const int wid = __builtin_amdgcn_readfirstlane(tid >> 6), lane = tid & 63, fr = lane & 15, fq = lane >> 4;
    const int my_tiles = (wid < 2) ? tiles_lo : ntiles;
    bf16x8 qf[QB][KS];
#pragma unroll
    for (int qi = 0; qi < QB; ++qi) {
        const bf16_t* qrow = q + (size_t)(wid * 16 * QB + qi * 16 + fr) * ldq;
#pragma unroll
        for (int ks = 0; ks < KS; ++ks) qf[qi][ks] = *(const bf16x8*)(qrow + ks * 32 + fq * 8);
    }
    f32x4 o[QB][DB];
    float mrow[QB], lsum[QB];
#pragma unroll
    for (int qi = 0; qi < QB; ++qi) {
        mrow[qi] = -1e30f; lsum[qi] = 0.f;
#pragma unroll
        for (int db = 0; db < DB; ++db) o[qi][db] = (f32x4){0.f, 0.f, 0.f, 0.f};
    }
    constexpr bool PREFV = PREF && (DV <= 128);
    u32x4 kr[PREF ? KCH : 1], vr[PREFV ? VCH : 1];
    if (PREF) {
#pragma unroll
        for (int i = 0; i < KCH; ++i) { const int c = tid + i * 256, key = c / KCW, cc = c % KCW; kr[PREF ? i : 0] = *(const u32x4*)(k + (size_t)key * ldk + cc * 8); }
        if (PREFV) {
#pragma unroll
            for (int i = 0; i < VCH; ++i) { const int c = tid + i * 256, d = c >> 3, cc = c & 7; vr[PREFV ? i : 0] = *(const u32x4*)(vT + (size_t)d * ldv + cc * 8); }
        }
    }
    for (int kt = 0; kt < ntiles; ++kt) {
        __syncthreads();
        {
            const int kn = kt * 64;
            if (PREF) {
#pragma unroll
                for (int i = 0; i < KCH; ++i) { const int c = tid + i * 256, key = c / KCW, cc = c % KCW; *(u32x4*)(sK + key * KSTR + cc * 16) = kr[PREF ? i : 0]; }
            } else {
#pragma unroll 4
                for (int i = 0; i < KCH; ++i) { const int c = tid + i * 256, key = c / KCW, cc = c % KCW; *(u32x4*)(sK + key * KSTR + cc * 16) = *(const u32x4*)(k + (size_t)(kn + key) * ldk + cc * 8); }
            }
            if (PREFV) {
#pragma unroll
                for (int i = 0; i < VCH; ++i) { const int c = tid + i * 256, d = c >> 3, cc = c & 7; *(u32x4*)(sV + d * VSTR + cc * 16) = vr[PREFV ? i : 0]; }
            } else {
#pragma unroll 4
                for (int i = 0; i < VCH; ++i) { const int c = tid + i * 256, d = c >> 3, cc = c & 7; *(u32x4*)(sV + d * VSTR + cc * 16) = *(const u32x4*)(vT + (size_t)d * ldv + kn + cc * 8); }
            }
        }
        __syncthreads();
        if (PREF && kt + 1 < ntiles) {
            const int kn = (kt + 1) * 64;
#pragma unroll
            for (int i = 0; i < KCH; ++i) { const int c = tid + i * 256, key = c / KCW, cc = c % KCW; kr[PREF ? i : 0] = *(const u32x4*)(k + (size_t)(kn + key) * ldk + cc * 8); }
            if (PREFV) {
#pragma unroll
                for (int i = 0; i < VCH; ++i) { const int c = tid + i * 256, d = c >> 3, cc = c & 7; vr[PREFV ? i : 0] = *(const u32x4*)(vT + (size_t)d * ldv + kn + cc * 8); }
            }
        }
        if (kt < my_tiles) {
            f32x4 s[QB][4];
#pragma unroll
            for (int kb = 0; kb < 4; ++kb) {
#pragma unroll
                for (int qi = 0; qi < QB; ++qi) s[qi][kb] = (f32x4){0.f, 0.f, 0.f, 0.f};
#pragma unroll
                for (int ks = 0; ks < KS; ++ks) {
                    const bf16x8 kf = *(const bf16x8*)(sK + (kb * 16 + fr) * KSTR + ks * 64 + fq * 16);
#pragma unroll
                    for (int qi = 0; qi < QB; ++qi) s[qi][kb] = mfma16(kf, qf[qi][ks], s[qi][kb]);
                }
            }
            bf16x8 pf[QB][2];
#pragma unroll
            for (int qi = 0; qi < QB; ++qi) {
                float mx = -1e30f;
#pragma unroll
                for (int kb = 0; kb < 4; ++kb)
#pragma unroll
                    for (int j = 0; j < 4; ++j) mx = fmaxf(mx, s[qi][kb][j]);
                mx = fmaxf(mx, __shfl_xor(mx, 16)); mx = fmaxf(mx, __shfl_xor(mx, 32));
                const float mnew = fmaxf(mrow[qi], mx);
                const float alpha = __builtin_amdgcn_exp2f(mrow[qi] - mnew);
                mrow[qi] = mnew;
                float ps = 0.f;
#pragma unroll
                for (int kb = 0; kb < 4; ++kb)
#pragma unroll
                    for (int j = 0; j < 4; ++j) { const float e = __builtin_amdgcn_exp2f(s[qi][kb][j] - mnew); s[qi][kb][j] = e; ps += e; }
                lsum[qi] = lsum[qi] * alpha + ps;
#pragma unroll
                for (int db = 0; db < DB; ++db) o[qi][db] *= alpha;
#pragma unroll
                for (int g = 0; g < 2; ++g) {
                    u32x4 w;
                    w.x = cvt_pk_bf16(s[qi][2 * g][0], s[qi][2 * g][1]); w.y = cvt_pk_bf16(s[qi][2 * g][2], s[qi][2 * g][3]);
                    w.z = cvt_pk_bf16(s[qi][2 * g + 1][0], s[qi][2 * g + 1][1]); w.w = cvt_pk_bf16(s[qi][2 * g + 1][2], s[qi][2 * g + 1][3]);
                    pf[qi][g] = as_bf16x8(w);
                }
            }
#pragma unroll
            for (int db = 0; db < DB; ++db) {
#pragma unroll
                for (int g = 0; g < 2; ++g) {
                    const u32x2 v0 = *(const u32x2*)(sV + (db * 16 + fr) * VSTR + ((2 * g) * 16 + fq * 4) * 2);
                    const u32x2 v1 = *(const u32x2*)(sV + (db * 16 + fr) * VSTR + ((2 * g + 1) * 16 + fq * 4) * 2);
                    u32x4 w; w.x = v0.x; w.y = v0.y; w.z = v1.x; w.w = v1.y;
#pragma unroll
                    for (int qi = 0; qi < QB; ++qi) o[qi][db] = mfma16(as_bf16x8(w), pf[qi][g], o[qi][db]);
                }
            }
        }
    }
#pragma unroll
    for (int qi = 0; qi < QB; ++qi) {
        float l = lsum[qi];
        l += __shfl_xor(l, 16); l += __shfl_xor(l, 32);
        const float inv = 1.0f / l;
        bf16_t* orow = out + (size_t)(wid * 16 * QB + qi * 16 + fr) * ldo + fq * 4;
#pragma unroll
        for (int db = 0; db < DB; ++db) {
            u32x2 w; w.x = cvt_pk_bf16(o[qi][db][0] * inv, o[qi][db][1] * inv); w.y = cvt_pk_bf16(o[qi][db][2] * inv, o[qi][db][3] * inv);
            *(u32x2*)(orow + db * 16) = w;
        }
    }
}

#define XB_TMO      128
#define XB_XCNT(j)  (256  + 64 * (j))
#define XB_XSUB(j)  (1280 + 64 * (j))
#define XB_XGEN(j)  (2304 + 64 * (j))
#define XB_TOP      3328
#define XB_TOPGEN   3392
#define XCD_BAR_WORDS 3456
#define XB_SPIN_CAP (1u << 18)
#define LAS __attribute__((address_space(3)))
DEV unsigned xb_ld(unsigned* p)              { return __hip_atomic_load(p, __ATOMIC_RELAXED, __HIP_MEMORY_SCOPE_AGENT); }
DEV unsigned xb_add(unsigned* p, unsigned v) { return __hip_atomic_fetch_add(p, v, __ATOMIC_RELAXED, __HIP_MEMORY_SCOPE_AGENT); }
DEV unsigned xb_xcc_id() { return (unsigned)__builtin_amdgcn_s_getreg((3 << 11) | 20) & 0xFu; }
#define XB_SPIN(cond, bar) do { unsigned _sp = 0; while (cond) { __builtin_amdgcn_s_sleep(1); \
    if ((++_sp & 255u) == 0u) { if (xb_ld(&(bar)[XB_TMO])) break; if (_sp > XB_SPIN_CAP) { atomicAdd(&(bar)[XB_TMO], 1u); break; } } } } while (0)
struct XcdBarrier { unsigned* bar; unsigned x; volatile LAS unsigned* st; };
DEV XcdBarrier xcd_barrier_post(unsigned* bar, volatile LAS unsigned* st) {
    XcdBarrier b; b.bar = bar; b.x = xb_xcc_id(); b.st = st;
    if (threadIdx.x == 0) (void)xb_add(&bar[XB_XCNT(b.x)], 1u);
    return b;
}
DEV void xcd_barrier_complete(unsigned* bar, unsigned x, unsigned& nloc, unsigned& nx) {
    const unsigned G = gridDim.x * gridDim.y * gridDim.z;
    unsigned sum, cnt, mine, sp = 0u;
    for (;;) {
        sum = 0u; cnt = 0u; mine = 0u;
#pragma unroll
        for (unsigned j = 0; j < 16; ++j) { const unsigned c = xb_ld(&bar[XB_XCNT(j)]); sum += c; cnt += (c > 0u) ? 1u : 0u; mine = (j == x) ? c : mine; }
        if (sum == G) break;
        __builtin_amdgcn_s_sleep(1);
        if ((++sp & 255u) == 0u) { if (xb_ld(&bar[XB_TMO])) break; if (sp > XB_SPIN_CAP) { atomicAdd(&bar[XB_TMO], 1u); break; } }
    }
    nloc = mine > 0u ? mine : 1u; nx = cnt > 0u ? cnt : 1u;
}
DEV void xcd_barrier(const XcdBarrier& b) {
    asm volatile("s_waitcnt vmcnt(0)" ::: "memory");
    __syncthreads();
    if (threadIdx.x == 0) {
        unsigned* bar = b.bar;
        __builtin_amdgcn_s_waitcnt(0);
        unsigned nloc = b.st[0], nx = b.st[1];
        if (nloc == 0u) { xcd_barrier_complete(bar, b.x, nloc, nx); b.st[0] = nloc; b.st[1] = nx; }
        const unsigned old = xb_add(&bar[XB_XSUB(b.x)], 1u);
        const unsigned gen = old / nloc;
        if (old + 1u == (gen + 1u) * nloc) {
            __builtin_amdgcn_fence(__ATOMIC_RELEASE, "agent");
            asm volatile("s_waitcnt vmcnt(0)" ::: "memory");
            const unsigned og = xb_add(&bar[XB_TOP], 1u);
            const unsigned tg = og / nx;
            if (og + 1u == (tg + 1u) * nx) xb_add(&bar[XB_TOPGEN], 1u);
            else XB_SPIN(xb_ld(&bar[XB_TOPGEN]) == tg, bar);
            __builtin_amdgcn_fence(__ATOMIC_ACQUIRE, "agent");
            xb_add(&bar[XB_XGEN(b.x)], 1u);
            asm volatile("s_waitcnt vmcnt(0)" ::: "memory");
        } else {
            XB_SPIN(xb_ld(&bar[XB_XGEN(b.x)]) == gen, bar);
            __builtin_amdgcn_fence(__ATOMIC_ACQUIRE, "agent");
            asm volatile("s_waitcnt vmcnt(0)" ::: "memory");
        }
    }
    __syncthreads();
}

DEV unsigned ordkey(float f) { const unsigned u = __float_as_uint(f); return (u & 0x80000000u) ? ~u : (u | 0x80000000u); }
DEV float unordkey(unsigned k) { const unsigned u = (k & 0x80000000u) ? (k & 0x7fffffffu) : ~k; return __uint_as_float(u); }
#define TOPK_INSERT(L, xk) { unsigned x_ = (xk); _Pragma("unroll") for (int s_ = 0; s_ < 16; ++s_) { const unsigned hi_ = max(L[s_], x_); x_ = min(L[s_], x_); L[s_] = hi_; } }
DEV unsigned byte_lookup(unsigned p0, unsigned p1, unsigned p2, unsigned p3, int a) {
    const unsigned w = (a < 8) ? ((a < 4) ? p0 : p1) : ((a < 12) ? p2 : p3);
    return (w >> ((a & 3) * 8)) & 0xffu;
}

DEV void grid_barrier(unsigned* bar, unsigned nblocks, unsigned& gen) {
    __threadfence();
    __syncthreads();
    gen += 1;
    if (threadIdx.x == 0) {
        const unsigned target = gen * nblocks;
        __hip_atomic_fetch_add(bar, 1u, __ATOMIC_RELEASE, __HIP_MEMORY_SCOPE_AGENT);
        while (__hip_atomic_load(bar, __ATOMIC_ACQUIRE, __HIP_MEMORY_SCOPE_AGENT) < target) __builtin_amdgcn_s_sleep(2);
    }
    __syncthreads();
    __threadfence();
}
#ifdef TIMED_MASK
#define GRID_SYNC() do { xcd_barrier(xb); { const long long tn_ = (long long)__builtin_amdgcn_s_memrealtime(); if ((TIMED_MASK >> ph_idx) & 1) t_acc += tn_ - t_last; t_last = tn_; ph_idx++; } } while (0)
#else
#define GRID_SYNC() xcd_barrier(xb)
#endif
#ifndef PH
#define PH 0x0FFF
#endif
constexpr int SMEM_BYTES = 4 * 128 * 144;

__global__ void __launch_bounds__(256, 2) fwd_megakernel(Params P) {
    cg::grid_group grid = cg::this_grid();
    __shared__ __attribute__((aligned(16))) char smem[SMEM_BYTES];
    __shared__ int s_item;
    const int nb = gridDim.x, bid = blockIdx.x;
    const int gsz = nb * 256;
    __shared__ uint4 xb_words;
    if (threadIdx.x == 0) xb_words = make_uint4(0u, 0u, 0u, 0u);
    __syncthreads();
    if (P.ws == nullptr) grid.sync();
    XcdBarrier xb = xcd_barrier_post((unsigned*)(P.ws + O_XBAR), (volatile LAS unsigned*)&xb_words);
#ifdef TIMED_MASK
    long long t_acc = 0, t_last = (long long)__builtin_amdgcn_s_memrealtime(); int ph_idx = 0;
#endif
#define XCD_TILE_LOOP(NM, NN, tm, tn) \
    for (int q_ = (bid % (nb >> 3)), R_ = (NM) >> 3, tm, tn; q_ < R_ * (NN) && ((tn = q_ / R_), (tm = (bid / (nb >> 3)) * R_ + q_ % R_), true); q_ += (nb >> 3))
#define PHASE_IDS int tid = threadIdx.x; asm volatile("" : "+v"(tid)); const int wid = __builtin_amdgcn_readfirstlane(tid >> 6), lane = tid & 63; const int gtid = bid * 256 + tid; (void)wid; (void)lane; (void)gtid;
    char* ws = P.ws;
    float* ssq0 = (float*)(ws + O_SSQ);
    float* ssqm = (float*)(ws + O_SSQ + 65536);
    float* ssqq = (float*)(ws + O_SSQ + 2 * 65536);
    float* ssqkv = (float*)(ws + O_SSQ + 3 * 65536);
    float* ssq1 = (float*)(ws + O_SSQ + 4 * 65536);
    float* ssq2 = (float*)(ws + O_SSQ + 5 * 65536);
    int* counters = (int*)(ws + O_CNT);
    float2* ropetab = (float2*)(ws + O_ROPE);
    bf16_t* p = (bf16_t*)(ws + O_P);
    bf16_t* qmla = (bf16_t*)P.out;
    bf16_t* kfull = (bf16_t*)((char*)P.out + 24 * MB);
    bf16_t* vTm = (bf16_t*)((char*)P.out + 48 * MB);

    auto do_tr = [&](int tile) {
        float* tileS = (float*)smem;

            const float* src; int ldn; bf16_t* dst; int ldk; int KT; int loc; const float* gain = nullptr; int drow_add = 0;
            bool ukv = false;
            if (tile < 560) { loc = tile; src = P.w_in; ldn = 2240; dst = (bf16_t*)(ws + O_WINT); ldk = 1024; KT = 16; gain = P.norm_mix_g; }
            else if (tile < 608) { loc = tile - 560; src = P.w_uq; ldn = 768; dst = (bf16_t*)(ws + O_WUQT); ldk = 256; KT = 4; gain = P.q_norm_g; }
            else if (tile < 640) { loc = tile - 608; src = P.w_ukv; ldn = 1024; dst = (bf16_t*)(ws + O_WUKT); ldk = 128; KT = 2; gain = P.kv_norm_g; ukv = true; }
            else if (tile < 648) { loc = tile - 640; src = P.rw_w_up; ldn = 512; dst = (bf16_t*)(ws + O_WUPT); ldk = 64; KT = 1; }
            else if (tile < 656) { loc = tile - 648; src = P.rw_a_up; ldn = 512; dst = (bf16_t*)(ws + O_AUPT); ldk = 64; KT = 1; }
            else if (tile < 672) { loc = tile - 656; src = P.rw_g_up; ldn = 512; dst = (bf16_t*)(ws + O_GUPT); ldk = 128; KT = 2; }
            else if (tile < 928) { loc = tile - 672; src = P.w_out; ldn = 1024; dst = (bf16_t*)(ws + O_WOUTT); ldk = 1024; KT = 16; }
            else if (tile < 1184) { loc = tile - 928; src = P.xa_wq; ldn = 1024; dst = (bf16_t*)(ws + O_XAQT); ldk = 1024; KT = 16; gain = P.norm_xa_g; }
            else if (tile < 1440) { loc = tile - 1184; src = P.xa_wk; ldn = 1024; dst = (bf16_t*)(ws + O_XAKVT); ldk = 1024; KT = 16; gain = P.norm_mem_g; }
            else if (tile < 1696) { loc = tile - 1440; src = P.xa_wv; ldn = 1024; dst = (bf16_t*)(ws + O_XAKVT); ldk = 1024; KT = 16; gain = P.norm_mem_g; drow_add = 1024; }
            else if (tile < 1952) { loc = tile - 1696; src = P.xa_wo; ldn = 1024; dst = (bf16_t*)(ws + O_XAOT); ldk = 1024; KT = 16; }
            else { loc = tile - 1952; src = P.peer_wq; ldn = 2048; dst = (bf16_t*)(ws + O_PWQT); ldk = 1024; KT = 16; gain = P.norm_ffn_g; }
            const int kt = loc % KT, ntile = loc / KT;
            int n0 = ntile * 64, drow0 = n0 + drow_add;
            if (ukv) {
                const int h = n0 >> 8, part = (n0 >> 7) & 1, d0 = n0 & 127;
                if (part) dst = (bf16_t*)(ws + O_WUVT);
                drow0 = h * 128 + d0;
            }
            tr_tile(src, ldn, dst, ldk, kt * 64, n0, drow0, gain, tileS);
            };
    auto convert_experts = [&](int r0, int r1, int wid, int lane) {
        unsigned char* e8u = (unsigned char*)(ws + O_EUB);
        unsigned char* e8v = (unsigned char*)(ws + O_EVB);
        float* esinv = (float*)(ws + O_SSQ + 6 * 65536);
        for (int r = r0 + wid; r < r1; r += 4) {
            const float* src = (r < 16384) ? (P.expert_u + (size_t)r * 1024) : (P.expert_v + (size_t)(r - 16384) * 1024);
            unsigned char* dst = (r < 16384) ? (e8u + (size_t)r * 1024) : (e8v + (size_t)(r - 16384) * 1024);
            f32x4 v[4]; float amax = 0.f;
#pragma unroll
            for (int i = 0; i < 4; ++i) {
                v[i] = *(const f32x4*)(src + i * 256 + lane * 4);
                amax = fmaxf(amax, fmaxf(fmaxf(fabsf(v[i][0]), fabsf(v[i][1])), fmaxf(fabsf(v[i][2]), fabsf(v[i][3]))));
            }
#pragma unroll
            for (int o = 32; o >= 1; o >>= 1) amax = fmaxf(amax, __shfl_xor(amax, o));
            amax = fmaxf(amax, 1e-30f);
            const float sc = 240.0f / amax;
#pragma unroll
            for (int i = 0; i < 4; ++i) {
                int w = 0;
                w = __builtin_amdgcn_cvt_pk_fp8_f32(v[i][0] * sc, v[i][1] * sc, w, false);
                w = __builtin_amdgcn_cvt_pk_fp8_f32(v[i][2] * sc, v[i][3] * sc, w, true);
                *(int*)(dst + i * 256 + lane * 4) = w;
            }
            if (lane == 0) esinv[r] = amax * (1.0f / 240.0f);
        }
    };
    if (PH & (1 << 0)) {
        PHASE_IDS
        for (int tile = bid; tile < 672 + 512; tile += nb) do_tr(tile < 672 ? tile : tile + 512);
        bf16_t* xb = (bf16_t*)(ws + O_XB);
        bf16_t* memb = (bf16_t*)(ws + O_MEMB);
        for (int r = bid * 4 + wid; r < T + 2048; r += nb * 4) {
            const float* srow = (r < T) ? (P.x + (size_t)r * 1024) : (P.mem + (size_t)(r - T) * 1024);
            bf16_t* drow = (r < T) ? (xb + (size_t)r * 1024) : (memb + (size_t)(r - T) * 1024);
            float ss = 0.f;
#pragma unroll
            for (int i = 0; i < 4; ++i) {
                const f32x4 v = *(const f32x4*)(srow + i * 256 + lane * 4);
                ss += v[0] * v[0] + v[1] * v[1] + v[2] * v[2] + v[3] * v[3];
                u32x2 w; w.x = cvt_pk_bf16(v[0], v[1]); w.y = cvt_pk_bf16(v[2], v[3]);
                *(u32x2*)(drow + i * 256 + lane * 4) = w;
            }
            ss = wave_sum(ss);
            if (lane == 0) { if (r < T) ssq0[r] = ss; else ssqm[r - T] = ss; }
        }
        for (int i = gtid; i < T * 32; i += gsz) {
            const int row = i >> 5, f = i & 31;
            const float inv = exp2f(-(float)f * (13.287712379549449f / 32.0f));
            const float ang = (float)P.pos[row] * inv;
            ropetab[i] = make_float2(cosf(ang), sinf(ang));
        }
        for (int i = gtid; i < T; i += gsz) { ssqq[i] = 0.f; ssqkv[i] = 0.f; ssq1[i] = 0.f; ssq2[i] = 0.f; }
        if (gtid < 64) counters[gtid] = 0;
        {
            bf16_t* keysb = (bf16_t*)(ws + O_KEYS);
            for (int i = gtid; i < 16 * 128 * 128 / 4; i += gsz) {
                const f32x4 v = *(const f32x4*)(P.peer_keys + (size_t)i * 4);
                u32x2 w; w.x = cvt_pk_bf16(v[0], v[1]); w.y = cvt_pk_bf16(v[2], v[3]);
                *(u32x2*)(keysb + (size_t)i * 4) = w;
            }
        }
        {
            u32x4* z = (u32x4*)(ws + O_WINT + (size_t)2240 * 1024 * 2);
            for (int i = gtid; i < 64 * 1024 * 2 / 16; i += gsz) z[i] = (u32x4){0u, 0u, 0u, 0u};
        }
    }
    GRID_SYNC();

    if (PH & (1 << 1)) {
        PHASE_IDS
        const bf16_t* xb = (const bf16_t*)(ws + O_XB);
        const bf16_t* memb = (const bf16_t*)(ws + O_MEMB);
        const bf16_t* winT = (const bf16_t*)(ws + O_WINT);
        const bf16_t* xakvT = (const bf16_t*)(ws + O_XAKVT);
        bf16_t* km = (bf16_t*)(ws + O_KM);
        bf16_t* vmT = (bf16_t*)(ws + O_VMT);
        auto p_epi = [&](const f32x4 (&acc)[4][4], int rbase, int cbase, int fr, int fq) {
#pragma unroll
                        for (int m = 0; m < 4; ++m) {
                            const int row = rbase + m * 16 + fr;
                            const float rs = rsqrtf(ssq0[row] * (1.0f / 1024.0f) + EPS);
                            float ss = 0.f;
#pragma unroll
                            for (int n = 0; n < 4; ++n) {
                                const f32x4 v = acc[m][n] * rs;
                                ss += v[0] * v[0] + v[1] * v[1] + v[2] * v[2] + v[3] * v[3];
                                u32x2 w; w.x = cvt_pk_bf16(v[0], v[1]); w.y = cvt_pk_bf16(v[2], v[3]);
                                *(u32x2*)(p + (size_t)row * 2304 + cbase + n * 16 + fq * 4) = w;
                            }
                            if (cbase < 384) {
                                ss += __shfl_xor(ss, 16); ss += __shfl_xor(ss, 32);
                                if (fq == 0) atomicAdd((cbase < 256) ? &ssqq[row] : &ssqkv[row], ss);
                            }
                        }
                    };
        XCD_TILE_LOOP(64, 16, tm, tn) { gemm_tile_big<true>(xb, 1024, winT, 1024, 1024, tm * 256, tn * 128, smem, p_epi); }
        for (int item = bid; item < 256; item += nb) { const int tm = item >> 1, tn = 16 + (item & 1); gemm_tile_glds<true>(xb, 1024, winT, 1024, 1024, tm * 128, tn * 128, smem, p_epi); }
    }
    GRID_SYNC();

    if (PH & (1 << 2)) {
        PHASE_IDS
        const bf16_t* wuqT = (const bf16_t*)(ws + O_WUQT);
        const bf16_t* wukT = (const bf16_t*)(ws + O_WUKT);
        const bf16_t* wuvT = (const bf16_t*)(ws + O_WUVT);
        const bf16_t* wupT = (const bf16_t*)(ws + O_WUPT);
        const bf16_t* aupT = (const bf16_t*)(ws + O_AUPT);
        const bf16_t* gupT = (const bf16_t*)(ws + O_GUPT);
        bf16_t* gbuf = (bf16_t*)(ws + O_G);
        bf16_t* rwr = (bf16_t*)(ws + O_RW_R);
        bf16_t* rwk = (bf16_t*)(ws + O_RW_K);
        bf16_t* rwv = (bf16_t*)(ws + O_RW_V);
        bf16_t* rwkk = (bf16_t*)(ws + O_RW_KK);
        bf16_t* rwka = (bf16_t*)(ws + O_RW_KA);
        float* decay = (float*)(ws + O_DECAY);
        const float QSCALE = 0.07216878364870322f * 1.4426950408889634f;
        const int N0 = 64 * 6, N1 = N0 + 256, N2 = N1 + 256, N3 = N2 + 512, N4 = N3 + 512, N5 = N4 + 512;
        auto shifted8 = [&](int row, int pc, int j0, float (&o)[8]) {
            const u32x4 cur = *(const u32x4*)(p + (size_t)row * 2304 + pc);
            u32x4 prv = (u32x4){0u, 0u, 0u, 0u};
            if (row & 2047) prv = *(const u32x4*)(p + (size_t)(row - 1) * 2304 + pc);
            const f32x4 m0 = *(const f32x4*)(P.shift_mu + j0), m1 = *(const f32x4*)(P.shift_mu + j0 + 4);
            const unsigned cu[4] = {cur.x, cur.y, cur.z, cur.w}, pu[4] = {prv.x, prv.y, prv.z, prv.w};
#pragma unroll
            for (int i = 0; i < 4; ++i) {
                const float c0 = bf_lo(cu[i]), c1 = bf_hi(cu[i]), p0 = bf_lo(pu[i]), p1 = bf_hi(pu[i]);
                const float mu0 = (i < 2) ? m0[2 * i] : m1[2 * i - 4], mu1 = (i < 2) ? m0[2 * i + 1] : m1[2 * i - 3];
                o[2 * i] = c0 + (p0 - c0) * mu0; o[2 * i + 1] = c1 + (p1 - c1) * mu1;
            }
        };
        auto shifted4 = [&](int row, int pc, int j0, f32x4& o) {
            const u32x2 cur = *(const u32x2*)(p + (size_t)row * 2304 + pc);
            u32x2 prv = (u32x2){0u, 0u};
            if (row & 2047) prv = *(const u32x2*)(p + (size_t)(row - 1) * 2304 + pc);
            const f32x4 mu = *(const f32x4*)(P.shift_mu + j0);
            const float c0 = bf_lo(cur.x), c1 = bf_hi(cur.x), c2 = bf_lo(cur.y), c3 = bf_hi(cur.y);
            const float p0 = bf_lo(prv.x), p1 = bf_hi(prv.x), p2 = bf_lo(prv.y), p3 = bf_hi(prv.y);
            o[0] = c0 + (p0 - c0) * mu[0]; o[1] = c1 + (p1 - c1) * mu[1]; o[2] = c2 + (p2 - c2) * mu[2]; o[3] = c3 + (p3 - c3) * mu[3];
        };
        for (;;) {
            __syncthreads();
            if (tid == 0) s_item = atomicAdd(&counters[1], 1);
            __syncthreads();
            const int item = s_item;
            if (item >= N5) break;
            if (item < N0) {
                const int tm = item / 6, tn = item % 6;
                gemm_tile_big<true>(p, 2304, wuqT, 256, 256, tm * 256, tn * 128, smem,
                    [&](const f32x4 (&acc)[4][4], int rbase, int cbase, int fr, int fq) {
                        const bool rope = (cbase % 192) == 128;
#pragma unroll
                        for (int m = 0; m < 4; ++m) {
                            const int row = rbase + m * 16 + fr;
                            const float rs = rsqrtf(ssqq[row] * (1.0f / 256.0f) + EPS) * QSCALE;
                            f32x4 v[4];
#pragma unroll
                            for (int n = 0; n < 4; ++n) v[n] = acc[m][n] * rs;
                            if (rope) {
#pragma unroll
                                for (int n = 0; n < 2; ++n)
#pragma unroll
                                    for (int j = 0; j < 4; ++j) {
                                        const float2 cs = ropetab[row * 32 + n * 16 + fq * 4 + j];
                                        const float t1 = v[n][j], t2 = v[n + 2][j];
                                        v[n][j] = t1 * cs.x - t2 * cs.y; v[n + 2][j] = t1 * cs.y + t2 * cs.x;
                                    }
                            }
#pragma unroll
                            for (int n = 0; n < 4; ++n) {
                                u32x2 w; w.x = cvt_pk_bf16(v[n][0], v[n][1]); w.y = cvt_pk_bf16(v[n][2], v[n][3]);
                                *(u32x2*)(qmla + (size_t)row * 768 + cbase + n * 16 + fq * 4) = w;
                            }
                        }
                    });
            } else if (item < N1) {
                const int it = item - N0, tm = it >> 2, tn = it & 3;
                gemm_tile_big<true>(p + 256, 2304, wukT, 128, 128, tm * 256, tn * 128, smem,
                    [&](const f32x4 (&acc)[4][4], int rbase, int cbase, int fr, int fq) {
#pragma unroll
                        for (int m = 0; m < 4; ++m) {
                            const int row = rbase + m * 16 + fr;
                            const float rs = rsqrtf(ssqkv[row] * (1.0f / 128.0f) + EPS);
#pragma unroll
                            for (int n = 0; n < 4; ++n) {
                                const int col = cbase + n * 16 + fq * 4, h = col >> 7, d = col & 127;
                                const f32x4 v = acc[m][n] * rs;
                                u32x2 w; w.x = cvt_pk_bf16(v[0], v[1]); w.y = cvt_pk_bf16(v[2], v[3]);
                                *(u32x2*)(kfull + (size_t)row * 768 + h * 192 + d) = w;
                            }
                        }
                    });
            } else if (item < N2) {
                const int it = item - N1, tm = it >> 2, tn = it & 3;
                gemm_tile_big<false>(p + 256, 2304, wuvT, 128, 128, tm * 256, tn * 128, smem,
                    [&](const f32x4 (&acc)[4][4], int rbase, int cbase, int fr, int fq) {
#pragma unroll
                        for (int m = 0; m < 4; ++m) {
                            const int row = rbase + m * 16 + fq * 4;
                            const f32x4 sq = *(const f32x4*)(ssqkv + row);
                            f32x4 rs;
#pragma unroll
                            for (int j = 0; j < 4; ++j) rs[j] = rsqrtf(sq[j] * (1.0f / 128.0f) + EPS);
                            const int b = row >> 11, s = row & 2047;
#pragma unroll
                            for (int n = 0; n < 4; ++n) {
                                const int col = cbase + n * 16 + fr;
                                const f32x4 v = acc[m][n] * rs;
                                u32x2 w; w.x = cvt_pk_bf16(v[0], v[1]); w.y = cvt_pk_bf16(v[2], v[3]);
                                *(u32x2*)(vTm + ((size_t)(b * 512 + col)) * 2048 + s) = w;
                            }
                        }
                    });
            } else if (item < N3) {
                const int it = item - N2, tm = it >> 2, tn = it & 3;
                auto al = [&](int row, int k) -> u32x4 {
                    float o[8]; shifted8(row, 1984 + k, 1536 + k, o);
                    u32x4 w;
                    w.x = cvt_pk_bf16(tanhf(o[0]), tanhf(o[1])); w.y = cvt_pk_bf16(tanhf(o[2]), tanhf(o[3]));
                    w.z = cvt_pk_bf16(tanhf(o[4]), tanhf(o[5])); w.w = cvt_pk_bf16(tanhf(o[6]), tanhf(o[7]));
                    return w;
                };
                gemm_tile<true>(al, wupT, 64, 64, tm * 128, tn * 128, smem,
                    [&](const f32x4 (&acc)[4][4], int rbase, int cbase, int fr, int fq) {
#pragma unroll
                        for (int m = 0; m < 4; ++m) {
                            const int row = rbase + m * 16 + fr;
#pragma unroll
                            for (int n = 0; n < 4; ++n) {
                                const int col = cbase + n * 16 + fq * 4;
                                const f32x4 w0 = *(const f32x4*)(P.rw_w0 + col);
                                f32x4 dv;
#pragma unroll
                                for (int j = 0; j < 4; ++j) {
                                    const float wp = w0[j] + acc[m][n][j];
                                    const float z = -wp;
                                    const float sp = fmaxf(z, 0.f) + log1pf(__expf(-fabsf(z)));
                                    dv[j] = __expf(-__expf(-sp - 0.5f));
                                }
                                *(f32x4*)(decay + (size_t)row * 512 + col) = dv;
                            }
                        }
                    });
            } else if (item < N4) {
                const int it = item - N3, tm = it >> 2, tn = it & 3;
                auto al = [&](int row, int k) -> u32x4 {
                    float o[8]; shifted8(row, 2048 + k, 1600 + k, o);
                    u32x4 w;
                    w.x = cvt_pk_bf16(o[0], o[1]); w.y = cvt_pk_bf16(o[2], o[3]); w.z = cvt_pk_bf16(o[4], o[5]); w.w = cvt_pk_bf16(o[6], o[7]);
                    return w;
                };
                gemm_tile<true>(al, aupT, 64, 64, tm * 128, tn * 128, smem,
                    [&](const f32x4 (&acc)[4][4], int rbase, int cbase, int fr, int fq) {
#pragma unroll
                        for (int m = 0; m < 4; ++m) {
                            const int row = rbase + m * 16 + fr;
                            f32x4 kv[4], kkr[4], av[4];
                            float ss = 0.f;
#pragma unroll
                            for (int n = 0; n < 4; ++n) {
                                const int col = cbase + n * 16 + fq * 4;
                                shifted4(row, 960 + col, 512 + col, kv[n]);
                                const f32x4 kkw = *(const f32x4*)(P.rw_k_k + col);
                                const f32x4 a0 = *(const f32x4*)(P.rw_a0 + col);
#pragma unroll
                                for (int j = 0; j < 4; ++j) {
                                    kkr[n][j] = kv[n][j] * kkw[j]; ss += kkr[n][j] * kkr[n][j];
                                    av[n][j] = sigmoidf_(a0[j] + acc[m][n][j]);
                                }
                            }
                            ss += __shfl_xor(ss, 16); ss += __shfl_xor(ss, 32);
                            const float inv = 1.0f / fmaxf(sqrtf(ss), 1e-12f);
#pragma unroll
                            for (int n = 0; n < 4; ++n) {
                                const int col = cbase + n * 16 + fq * 4;
                                const f32x4 ka = *(const f32x4*)(P.rw_k_a + col);
                                f32x4 rv, vv, kk, k2, kka;
                                shifted4(row, 448 + col, col, rv);
                                shifted4(row, 1472 + col, 1024 + col, vv);
#pragma unroll
                                for (int j = 0; j < 4; ++j) {
                                    kk[j] = kkr[n][j] * inv;
                                    k2[j] = kv[n][j] * (1.0f + (av[n][j] - 1.0f) * ka[j]);
                                    kka[j] = kk[j] * av[n][j];
                                }
                                const size_t o = (size_t)row * 512 + col;
                                u32x2 w;
                                w.x = cvt_pk_bf16(rv[0], rv[1]); w.y = cvt_pk_bf16(rv[2], rv[3]); *(u32x2*)(rwr + o) = w;
                                w.x = cvt_pk_bf16(k2[0], k2[1]); w.y = cvt_pk_bf16(k2[2], k2[3]); *(u32x2*)(rwk + o) = w;
                                w.x = cvt_pk_bf16(vv[0], vv[1]); w.y = cvt_pk_bf16(vv[2], vv[3]); *(u32x2*)(rwv + o) = w;
                                w.x = cvt_pk_bf16(kk[0], kk[1]); w.y = cvt_pk_bf16(kk[2], kk[3]); *(u32x2*)(rwkk + o) = w;
                                w.x = cvt_pk_bf16(kka[0], kka[1]); w.y = cvt_pk_bf16(kka[2], kka[3]); *(u32x2*)(rwka + o) = w;
                            }
                        }
                    });
            } else {
                const int it = item - N4, tm = it >> 2, tn = it & 3;
                auto al = [&](int row, int k) -> u32x4 {
                    float o[8]; shifted8(row, 2112 + k, 1664 + k, o);
                    u32x4 w;
                    w.x = cvt_pk_bf16(sigmoidf_(o[0]), sigmoidf_(o[1])); w.y = cvt_pk_bf16(sigmoidf_(o[2]), sigmoidf_(o[3]));
                    w.z = cvt_pk_bf16(sigmoidf_(o[4]), sigmoidf_(o[5])); w.w = cvt_pk_bf16(sigmoidf_(o[6]), sigmoidf_(o[7]));
                    return w;
                };
                gemm_tile<true>(al, gupT, 128, 128, tm * 128, tn * 128, smem,
                    [&](const f32x4 (&acc)[4][4], int rbase, int cbase, int fr, int fq) {
#pragma unroll
                        for (int m = 0; m < 4; ++m) {
                            const int row = rbase + m * 16 + fr;
#pragma unroll
                            for (int n = 0; n < 4; ++n) {
                                const f32x4 v = acc[m][n];
                                u32x2 w; w.x = cvt_pk_bf16(v[0], v[1]); w.y = cvt_pk_bf16(v[2], v[3]);
                                *(u32x2*)(gbuf + (size_t)row * 512 + cbase + n * 16 + fq * 4) = w;
                            }
                        }
                    });
            }
        }
        for (int i = gtid; i < T * 32; i += gsz) {
            const int row = i >> 5, f = i & 31;
            const float t1 = __uint_as_float((unsigned)p[(size_t)row * 2304 + 384 + f] << 16);
            const float t2 = __uint_as_float((unsigned)p[(size_t)row * 2304 + 416 + f] << 16);
            const float2 cs = ropetab[i];
            const bf16_t o1 = (bf16_t)(cvt_pk_bf16(t1 * cs.x - t2 * cs.y, 0.f) & 0xffffu);
            const bf16_t o2 = (bf16_t)(cvt_pk_bf16(t1 * cs.y + t2 * cs.x, 0.f) & 0xffffu);
#pragma unroll
            for (int h = 0; h < 4; ++h) { kfull[(size_t)row * 768 + h * 192 + 128 + f] = o1; kfull[(size_t)row * 768 + h * 192 + 160 + f] = o2; }
        }
    }
    GRID_SYNC();

    if (PH & (1 << 3)) {
        PHASE_IDS
        const bf16_t* rwr = (const bf16_t*)(ws + O_RW_R);
        const bf16_t* rwk = (const bf16_t*)(ws + O_RW_K);
        const bf16_t* rwv = (const bf16_t*)(ws + O_RW_V);
        const bf16_t* rwkk = (const bf16_t*)(ws + O_RW_KK);
        const bf16_t* rwka = (const bf16_t*)(ws + O_RW_KA);
        const float* decay = (const float*)(ws + O_DECAY);
        bf16_t* yraw = (bf16_t*)(ws + O_YRAW);
        bf16_t* mix = (bf16_t*)(ws + O_MIX);
        for (;;) {
            __syncthreads();
            if (tid == 0) s_item = atomicAdd(&counters[0], 1);
            __syncthreads();
            const int item = s_item;
            if (item >= 256 + 512 + 128 + 320 + 512) break;
            if (item < 256) {
                const int b = item >> 5, h = (item >> 2) & 7, qr = item & 3;
                float* opnd = (float*)smem;
                float* vbuf = (float*)(smem + 40960);
                float* ybuf = (float*)(smem + 40960 + 2048);
                const int seg = lane & 15, rl = wid * 4 + (lane >> 4);
                const int lstep = tid >> 4, lc4 = (tid & 15) * 4;
                const int vstep = (tid & 63) >> 2, vc4 = (tid & 3) * 4;
                const size_t gbase = ((size_t)b * 2048) * 512 + h * 64;
                u32x2 pr_kk, pr_k, pr_r, pr_ka, pr_v; f32x4 pr_w;
                auto prefetch = [&](int ch) {
                    const size_t o = gbase + (size_t)(ch * 16 + lstep) * 512 + lc4;
                    pr_kk = *(const u32x2*)(rwkk + o); pr_k = *(const u32x2*)(rwk + o); pr_r = *(const u32x2*)(rwr + o); pr_ka = *(const u32x2*)(rwka + o);
                    pr_w = *(const f32x4*)(decay + o);
                    if (tid < 64) pr_v = *(const u32x2*)(rwv + gbase + (size_t)(ch * 16 + vstep) * 512 + qr * 16 + vc4);
                };
                auto commit = [&](int buf) {
                    float* ob = opnd + buf * 5120 + lstep * 64 + lc4;
                    *(f32x4*)(ob + 0 * 1024) = (f32x4){bf_lo(pr_kk.x), bf_hi(pr_kk.x), bf_lo(pr_kk.y), bf_hi(pr_kk.y)};
                    *(f32x4*)(ob + 1 * 1024) = pr_w;
                    *(f32x4*)(ob + 2 * 1024) = (f32x4){bf_lo(pr_k.x), bf_hi(pr_k.x), bf_lo(pr_k.y), bf_hi(pr_k.y)};
                    *(f32x4*)(ob + 3 * 1024) = (f32x4){bf_lo(pr_r.x), bf_hi(pr_r.x), bf_lo(pr_r.y), bf_hi(pr_r.y)};
                    *(f32x4*)(ob + 4 * 1024) = (f32x4){bf_lo(pr_ka.x), bf_hi(pr_ka.x), bf_lo(pr_ka.y), bf_hi(pr_ka.y)};
                    if (tid < 64) *(f32x4*)(vbuf + buf * 256 + vstep * 16 + vc4) = (f32x4){bf_lo(pr_v.x), bf_hi(pr_v.x), bf_lo(pr_v.y), bf_hi(pr_v.y)};
                };
                float s0 = 0.f, s1 = 0.f, s2 = 0.f, s3 = 0.f;
                prefetch(0); commit(0);
                __syncthreads();
                for (int ch = 0; ch < 128; ++ch) {
                    if (ch + 1 < 128) prefetch(ch + 1);
                    const float* ob = opnd + (ch & 1) * 5120 + seg * 4;
                    const float* vb = vbuf + (ch & 1) * 256 + rl;
                    float ykeep = 0.f;
                    f32x4 c_kk = *(const f32x4*)(ob + 0 * 1024), c_w = *(const f32x4*)(ob + 1 * 1024), c_k = *(const f32x4*)(ob + 2 * 1024);
                    f32x4 c_r = *(const f32x4*)(ob + 3 * 1024), c_a = *(const f32x4*)(ob + 4 * 1024);
                    float c_v = vb[0];
                    f32x4 r_prev = c_r;
#pragma unroll
                    for (int s = 0; s < 16; ++s) {
                        f32x4 n_kk = c_kk, n_w = c_w, n_k = c_k, n_r = c_r, n_a = c_a; float n_v = c_v;
                        if (s + 1 < 16) {
                            n_kk = *(const f32x4*)(ob + 0 * 1024 + (s + 1) * 64); n_w = *(const f32x4*)(ob + 1 * 1024 + (s + 1) * 64);
                            n_k = *(const f32x4*)(ob + 2 * 1024 + (s + 1) * 64); n_r = *(const f32x4*)(ob + 3 * 1024 + (s + 1) * 64);
                            n_a = *(const f32x4*)(ob + 4 * 1024 + (s + 1) * 64); n_v = vb[(s + 1) * 16];
                        }
                        __builtin_amdgcn_sched_barrier(0);
                        float t0 = opq(s0 * c_kk[0]), u0 = opq(s0 * r_prev[0]);
                        float t1 = opq(s1 * c_kk[1]), u1 = opq(s1 * r_prev[1]);
                        t0 = opq(__builtin_fmaf(s2, c_kk[2], t0)); u0 = opq(__builtin_fmaf(s2, r_prev[2], u0));
                        t1 = opq(__builtin_fmaf(s3, c_kk[3], t1)); u1 = opq(__builtin_fmaf(s3, r_prev[3], u1));
                        float sa = opq(t0 + t1), y = opq(u0 + u1);
                        const float kv0 = opq(c_k[0] * c_v), kv1 = opq(c_k[1] * c_v), kv2 = opq(c_k[2] * c_v), kv3 = opq(c_k[3] * c_v);
                        allreduce16_pair(sa, y);
                        if (s > 0 && (s - 1) == seg) ykeep = y;
                        const float nsa = -sa;
                        s0 = opq(__builtin_fmaf(s0, c_w[0], opq(__builtin_fmaf(c_a[0], nsa, kv0))));
                        s1 = opq(__builtin_fmaf(s1, c_w[1], opq(__builtin_fmaf(c_a[1], nsa, kv1))));
                        s2 = opq(__builtin_fmaf(s2, c_w[2], opq(__builtin_fmaf(c_a[2], nsa, kv2))));
                        s3 = opq(__builtin_fmaf(s3, c_w[3], opq(__builtin_fmaf(c_a[3], nsa, kv3))));
                        r_prev = c_r;
                        c_kk = n_kk; c_w = n_w; c_k = n_k; c_r = n_r; c_a = n_a; c_v = n_v;
                    }
                    {
                        float u0 = opq(s0 * r_prev[0]), u1 = opq(s1 * r_prev[1]);
                        u0 = opq(__builtin_fmaf(s2, r_prev[2], u0)); u1 = opq(__builtin_fmaf(s3, r_prev[3], u1));
                        float y = u0 + u1;
                        y = allreduce16(y);
                        if (seg == 15) ykeep = y;
                    }
                    ybuf[seg * 16 + rl] = ykeep;
                    lds_barrier();
                    yraw[gbase + (size_t)(ch * 16 + (tid >> 4)) * 512 + qr * 16 + (tid & 15)] = (bf16_t)(cvt_pk_bf16(ybuf[tid], 0.f) & 0xffffu);
                    if (ch + 1 < 128) commit((ch + 1) & 1);
                    lds_barrier();
                }
            } else if (item < 768) {
                const int a = item - 256, qb = 15 - (a >> 5), bh = a & 31, b = bh >> 2, h = bh & 3;
                const size_t row0 = (size_t)b * 2048 + qb * 128;
                attn_item<192, 128, false, 2>(qmla + row0 * 768 + h * 192, 768,
                                    kfull + ((size_t)b * 2048) * 768 + h * 192, 768,
                                    vTm + ((size_t)(b * 4 + h) * 128) * 2048, 2048, 2 * qb + 2, 2 * qb + 1,
                                    mix + row0 * 1024 + h * 128, 1024, smem);
            } else if (item < 896) {
                const int i_ = item - 768, tm = i_ >> 4, tn = i_ & 15;
                const bf16_t* memb = (const bf16_t*)(ws + O_MEMB);
                const bf16_t* xakvT = (const bf16_t*)(ws + O_XAKVT);
                bf16_t* km = (bf16_t*)(ws + O_KM);
                bf16_t* vmT = (bf16_t*)(ws + O_VMT);
                if (tn < 8) {
                    gemm_tile_big<true>(memb, 1024, xakvT, 1024, 1024, tm * 256, tn * 128, smem,
                        [&](const f32x4 (&acc)[4][4], int rbase, int cbase, int fr, int fq) {
#pragma unroll
                            for (int m = 0; m < 4; ++m) {
                                const int row = rbase + m * 16 + fr;
                                const float rs = rsqrtf(ssqm[row] * (1.0f / 1024.0f) + EPS);
#pragma unroll
                                for (int n = 0; n < 4; ++n) {
                                    const f32x4 v = acc[m][n] * rs;
                                    u32x2 w; w.x = cvt_pk_bf16(v[0], v[1]); w.y = cvt_pk_bf16(v[2], v[3]);
                                    *(u32x2*)(km + (size_t)row * 1024 + cbase + n * 16 + fq * 4) = w;
                                }
                            }
                        });
                } else {
                    gemm_tile_big<false>(memb, 1024, xakvT, 1024, 1024, tm * 256, tn * 128, smem,
                        [&](const f32x4 (&acc)[4][4], int rbase, int cbase, int fr, int fq) {
#pragma unroll
                            for (int m = 0; m < 4; ++m) {
                                const int row = rbase + m * 16 + fq * 4;
                                const f32x4 sq = *(const f32x4*)(ssqm + row);
                                f32x4 rs;
#pragma unroll
                                for (int j = 0; j < 4; ++j) rs[j] = rsqrtf(sq[j] * (1.0f / 1024.0f) + EPS);
                                const int b = row >> 8, mi = row & 255;
#pragma unroll
                                for (int n = 0; n < 4; ++n) {
                                    const int col = cbase + n * 16 + fr - 1024;
                                    const f32x4 v = acc[m][n] * rs;
                                    u32x2 w; w.x = cvt_pk_bf16(v[0], v[1]); w.y = cvt_pk_bf16(v[2], v[3]);
                                    *(u32x2*)(vmT + ((size_t)(b * 1024 + col)) * 256 + mi) = w;
                                }
                            }
                        });
                }
            } else {
                const int i_ = item - 896;
                if (i_ < 320) { for (int t_ = 0; t_ < 4; ++t_) { const int tl_ = i_ * 4 + t_; do_tr(tl_ < 512 ? 672 + tl_ : 1696 + (tl_ - 512)); } }
                else { const int r0_ = (i_ - 320) * 64; convert_experts(r0_, r0_ + 64, wid, lane); }
            }
        }
    }
    GRID_SYNC();

    if (PH & (1 << 4)) {
        PHASE_IDS
        const bf16_t* rwr = (const bf16_t*)(ws + O_RW_R);
        const bf16_t* rwk = (const bf16_t*)(ws + O_RW_K);
        const bf16_t* rwv = (const bf16_t*)(ws + O_RW_V);
        const bf16_t* gbuf = (const bf16_t*)(ws + O_G);
        const bf16_t* yraw = (const bf16_t*)(ws + O_YRAW);
        bf16_t* mix = (bf16_t*)(ws + O_MIX);
#pragma unroll 4
        for (int i = gtid; i < T * 128; i += gsz) {
            const int row = i >> 7, c4 = (i & 127) * 4;
            const size_t o = (size_t)row * 512 + c4;
            const u32x2 yu = *(const u32x2*)(yraw + o);
            const f32x4 y = (f32x4){bf_lo(yu.x), bf_hi(yu.x), bf_lo(yu.y), bf_hi(yu.y)};
            float s1 = y[0] + y[1] + y[2] + y[3];
#pragma unroll
            for (int d = 1; d < 16; d <<= 1) s1 += __shfl_xor(s1, d);
            const float mu = s1 * (1.0f / 64.0f);
            const f32x4 dy = y - mu;
            float s2 = dy[0] * dy[0] + dy[1] * dy[1] + dy[2] * dy[2] + dy[3] * dy[3];
            const u32x2 ru = *(const u32x2*)(rwr + o), ku = *(const u32x2*)(rwk + o), vu = *(const u32x2*)(rwv + o), gu = *(const u32x2*)(gbuf + o);
            const f32x4 rk = *(const f32x4*)(P.rw_r_k + c4);
            const f32x4 rv = (f32x4){bf_lo(ru.x), bf_hi(ru.x), bf_lo(ru.y), bf_hi(ru.y)};
            const f32x4 kv = (f32x4){bf_lo(ku.x), bf_hi(ku.x), bf_lo(ku.y), bf_hi(ku.y)};
            const f32x4 vv = (f32x4){bf_lo(vu.x), bf_hi(vu.x), bf_lo(vu.y), bf_hi(vu.y)};
            const f32x4 gv = (f32x4){bf_lo(gu.x), bf_hi(gu.x), bf_lo(gu.y), bf_hi(gu.y)};
            float s3 = rv[0] * kv[0] * rk[0] + rv[1] * kv[1] * rk[1] + rv[2] * kv[2] * rk[2] + rv[3] * kv[3] * rk[3];
#pragma unroll
            for (int d = 1; d < 16; d <<= 1) { s2 += __shfl_xor(s2, d); s3 += __shfl_xor(s3, d); }
            const float rstd = rsqrtf(s2 * (1.0f / 64.0f) + 64e-5f);
            const f32x4 lw = *(const f32x4*)(P.rw_lnx_w + c4), lb = *(const f32x4*)(P.rw_lnx_b + c4);
            f32x4 r;
#pragma unroll
            for (int j = 0; j < 4; ++j) {
#ifdef DBG_NOY
                r[j] = (lb[j] + s3 * vv[j]) * gv[j];
#else
                r[j] = (dy[j] * rstd * lw[j] + lb[j] + s3 * vv[j]) * gv[j];
#endif
            }
            u32x2 w; w.x = cvt_pk_bf16(r[0], r[1]); w.y = cvt_pk_bf16(r[2], r[3]);
            *(u32x2*)(mix + (size_t)row * 1024 + 512 + c4) = w;
        }
    }
    GRID_SYNC();

    if (PH & (1 << 5)) {
        PHASE_IDS
        const bf16_t* mix = (const bf16_t*)(ws + O_MIX);
        const bf16_t* woutT = (const bf16_t*)(ws + O_WOUTT);
        bf16_t* h1b = (bf16_t*)(ws + O_H1B);
        XCD_TILE_LOOP(64, 8, tm, tn) {
            auto almix = [&](int row, int k) -> u32x4 {
#ifdef DBG_ZERO_RWKV
                if (k >= 512) return (u32x4){0u, 0u, 0u, 0u};
#endif
#ifdef DBG_ZERO_MLA
                if (k < 512) return (u32x4){0u, 0u, 0u, 0u};
#endif
                return *(const u32x4*)(mix + (size_t)row * 1024 + k);
            };
            (void)almix; gemm_tile_big<true>(mix, 1024, woutT, 1024, 1024, tm * 256, tn * 128, smem,
                [&](const f32x4 (&acc)[4][4], int rbase, int cbase, int fr, int fq) {
#pragma unroll
                    for (int m = 0; m < 4; ++m) {
                        const int row = rbase + m * 16 + fr;
                        float ss = 0.f;
#pragma unroll
                        for (int n = 0; n < 4; ++n) {
                            const size_t o = (size_t)row * 1024 + cbase + n * 16 + fq * 4;
                            const f32x4 v = *(const f32x4*)(P.x + o) + acc[m][n];
                            ss += v[0] * v[0] + v[1] * v[1] + v[2] * v[2] + v[3] * v[3];
                            *(f32x4*)(P.out + o) = v;
                            u32x2 w; w.x = cvt_pk_bf16(v[0], v[1]); w.y = cvt_pk_bf16(v[2], v[3]);
                            *(u32x2*)(h1b + o) = w;
                        }
                        ss += __shfl_xor(ss, 16); ss += __shfl_xor(ss, 32);
                        if (fq == 0) atomicAdd(&ssq1[row], ss);
                    }
                });
        }
    }
    GRID_SYNC();

    if (PH & (1 << 6)) {
        PHASE_IDS
        const bf16_t* h1b = (const bf16_t*)(ws + O_H1B);
        const bf16_t* xaqT = (const bf16_t*)(ws + O_XAQT);
        bf16_t* qxa = (bf16_t*)(ws + O_QXA);
        const float XSCALE = 0.0625f * 1.4426950408889634f;
        XCD_TILE_LOOP(64, 8, tm, tn) {
            gemm_tile_big<true>(h1b, 1024, xaqT, 1024, 1024, tm * 256, tn * 128, smem,
                [&](const f32x4 (&acc)[4][4], int rbase, int cbase, int fr, int fq) {
#pragma unroll
                    for (int m = 0; m < 4; ++m) {
                        const int row = rbase + m * 16 + fr;
                        const float rs = rsqrtf(ssq1[row] * (1.0f / 1024.0f) + EPS) * XSCALE;
#pragma unroll
                        for (int n = 0; n < 4; ++n) {
                            const f32x4 v = acc[m][n] * rs;
                            u32x2 w; w.x = cvt_pk_bf16(v[0], v[1]); w.y = cvt_pk_bf16(v[2], v[3]);
                            *(u32x2*)(qxa + (size_t)row * 1024 + cbase + n * 16 + fq * 4) = w;
                        }
                    }
                });
        }
    }
    GRID_SYNC();

    if (PH & (1 << 7)) {
        PHASE_IDS
        const bf16_t* qxa = (const bf16_t*)(ws + O_QXA);
        const bf16_t* km = (const bf16_t*)(ws + O_KM);
        const bf16_t* vmT = (const bf16_t*)(ws + O_VMT);
        bf16_t* oxa = (bf16_t*)(ws + O_OXA);
        for (int item = bid; item < 8 * 4 * 32; item += nb) {
            const int qt = item >> 5 & 31, bh = item & 31;
            const int b = bh >> 2, h = bh & 3;
            const size_t row0 = (size_t)b * 2048 + qt * 64;
            attn_item<256, 256, true, 1>(qxa + row0 * 1024 + h * 256, 1024,
                                km + ((size_t)b * 256) * 1024 + h * 256, 1024,
                                vmT + ((size_t)(b * 4 + h) * 256) * 256, 256, 4, 4,
                                oxa + row0 * 1024 + h * 256, 1024, smem);
        }
    }
    GRID_SYNC();

    if (PH & (1 << 8)) {
        PHASE_IDS
        const bf16_t* oxa = (const bf16_t*)(ws + O_OXA);
        const bf16_t* xaoT = (const bf16_t*)(ws + O_XAOT);
        bf16_t* h2b = (bf16_t*)(ws + O_H2B);
        XCD_TILE_LOOP(64, 8, tm, tn) {
            gemm_tile_big<true>(oxa, 1024, xaoT, 1024, 1024, tm * 256, tn * 128, smem,
                [&](const f32x4 (&acc)[4][4], int rbase, int cbase, int fr, int fq) {
#pragma unroll
                    for (int m = 0; m < 4; ++m) {
                        const int row = rbase + m * 16 + fr;
                        float ss = 0.f;
#pragma unroll
                        for (int n = 0; n < 4; ++n) {
                            const size_t o = (size_t)row * 1024 + cbase + n * 16 + fq * 4;
                            const f32x4 v = *(const f32x4*)(P.out + o) + acc[m][n];
                            ss += v[0] * v[0] + v[1] * v[1] + v[2] * v[2] + v[3] * v[3];
                            *(f32x4*)(P.out + o) = v;
                            u32x2 w; w.x = cvt_pk_bf16(v[0], v[1]); w.y = cvt_pk_bf16(v[2], v[3]);
                            *(u32x2*)(h2b + o) = w;
                        }
                        ss += __shfl_xor(ss, 16); ss += __shfl_xor(ss, 32);
                        if (fq == 0) atomicAdd(&ssq2[row], ss);
                    }
                });
        }
    }
    GRID_SYNC();

    if (PH & (1 << 9)) {
        PHASE_IDS
        const bf16_t* h2b = (const bf16_t*)(ws + O_H2B);
        const bf16_t* pwqT = (const bf16_t*)(ws + O_PWQT);
        bf16_t* pq = (bf16_t*)(ws + O_PQ);
        const bf16_t* keysb = (const bf16_t*)(ws + O_KEYS);
        bf16_t* scores = (bf16_t*)(ws + O_SCORES);
        (void)pq;
        XCD_TILE_LOOP(64, 16, tm, g) { pq_scores_tile(h2b, 1024, pwqT, 1024, 1024, tm * 256, g, ssq2, keysb, scores, smem); }
    }
    GRID_SYNC();

    if (PH & (1 << 11)) {
        PHASE_IDS
        const bf16_t* scores = (const bf16_t*)(ws + O_SCORES);
        const unsigned char* eu8 = (const unsigned char*)(ws + O_EUB);
        const unsigned char* ev8 = (const unsigned char*)(ws + O_EVB);
        const float* esinv = (const float*)(ws + O_SSQ + 6 * 65536);
        char* wsm = smem + wid * 13824;
        int* eidx = (int*)wsm;
        float* egate = (float*)(wsm + 4096);
        float* esu = (float*)(wsm + 8192);
        unsigned char* xs = (unsigned char*)(wsm + 12288);
        float* acts = (float*)(wsm + 13312);
        const int fr = lane & 15, fq = lane >> 4;
        for (int witem = bid * 4 + wid; witem < T / 8; witem += nb * 4) {
            const int t0 = witem * 8;
            {
                const int tt = lane >> 3, h = lane & 7;
                const bf16_t* sp = scores + (size_t)(t0 + tt) * 2048 + h * 256;
                unsigned L1[16], L2[16];
#pragma unroll
                for (int s = 0; s < 16; ++s) { L1[s] = 0u; L2[s] = 0u; }
                for (int i = 0; i < 128; i += 8) {
                    const u32x4 a = *(const u32x4*)(sp + i);
                    const u32x4 b = *(const u32x4*)(sp + 128 + i);
                    const unsigned au[4] = {a.x, a.y, a.z, a.w}, bu[4] = {b.x, b.y, b.z, b.w};
#pragma unroll
                    for (int e = 0; e < 4; ++e) {
                        const unsigned id0 = 127u - (unsigned)(i + 2 * e), id1 = id0 - 1u;
                        TOPK_INSERT(L1, (ordkey(bf_lo(au[e])) & ~127u) | id0);
                        TOPK_INSERT(L1, (ordkey(bf_hi(au[e])) & ~127u) | id1);
                        TOPK_INSERT(L2, (ordkey(bf_lo(bu[e])) & ~127u) | id0);
                        TOPK_INSERT(L2, (ordkey(bf_hi(bu[e])) & ~127u) | id1);
                    }
                }
                float v1[16], v2[16];
                unsigned pa0 = 0u, pa1 = 0u, pa2 = 0u, pa3 = 0u, pb0 = 0u, pb1 = 0u, pb2 = 0u, pb3 = 0u;
#pragma unroll
                for (int s = 0; s < 16; ++s) {
                    v1[s] = unordkey(L1[s] & ~127u); v2[s] = unordkey(L2[s] & ~127u);
                    const unsigned i1_ = (127u - (L1[s] & 127u)) << ((s & 3) * 8), i2_ = (127u - (L2[s] & 127u)) << ((s & 3) * 8);
                    if ((s >> 2) == 0) { pa0 |= i1_; pb0 |= i2_; } else if ((s >> 2) == 1) { pa1 |= i1_; pb1 |= i2_; }
                    else if ((s >> 2) == 2) { pa2 |= i1_; pb2 |= i2_; } else { pa3 |= i1_; pb3 |= i2_; }
                }
                unsigned C[16];
#pragma unroll
                for (int s = 0; s < 16; ++s) C[s] = 0u;
#pragma unroll
                for (int a = 0; a < 16; ++a)
#pragma unroll
                    for (int b = 0; b < 16; ++b)
                        if ((a + 1) * (b + 1) <= 16) { TOPK_INSERT(C, (ordkey(v1[a] + v2[b]) & ~255u) | (255u - (unsigned)(a * 16 + b))); }
                float cv[16], sum = 0.f;
                {
                    const float mxv = unordkey(C[0] & ~255u);
                    sum = 0.f;
#pragma unroll
                    for (int s = 0; s < 16; ++s) { cv[s] = __expf(unordkey(C[s] & ~255u) - mxv); sum += cv[s]; }
                }
                const float isum = 1.0f / sum;
#pragma unroll
                for (int s = 0; s < 16; ++s) {
                    const int ab = 255 - (int)(C[s] & 255u), a = ab >> 4, b = ab & 15;
                    const int e = (int)(byte_lookup(pa0, pa1, pa2, pa3, a) * 128u + byte_lookup(pb0, pb1, pb2, pb3, b));
                    eidx[tt * 128 + h * 16 + s] = e;
                    egate[tt * 128 + h * 16 + s] = cv[s] * isum * esinv[16384 + e];
                    esu[tt * 128 + h * 16 + s] = esinv[e];
                }
            }
            __builtin_amdgcn_wave_barrier();
            for (int tt = 0; tt < 8; ++tt) {
                const int row = t0 + tt;
                const float* hrow = P.out + (size_t)row * 1024 + lane * 16;
                f32x4 hv[4];
#pragma unroll
                for (int i = 0; i < 4; ++i) hv[i] = *(const f32x4*)(hrow + i * 4);
                const float rs2 = rsqrtf(ssq2[row] * (1.0f / 1024.0f) + EPS);
                float sxinv;
                {
                    f32x4 a[4]; float amax = 0.f;
#pragma unroll
                    for (int i = 0; i < 4; ++i) {
                        a[i] = hv[i] * *(const f32x4*)(P.norm_ffn_g + lane * 16 + i * 4) * rs2;
                        amax = fmaxf(amax, fmaxf(fmaxf(fabsf(a[i][0]), fabsf(a[i][1])), fmaxf(fabsf(a[i][2]), fabsf(a[i][3]))));
                    }
#pragma unroll
                    for (int o = 32; o >= 1; o >>= 1) amax = fmaxf(amax, __shfl_xor(amax, o));
                    amax = fmaxf(amax, 1e-30f);
                    const float sc = 240.0f / amax; sxinv = amax * (1.0f / 240.0f);
                    int w[4];
#pragma unroll
                    for (int i = 0; i < 4; ++i) {
                        w[i] = __builtin_amdgcn_cvt_pk_fp8_f32(a[i][0] * sc, a[i][1] * sc, 0, false);
                        w[i] = __builtin_amdgcn_cvt_pk_fp8_f32(a[i][2] * sc, a[i][3] * sc, w[i], true);
                    }
                    *(u32x4*)(xs + lane * 16) = (u32x4){(unsigned)w[0], (unsigned)w[1], (unsigned)w[2], (unsigned)w[3]};
                }
                __builtin_amdgcn_wave_barrier();
                int er[8];
#pragma unroll
                for (int eg = 0; eg < 8; ++eg) er[eg] = eidx[tt * 128 + eg * 16 + fr];
                f32x4 acc[8];
#pragma unroll
                for (int eg = 0; eg < 8; ++eg) acc[eg] = (f32x4){0.f, 0.f, 0.f, 0.f};
#pragma unroll 2
                for (int it = 0; it < 16; ++it) {
                    const i64x2 xq = *(const i64x2*)(xs + it * 64 + fq * 16);
#pragma unroll
                    for (int eg = 0; eg < 8; ++eg) {
                        const i64x2 uq = *(const i64x2*)(eu8 + (size_t)er[eg] * 1024 + it * 64 + fq * 16);
                        acc[eg] = __builtin_amdgcn_mfma_f32_16x16x32_fp8_fp8(uq.x, xq.x, acc[eg], 0, 0, 0);
                        acc[eg] = __builtin_amdgcn_mfma_f32_16x16x32_fp8_fp8(uq.y, xq.y, acc[eg], 0, 0, 0);
                    }
                }
#pragma unroll
                for (int eg = 0; eg < 8; ++eg) {
                    const f32x4 gt = *(const f32x4*)(egate + tt * 128 + eg * 16 + fq * 4);
                    const f32x4 su = *(const f32x4*)(esu + tt * 128 + eg * 16 + fq * 4);
                    f32x4 av;
#pragma unroll
                    for (int j = 0; j < 4; ++j) { const float pre = acc[eg][j] * su[j] * sxinv; av[j] = 0.5f * pre * (1.0f + erff(pre * 0.70710678118654752f)) * gt[j]; }
                    if (fr == 0) *(f32x4*)(acts + eg * 16 + fq * 4) = av;
                }
                __builtin_amdgcn_wave_barrier();
                f32x4 oa[4];
#pragma unroll
                for (int i = 0; i < 4; ++i) oa[i] = (f32x4){0.f, 0.f, 0.f, 0.f};
                for (int j0 = 0; j0 < 128; j0 += 8) {
                    const f32x4 a4 = *(const f32x4*)(acts + j0), a5 = *(const f32x4*)(acts + j0 + 4);
                    const float as[8] = {a4[0], a4[1], a4[2], a4[3], a5[0], a5[1], a5[2], a5[3]};
                    u32x4 vq[8];
#pragma unroll
                    for (int jj = 0; jj < 8; ++jj) vq[jj] = *(const u32x4*)(ev8 + (size_t)eidx[tt * 128 + j0 + jj] * 1024 + lane * 16);
#pragma unroll
                    for (int jj = 0; jj < 8; ++jj) {
                        const float a = as[jj];
                        const unsigned q4[4] = {vq[jj].x, vq[jj].y, vq[jj].z, vq[jj].w};
#pragma unroll
                        for (int i = 0; i < 4; ++i) {
                            const f32x2_t lo = __builtin_amdgcn_cvt_pk_f32_fp8((int)q4[i], false), hi = __builtin_amdgcn_cvt_pk_f32_fp8((int)q4[i], true);
                            oa[i][0] += a * lo[0]; oa[i][1] += a * lo[1]; oa[i][2] += a * hi[0]; oa[i][3] += a * hi[1];
                        }
                    }
                }
                float ss = 0.f;
#pragma unroll
                for (int i = 0; i < 4; ++i) { hv[i] = hv[i] + oa[i]; ss += hv[i][0] * hv[i][0] + hv[i][1] * hv[i][1] + hv[i][2] * hv[i][2] + hv[i][3] * hv[i][3]; }
                ss = wave_sum(ss);
                const float rs3 = rsqrtf(ss * (1.0f / 1024.0f) + EPS);
                float* orow = P.out + (size_t)row * 1024 + lane * 16;
#pragma unroll
                for (int i = 0; i < 4; ++i) *(f32x4*)(orow + i * 4) = hv[i] * rs3 * *(const f32x4*)(P.final_norm_g + lane * 16 + i * 4);
                __builtin_amdgcn_wave_barrier();
            }
        }
    }
#ifdef TIMED_MASK
    {
        xcd_barrier(xb);
        const long long tn_ = (long long)__builtin_amdgcn_s_memrealtime();
        if ((TIMED_MASK >> ph_idx) & 1) t_acc += tn_ - t_last;
        const long long t_end = tn_ + t_acc;
        while ((long long)__builtin_amdgcn_s_memrealtime() < t_end) __builtin_amdgcn_s_sleep(8);
    }
#endif
    if (PH & (1 << 12)) {
        PHASE_IDS
        GRID_SYNC();
        const float* src = (PH & (1 << 5)) ? (const float*)P.out : P.x;
        for (int r = bid * 4 + wid; r < T; r += nb * 4) {
            const float* srow = src + (size_t)r * 1024;
            f32x4 v[4]; float ss = 0.f;
#pragma unroll
            for (int i = 0; i < 4; ++i) { v[i] = *(const f32x4*)(srow + i * 256 + lane * 4); ss += v[i][0] * v[i][0] + v[i][1] * v[i][1] + v[i][2] * v[i][2] + v[i][3] * v[i][3]; }
            ss = wave_sum(ss);
            const float rs = rsqrtf(ss * (1.0f / 1024.0f) + EPS);
#pragma unroll
            for (int i = 0; i < 4; ++i) *(f32x4*)(P.out + (size_t)r * 1024 + i * 256 + lane * 4) = v[i] * rs * *(const f32x4*)(P.final_norm_g + i * 256 + lane * 4);
        }
    }
}

extern "C" void kernel_launch(void* const* d_in, const int* in_sizes, int n_in, void* d_out, int out_size, void* d_ws, size_t ws_size,
                              hipStream_t stream) {
    (void)in_sizes; (void)n_in; (void)out_size;
    if (ws_size < WS_NEED) { fprintf(stderr, "workspace too small: %zu\n", ws_size); return; }
    static int grid_blocks = 0;
    if (!grid_blocks) {
        int dev = 0, cus = 0, per_cu = 0;
        hipGetDevice(&dev);
        hipDeviceGetAttribute(&cus, hipDeviceAttributeMultiprocessorCount, dev);
        hipOccupancyMaxActiveBlocksPerMultiprocessor(&per_cu, fwd_megakernel, 256, 0);
        if (per_cu > 2) per_cu = 2;
        grid_blocks = cus * per_cu;
    }
    Params p{};
    const float** fp = (const float**)&p;
    (void)fp;
    p.x = (const float*)d_in[0]; p.mem = (const float*)d_in[1]; p.pos = (const int*)d_in[2];
    p.norm_mix_g = (const float*)d_in[3]; p.w_in = (const float*)d_in[4]; p.shift_mu = (const float*)d_in[5];
    p.q_norm_g = (const float*)d_in[6]; p.kv_norm_g = (const float*)d_in[7]; p.w_uq = (const float*)d_in[8]; p.w_ukv = (const float*)d_in[9];
    p.rw_w0 = (const float*)d_in[10]; p.rw_w_up = (const float*)d_in[11]; p.rw_a0 = (const float*)d_in[12]; p.rw_a_up = (const float*)d_in[13];
    p.rw_g_up = (const float*)d_in[14]; p.rw_k_k = (const float*)d_in[15]; p.rw_k_a = (const float*)d_in[16]; p.rw_r_k = (const float*)d_in[17];
    p.rw_lnx_w = (const float*)d_in[18]; p.rw_lnx_b = (const float*)d_in[19]; p.w_out = (const float*)d_in[20];
    p.norm_xa_g = (const float*)d_in[21]; p.norm_mem_g = (const float*)d_in[22]; p.xa_wq = (const float*)d_in[23]; p.xa_wk = (const float*)d_in[24];
    p.xa_wv = (const float*)d_in[25]; p.xa_wo = (const float*)d_in[26]; p.norm_ffn_g = (const float*)d_in[27]; p.peer_wq = (const float*)d_in[28];
    p.peer_keys = (const float*)d_in[29]; p.expert_u = (const float*)d_in[30]; p.expert_v = (const float*)d_in[31]; p.final_norm_g = (const float*)d_in[32];
    p.out = (float*)d_out; p.ws = (char*)d_ws;
    hipMemsetAsync((char*)d_ws + O_XBAR, 0, XCD_BAR_WORDS_BYTES, stream);
    void* args[] = {&p};
    hipError_t e = hipLaunchCooperativeKernel((void*)fwd_megakernel, dim3(grid_blocks), dim3(256), args, 0, stream);
    if (e != hipSuccess) fprintf(stderr, "cooperative launch failed: %s (grid %d)\n", hipGetErrorString(e), grid_blocks);
}
```

```cpp
#include <hip/hip_runtime.h>
#include <hip/hip_cooperative_groups.h>
#include <cstdio>
namespace cg = cooperative_groups;

typedef unsigned short bf16_t;
typedef short bf16x8 __attribute__((ext_vector_type(8)));
typedef float f32x4 __attribute__((ext_vector_type(4)));
typedef unsigned u32x4 __attribute__((ext_vector_type(4)));
typedef unsigned u32x2 __attribute__((ext_vector_type(2)));
typedef long i64x2 __attribute__((ext_vector_type(2)));

#define DEV __device__ __forceinline__

constexpr int T = 16384;
constexpr float EPS = 1e-6f;
constexpr size_t MB = 1u << 20;
constexpr size_t XCD_BAR_WORDS_BYTES = 3456 * 4;

constexpr size_t O_WINT  = 0;
constexpr size_t O_WUQT  = O_WINT  + (size_t)2304 * 1024 * 2;
constexpr size_t O_WUKT  = O_WUQT  + (size_t)768 * 256 * 2;
constexpr size_t O_WUVT  = O_WUKT  + (size_t)512 * 128 * 2;
constexpr size_t O_WUPT  = O_WUVT  + (size_t)512 * 128 * 2;
constexpr size_t O_AUPT  = O_WUPT  + (size_t)512 * 64 * 2;
constexpr size_t O_GUPT  = O_AUPT  + (size_t)512 * 64 * 2;
constexpr size_t O_WOUTT = O_GUPT  + (size_t)512 * 128 * 2;
constexpr size_t O_XAQT  = O_WOUTT + (size_t)1024 * 1024 * 2;
constexpr size_t O_XAKVT = O_XAQT  + (size_t)1024 * 1024 * 2;
constexpr size_t O_XAOT  = O_XAKVT + (size_t)2048 * 1024 * 2;
constexpr size_t O_PWQT  = O_XAOT  + (size_t)1024 * 1024 * 2;
constexpr size_t O_KEYS  = O_PWQT  + (size_t)2048 * 1024 * 2;
constexpr size_t O_SSQ   = O_KEYS  + (size_t)16 * 128 * 128 * 2;
constexpr size_t O_CNT   = O_SSQ   + (size_t)8 * 65536;
constexpr size_t O_ROPE  = O_CNT   + 4096;
constexpr size_t O_KM    = O_ROPE  + (size_t)T * 32 * 8;
constexpr size_t O_VMT   = O_KM    + (size_t)2048 * 1024 * 2;
constexpr size_t O_MEMB  = O_VMT   + (size_t)2048 * 1024 * 2;
constexpr size_t O_PERSIST_END = O_MEMB + (size_t)2048 * 1024 * 2;
constexpr size_t O_XBAR = O_PERSIST_END;
static_assert(O_XBAR + XCD_BAR_WORDS_BYTES <= 40 * MB, "persistent region too large");
constexpr size_t O_P     = 40 * MB;
constexpr size_t O_YRAW  = 40 * MB;
constexpr size_t O_MIX   = 72 * MB;
constexpr size_t O_OXA   = 144 * MB;
constexpr size_t O_H2B   = 72 * MB;
constexpr size_t O_SCORES= 144 * MB;
constexpr size_t O_SCORES_OLD_UNUSED = 40 * MB;
constexpr size_t O_XB    = 112 * MB;
constexpr size_t O_G     = 112 * MB;
constexpr size_t O_QXA   = 72 * MB;
constexpr size_t O_RW_R  = 144 * MB;
constexpr size_t O_RW_K  = 160 * MB;
constexpr size_t O_RW_V  = 176 * MB;
constexpr size_t O_RW_KK = 192 * MB;
constexpr size_t O_RW_KA = 208 * MB;
constexpr size_t O_DECAY = 224 * MB;
constexpr size_t O_H1B   = 144 * MB;
constexpr size_t O_EUB   = 128 * MB;
constexpr size_t O_EUB_OLD = 176 * MB;
constexpr size_t O_EVB   = 56 * MB;
constexpr size_t O_EVB_OLD = 208 * MB;
constexpr size_t O_PQ    = 104 * MB;
constexpr size_t WS_NEED = 256 * MB;

struct Params {
    const float *x, *mem; const int* pos;
    const float *norm_mix_g, *w_in, *shift_mu, *q_norm_g, *kv_norm_g, *w_uq, *w_ukv;
    const float *rw_w0, *rw_w_up, *rw_a0, *rw_a_up, *rw_g_up, *rw_k_k, *rw_k_a, *rw_r_k, *rw_lnx_w, *rw_lnx_b;
    const float *w_out, *norm_xa_g, *norm_mem_g, *xa_wq, *xa_wk, *xa_wv, *xa_wo;
    const float *norm_ffn_g, *peer_wq, *peer_keys, *expert_u, *expert_v, *final_norm_g;
    float* out; char* ws;
};

typedef __bf16 bf16x2_t __attribute__((ext_vector_type(2)));
typedef float f32x2_t __attribute__((ext_vector_type(2)));
DEV unsigned cvt_pk_bf16(float lo, float hi) { const f32x2_t f = {lo, hi}; const bf16x2_t b = __builtin_convertvector(f, bf16x2_t); unsigned r; __builtin_memcpy(&r, &b, 4); return r; }
DEV float bf_lo(unsigned u) { return __uint_as_float(u << 16); }
DEV float bf_hi(unsigned u) { return __uint_as_float(u & 0xffff0000u); }
DEV f32x4 mfma16(bf16x8 a, bf16x8 b, f32x4 c) { return __builtin_amdgcn_mfma_f32_16x16x32_bf16(a, b, c, 0, 0, 0); }
DEV float sigmoidf_(float v) { return 1.0f / (1.0f + __expf(-v)); }
DEV float wave_sum(float v) {
#pragma unroll
    for (int o = 32; o >= 1; o >>= 1) v += __shfl_xor(v, o);
    return v;
}
DEV float allreduce8(float x) {
    x += __int_as_float(__builtin_amdgcn_update_dpp(0, __float_as_int(x), 0xB1, 0xF, 0xF, true));
    x += __int_as_float(__builtin_amdgcn_update_dpp(0, __float_as_int(x), 0x4E, 0xF, 0xF, true));
    x += __int_as_float(__builtin_amdgcn_update_dpp(0, __float_as_int(x), 0x141, 0xF, 0xF, true));
    return x;
}
DEV float opq(float x) { asm("" : "+v"(x)); return x; }
DEV void lds_barrier() { asm volatile("s_waitcnt lgkmcnt(0)\n\ts_barrier" ::: "memory"); }
DEV float allreduce16(float x) {
    x += __int_as_float(__builtin_amdgcn_update_dpp(0, __float_as_int(x), 0xB1, 0xF, 0xF, true));
    x += __int_as_float(__builtin_amdgcn_update_dpp(0, __float_as_int(x), 0x4E, 0xF, 0xF, true));
    x += __int_as_float(__builtin_amdgcn_update_dpp(0, __float_as_int(x), 0x141, 0xF, 0xF, true));
    x += __int_as_float(__builtin_amdgcn_update_dpp(0, __float_as_int(x), 0x140, 0xF, 0xF, true));
    return x;
}
DEV void allreduce16_pair(float& a, float& b) {
    a += __int_as_float(__builtin_amdgcn_update_dpp(0, __float_as_int(a), 0xB1, 0xF, 0xF, true));
    b += __int_as_float(__builtin_amdgcn_update_dpp(0, __float_as_int(b), 0xB1, 0xF, 0xF, true));
    a += __int_as_float(__builtin_amdgcn_update_dpp(0, __float_as_int(a), 0x4E, 0xF, 0xF, true));
    b += __int_as_float(__builtin_amdgcn_update_dpp(0, __float_as_int(b), 0x4E, 0xF, 0xF, true));
    a += __int_as_float(__builtin_amdgcn_update_dpp(0, __float_as_int(a), 0x141, 0xF, 0xF, true));
    b += __int_as_float(__builtin_amdgcn_update_dpp(0, __float_as_int(b), 0x141, 0xF, 0xF, true));
    a += __int_as_float(__builtin_amdgcn_update_dpp(0, __float_as_int(a), 0x140, 0xF, 0xF, true));
    b += __int_as_float(__builtin_amdgcn_update_dpp(0, __float_as_int(b), 0x140, 0xF, 0xF, true));
}
DEV bf16x8 as_bf16x8(u32x4 v) { bf16x8 r; __builtin_memcpy(&r, &v, 16); return r; }

template <bool SWAP, class AL, class EP>
DEV void gemm_tile(AL aload, const bf16_t* __restrict__ Bt, int ldb, int K, int row0, int col0, char* smem, EP epi) {
    int tid = threadIdx.x; asm volatile("" : "+v"(tid));
    const int wid = __builtin_amdgcn_readfirstlane(tid >> 6), lane = tid & 63, wr = wid >> 1, wc = wid & 1, fr = lane & 15, fq = lane >> 4;
    constexpr int RS = 144;
    constexpr int TB = 128 * RS;
    char* sA = smem; char* sB = smem + 2 * TB;
    f32x4 acc[4][4];
#pragma unroll
    for (int m = 0; m < 4; ++m)
#pragma unroll
        for (int n = 0; n < 4; ++n) acc[m][n] = (f32x4){0.f, 0.f, 0.f, 0.f};
    const int lr = tid >> 3, lk = (tid & 7) * 8;
    const bf16_t* bp = Bt + (size_t)(col0 + lr) * ldb + lk;
    const int lo = lr * RS + (tid & 7) * 16;
    u32x4 ra[4], rb[4];
#pragma unroll
    for (int i = 0; i < 4; ++i) { ra[i] = aload(row0 + lr + 32 * i, lk); rb[i] = *(const u32x4*)(bp + (size_t)(32 * i) * ldb); }
#pragma unroll
    for (int i = 0; i < 4; ++i) { *(u32x4*)(sA + lo + i * 32 * RS) = ra[i]; *(u32x4*)(sB + lo + i * 32 * RS) = rb[i]; }
    __syncthreads();
    const int nt = K >> 6;
    for (int t = 0; t < nt; ++t) {
        const bool more = (t + 1 < nt);
        if (more) {
            const int kb = (t + 1) << 6;
#pragma unroll
            for (int i = 0; i < 4; ++i) { ra[i] = aload(row0 + lr + 32 * i, kb + lk); rb[i] = *(const u32x4*)(bp + (size_t)(32 * i) * ldb + kb); }
        }
        const char* a = sA + (t & 1) * TB; const char* b = sB + (t & 1) * TB;
#pragma unroll
        for (int kh = 0; kh < 2; ++kh) {
            bf16x8 af[4], bfr[4];
#pragma unroll
            for (int m = 0; m < 4; ++m) af[m] = *(const bf16x8*)(a + (wr * 64 + m * 16 + fr) * RS + kh * 64 + fq * 16);
#pragma unroll
            for (int n = 0; n < 4; ++n) bfr[n] = *(const bf16x8*)(b + (wc * 64 + n * 16 + fr) * RS + kh * 64 + fq * 16);
#pragma unroll
            for (int m = 0; m < 4; ++m)
#pragma unroll
                for (int n = 0; n < 4; ++n)
                    acc[m][n] = SWAP ? mfma16(bfr[n], af[m], acc[m][n]) : mfma16(af[m], bfr[n], acc[m][n]);
        }
        if (more) {
            const int o = ((t + 1) & 1) * TB;
#pragma unroll
            for (int i = 0; i < 4; ++i) { *(u32x4*)(sA + o + lo + i * 32 * RS) = ra[i]; *(u32x4*)(sB + o + lo + i * 32 * RS) = rb[i]; }
        }
        __syncthreads();
    }
    int rb_ = row0 + wr * 64, cb_ = col0 + wc * 64;
    asm volatile("" : "+s"(rb_), "+s"(cb_));
    epi(acc, rb_, cb_, fr, fq);
}

#define GLDS16(gp, lp) __builtin_amdgcn_global_load_lds((const unsigned*)(gp), (__attribute__((address_space(3))) unsigned*)(lp), 16, 0, 0)
template <bool SWAP, class EP>
DEV void gemm_tile_glds(const bf16_t* __restrict__ A, int lda, const bf16_t* __restrict__ Bt, int ldb, int K, int row0, int col0, char* smem, EP epi) {
    int tid = threadIdx.x; asm volatile("" : "+v"(tid));
    const int wid = __builtin_amdgcn_readfirstlane(tid >> 6), lane = tid & 63, wr = wid >> 1, wc = wid & 1, fr = lane & 15, fq = lane >> 4;
    constexpr int ST = 16384;
    f32x4 acc[4][4];
#pragma unroll
    for (int m = 0; m < 4; ++m)
#pragma unroll
        for (int n = 0; n < 4; ++n) acc[m][n] = (f32x4){0.f, 0.f, 0.f, 0.f};
    const int b0 = tid * 16, r0 = b0 >> 6, c0 = (b0 & 63) >> 1;
    const bf16_t* ap0 = A + (size_t)(row0 + r0) * lda + c0;
    const bf16_t* ap1 = ap0 + (size_t)64 * lda;
    const bf16_t* bp0 = Bt + (size_t)(col0 + r0) * ldb + c0;
    const bf16_t* bp1 = bp0 + (size_t)64 * ldb;
    auto issue = [&](int kt) {
        char* st = smem + (kt & 3) * ST + b0;
        GLDS16(ap0 + kt * 32, st); GLDS16(ap1 + kt * 32, st + 4096);
        GLDS16(bp0 + kt * 32, st + 8192); GLDS16(bp1 + kt * 32, st + 8192 + 4096);
    };
    const int nt = K >> 5;
    asm volatile("s_waitcnt vmcnt(0) lgkmcnt(0)\n\ts_barrier" ::: "memory");
    issue(0);
    if (nt > 1) issue(1);
    if (nt > 2) issue(2);
    for (int t = 0; t < nt; ++t) {
        if (t + 2 < nt) asm volatile("s_waitcnt vmcnt(8)" ::: "memory");
        else if (t + 1 < nt) asm volatile("s_waitcnt vmcnt(4)" ::: "memory");
        else asm volatile("s_waitcnt vmcnt(0)" ::: "memory");
        asm volatile("s_barrier" ::: "memory");
        if (t + 3 < nt) issue(t + 3);
        const char* a = smem + (t & 3) * ST; const char* b = a + 8192;
        bf16x8 af[4], bfr[4];
#pragma unroll
        for (int m = 0; m < 4; ++m) af[m] = *(const bf16x8*)(a + (wr * 64 + m * 16 + fr) * 64 + fq * 16);
#pragma unroll
        for (int n = 0; n < 4; ++n) bfr[n] = *(const bf16x8*)(b + (wc * 64 + n * 16 + fr) * 64 + fq * 16);
#pragma unroll
        for (int m = 0; m < 4; ++m)
#pragma unroll
            for (int n = 0; n < 4; ++n)
                acc[m][n] = SWAP ? mfma16(bfr[n], af[m], acc[m][n]) : mfma16(af[m], bfr[n], acc[m][n]);
    }
    int rb_ = row0 + wr * 64, cb_ = col0 + wc * 64;
    asm volatile("" : "+s"(rb_), "+s"(cb_));
    epi(acc, rb_, cb_, fr, fq);
}

template <bool SWAP, class EP>
DEV void gemm_tile_big(const bf16_t* __restrict__ A, int lda, const bf16_t* __restrict__ Bt, int ldb, int K, int row0, int col0, char* smem, EP epi) {
    int tid = threadIdx.x; asm volatile("" : "+v"(tid));
    const int wid = __builtin_amdgcn_readfirstlane(tid >> 6), lane = tid & 63, wr = wid >> 1, wc = wid & 1, fr = lane & 15, fq = lane >> 4;
    constexpr int ST = 24576;
    f32x4 acc[2][4][4];
#pragma unroll
    for (int h = 0; h < 2; ++h)
#pragma unroll
        for (int m = 0; m < 4; ++m)
#pragma unroll
            for (int n = 0; n < 4; ++n) acc[h][m][n] = (f32x4){0.f, 0.f, 0.f, 0.f};
    const int b0 = tid * 16, r0 = b0 >> 6, c0 = (b0 & 63) >> 1;
    const bf16_t* ap = A + (size_t)(row0 + r0) * lda + c0;
    const bf16_t* bp = Bt + (size_t)(col0 + r0) * ldb + c0;
    const size_t a64 = (size_t)64 * lda, b64 = (size_t)64 * ldb;
    auto issue = [&](int kt) {
        char* st = smem + (kt % 3) * ST + b0;
        GLDS16(ap + kt * 32, st); GLDS16(ap + a64 + kt * 32, st + 4096);
        GLDS16(ap + 2 * a64 + kt * 32, st + 8192); GLDS16(ap + 3 * a64 + kt * 32, st + 12288);
        GLDS16(bp + kt * 32, st + 16384); GLDS16(bp + b64 + kt * 32, st + 16384 + 4096);
    };
    const int nt = K >> 5;
    asm volatile("s_waitcnt vmcnt(0) lgkmcnt(0)\n\ts_barrier" ::: "memory");
    issue(0);
    if (nt > 1) issue(1);
    for (int t = 0; t < nt; ++t) {
        if (t + 1 < nt) asm volatile("s_waitcnt vmcnt(6)" ::: "memory");
        else asm volatile("s_waitcnt vmcnt(0)" ::: "memory");
        asm volatile("s_barrier" ::: "memory");
        if (t + 2 < nt) issue(t + 2);
        const char* a = smem + (t % 3) * ST; const char* b = a + 16384;
        bf16x8 bfr[4], af[2][4];
#pragma unroll
        for (int n = 0; n < 4; ++n) bfr[n] = *(const bf16x8*)(b + (wc * 64 + n * 16 + fr) * 64 + fq * 16);
#pragma unroll
        for (int h = 0; h < 2; ++h)
#pragma unroll
            for (int m = 0; m < 4; ++m) af[h][m] = *(const bf16x8*)(a + (wr * 128 + h * 64 + m * 16 + fr) * 64 + fq * 16);
#pragma unroll
        for (int h = 0; h < 2; ++h)
#pragma unroll
            for (int m = 0; m < 4; ++m)
#pragma unroll
                for (int n = 0; n < 4; ++n)
                    acc[h][m][n] = SWAP ? mfma16(bfr[n], af[h][m], acc[h][m][n]) : mfma16(af[h][m], bfr[n], acc[h][m][n]);
        __builtin_amdgcn_iglp_opt(0);
    }
    int rb_ = row0 + wr * 128, cb_ = col0 + wc * 64;
    asm volatile("" : "+s"(rb_), "+s"(cb_));
    epi(acc[0], rb_, cb_, fr, fq);
    epi(acc[1], rb_ + 64, cb_, fr, fq);
}

DEV void pq_scores_tile(const bf16_t* __restrict__ A, int lda, const bf16_t* __restrict__ Bt, int ldb, int K, int row0, int g,
                        const float* __restrict__ ssq2, const bf16_t* __restrict__ keysb, bf16_t* __restrict__ scores, char* smem) {
    int tid = threadIdx.x; asm volatile("" : "+v"(tid));
    const int wid = __builtin_amdgcn_readfirstlane(tid >> 6), lane = tid & 63, wr = wid >> 1, wc = wid & 1, fr = lane & 15, fq = lane >> 4;
    constexpr int ST = 24576;
    const int col0 = g * 128;
    f32x4 acc[2][4][4];
#pragma unroll
    for (int h = 0; h < 2; ++h)
#pragma unroll
        for (int m = 0; m < 4; ++m)
#pragma unroll
            for (int n = 0; n < 4; ++n) acc[h][m][n] = (f32x4){0.f, 0.f, 0.f, 0.f};
    const int b0 = tid * 16, r0 = b0 >> 6, c0 = (b0 & 63) >> 1;
    const bf16_t* ap = A + (size_t)(row0 + r0) * lda + c0;
    const bf16_t* bp = Bt + (size_t)(col0 + r0) * ldb + c0;
    const size_t a64 = (size_t)64 * lda, b64 = (size_t)64 * ldb;
    auto issue = [&](int kt) {
        char* st = smem + (kt % 3) * ST + b0;
        GLDS16(ap + kt * 32, st); GLDS16(ap + a64 + kt * 32, st + 4096);
        GLDS16(ap + 2 * a64 + kt * 32, st + 8192); GLDS16(ap + 3 * a64 + kt * 32, st + 12288);
        GLDS16(bp + kt * 32, st + 16384); GLDS16(bp + b64 + kt * 32, st + 16384 + 4096);
    };
    const int nt = K >> 5;
    asm volatile("s_waitcnt vmcnt(0) lgkmcnt(0)\n\ts_barrier" ::: "memory");
    issue(0);
    if (nt > 1) issue(1);
    for (int t = 0; t < nt; ++t) {
        if (t + 1 < nt) asm volatile("s_waitcnt vmcnt(6)" ::: "memory");
        else asm volatile("s_waitcnt vmcnt(0)" ::: "memory");
        asm volatile("s_barrier" ::: "memory");
        if (t + 2 < nt) issue(t + 2);
        const char* a = smem + (t % 3) * ST; const char* b = a + 16384;
        bf16x8 bfr[4];
#pragma unroll
        for (int n = 0; n < 4; ++n) bfr[n] = *(const bf16x8*)(b + (wc * 64 + n * 16 + fr) * 64 + fq * 16);
#pragma unroll
        for (int h = 0; h < 2; ++h) {
            bf16x8 af[4];
#pragma unroll
            for (int m = 0; m < 4; ++m) af[m] = *(const bf16x8*)(a + (wr * 128 + h * 64 + m * 16 + fr) * 64 + fq * 16);
#pragma unroll
            for (int m = 0; m < 4; ++m)
#pragma unroll
                for (int n = 0; n < 4; ++n) acc[h][m][n] = mfma16(bfr[n], af[m], acc[h][m][n]);
        }
    }
    u32x2 pk[2][4][4];
#pragma unroll
    for (int h = 0; h < 2; ++h)
#pragma unroll
        for (int m = 0; m < 4; ++m) {
            const int row = row0 + wr * 128 + h * 64 + m * 16 + fr;
            const float rs = rsqrtf(ssq2[row] * (1.0f / 1024.0f) + EPS);
#pragma unroll
            for (int n = 0; n < 4; ++n) {
                const f32x4 v = acc[h][m][n] * rs;
                pk[h][m][n].x = cvt_pk_bf16(v[0], v[1]); pk[h][m][n].y = cvt_pk_bf16(v[2], v[3]);
            }
        }
    constexpr int RS2 = 272;
    char* sA2 = smem; char* sKy = smem + 128 * RS2;
    asm volatile("s_waitcnt lgkmcnt(0)\n\ts_barrier" ::: "memory");
    {
        const bf16_t* kg = keysb + (size_t)g * 128 * 128;
#pragma unroll
        for (int i = 0; i < 8; ++i) { const int c = tid + i * 256, key = c >> 4, cc = c & 15; *(u32x4*)(sKy + key * RS2 + cc * 16) = *(const u32x4*)(kg + (size_t)key * 128 + cc * 8); }
    }
#pragma unroll 1
    for (int half = 0; half < 2; ++half) {
        if (wr == half) {
#pragma unroll
            for (int h = 0; h < 2; ++h)
#pragma unroll
                for (int m = 0; m < 4; ++m)
#pragma unroll
                    for (int n = 0; n < 4; ++n)
                        *(u32x2*)(sA2 + (h * 64 + m * 16 + fr) * RS2 + (wc * 64 + n * 16 + fq * 4) * 2) = pk[h][m][n];
        }
        __syncthreads();
        f32x4 acc2[4][4];
#pragma unroll
        for (int m = 0; m < 4; ++m)
#pragma unroll
            for (int n = 0; n < 4; ++n) acc2[m][n] = (f32x4){0.f, 0.f, 0.f, 0.f};
#pragma unroll
        for (int ks = 0; ks < 4; ++ks) {
            bf16x8 af[4], bfr[4];
#pragma unroll
            for (int m = 0; m < 4; ++m) af[m] = *(const bf16x8*)(sA2 + (wr * 64 + m * 16 + fr) * RS2 + ks * 64 + fq * 16);
#pragma unroll
            for (int n = 0; n < 4; ++n) bfr[n] = *(const bf16x8*)(sKy + (wc * 64 + n * 16 + fr) * RS2 + ks * 64 + fq * 16);
#pragma unroll
            for (int m = 0; m < 4; ++m)
#pragma unroll
                for (int n = 0; n < 4; ++n) acc2[m][n] = mfma16(bfr[n], af[m], acc2[m][n]);
        }
#pragma unroll
        for (int m = 0; m < 4; ++m) {
            const int row = row0 + half * 128 + wr * 64 + m * 16 + fr;
#pragma unroll
            for (int n = 0; n < 4; ++n) {
                const f32x4 v = acc2[m][n];
                u32x2 w; w.x = cvt_pk_bf16(v[0], v[1]); w.y = cvt_pk_bf16(v[2], v[3]);
                *(u32x2*)(scores + (size_t)row * 2048 + col0 + wc * 64 + n * 16 + fq * 4) = w;
            }
        }
        __syncthreads();
    }
}

struct PlainA {
    const bf16_t* A; int lda;
    DEV u32x4 operator()(int row, int k) const { return *(const u32x4*)(A + (size_t)row * lda + k); }
};

DEV void tr_tile(const float* __restrict__ src, int ldn, bf16_t* __restrict__ dst, int ldk, int k0, int n0, int drow0,
                 const float* __restrict__ gain, float* tileS) {
    int tid = threadIdx.x; asm volatile("" : "+v"(tid));
    __syncthreads();
#pragma unroll 4
    for (int i = 0; i < 16; ++i) {
        const int kk = i * 4 + (tid >> 6), nn = tid & 63;
        float v = src[(size_t)(k0 + kk) * ldn + n0 + nn];
        if (gain) v *= gain[k0 + kk];
        tileS[kk * 65 + nn] = v;
    }
    __syncthreads();
#pragma unroll 4
    for (int i = 0; i < 16; ++i) {
        const int nn = i * 4 + (tid >> 6), kk = tid & 63;
        const float v = tileS[kk * 65 + nn];
        dst[(size_t)(drow0 + nn) * ldk + k0 + kk] = (bf16_t)(cvt_pk_bf16(v, 0.f) & 0xffffu);
    }
}

template <int DQK, int DV, bool PREF, int QB>
DEV void attn_item(const bf16_t* __restrict__ q, int ldq, const bf16_t* __restrict__ k, int ldk,
                   const bf16_t* __restrict__ vT, int ldv, int ntiles, int tiles_lo, bf16_t* __restrict__ out, int ldo, char* smem) {
    constexpr int KS = DQK / 32, DB = DV / 16;
    constexpr int KSTR = DQK * 2 + 16;
    constexpr int VSTR = 144;
    constexpr int KCH = 64 * DQK / 8 / 256, VCH = DV * 64 / 8 / 256, KCW = DQK / 8;
    char* sK = smem; char* sV = smem + 64 * KSTR;
    int tid = threadIdx.x; asm volatile("" : "+v"(tid));
    const int wid = __builtin_amdgcn_readfirstlane(tid >> 6), lane = tid & 63, fr = lane & 15, fq = lane >> 4;
    const int my_tiles = (wid < 2) ? tiles_lo : ntiles;
    bf16x8 qf[QB][KS];
#pragma unroll
    for (int qi = 0; qi < QB; ++qi) {
        const bf16_t* qrow = q + (size_t)(wid * 16 * QB + qi * 16 + fr) * ldq;
#pragma unroll
        for (int ks = 0; ks < KS; ++ks) qf[qi][ks] = *(const bf16x8*)(qrow + ks * 32 + fq * 8);
    }
    f32x4 o[QB][DB];
    float mrow[QB], lsum[QB];
#pragma unroll
    for (int qi = 0; qi < QB; ++qi) {
        mrow[qi] = -1e30f; lsum[qi] = 0.f;
#pragma unroll
        for (int db = 0; db < DB; ++db) o[qi][db] = (f32x4){0.f, 0.f, 0.f, 0.f};
    }
    constexpr bool PREFV = PREF && (DV <= 128);
    u32x4 kr[PREF ? KCH : 1], vr[PREFV ? VCH : 1];
    if (PREF) {
#pragma unroll
        for (int i = 0; i < KCH; ++i) { const int c = tid + i * 256, key = c / KCW, cc = c % KCW; kr[PREF ? i : 0] = *(const u32x4*)(k + (size_t)key * ldk + cc * 8); }
        if (PREFV) {
#pragma unroll
            for (int i = 0; i < VCH; ++i) { const int c = tid + i * 256, d = c >> 3, cc = c & 7; vr[PREFV ? i : 0] = *(const u32x4*)(vT + (size_t)d * ldv + cc * 8); }
        }
    }
    for (int kt = 0; kt < ntiles; ++kt) {
        __syncthreads();
        {
            const int kn = kt * 64;
            if (PREF) {
#pragma unroll
                for (int i = 0; i < KCH; ++i) { const int c = tid + i * 256, key = c / KCW, cc = c % KCW; *(u32x4*)(sK + key * KSTR + cc * 16) = kr[PREF ? i : 0]; }
            } else {
#pragma unroll 4
                for (int i = 0; i < KCH; ++i) { const int c = tid + i * 256, key = c / KCW, cc = c % KCW; *(u32x4*)(sK + key * KSTR + cc * 16) = *(const u32x4*)(k + (size_t)(kn + key) * ldk + cc * 8); }
            }
            if (PREFV) {
#pragma unroll
                for (int i = 0; i < VCH; ++i) { const int c = tid + i * 256, d = c >> 3, cc = c & 7; *(u32x4*)(sV + d * VSTR + cc * 16) = vr[PREFV ? i : 0]; }
            } else {
#pragma unroll 4
                for (int i = 0; i < VCH; ++i) { const int c = tid + i * 256, d = c >> 3, cc = c & 7; *(u32x4*)(sV + d * VSTR + cc * 16) = *(const u32x4*)(vT + (size_t)d * ldv + kn + cc * 8); }
            }
        }
        __syncthreads();
        if (PREF && kt + 1 < ntiles) {
            const int kn = (kt + 1) * 64;
#pragma unroll
            for (int i = 0; i < KCH; ++i) { const int c = tid + i * 256, key = c / KCW, cc = c % KCW; kr[PREF ? i : 0] = *(const u32x4*)(k + (size_t)(kn + key) * ldk + cc * 8); }
            if (PREFV) {
#pragma unroll
                for (int i = 0; i < VCH; ++i) { const int c = tid + i * 256, d = c >> 3, cc = c & 7; vr[PREFV ? i : 0] = *(const u32x4*)(vT + (size_t)d * ldv + kn + cc * 8); }
            }
        }
        if (kt < my_tiles) {
            f32x4 s[QB][4];
#pragma unroll
            for (int kb = 0; kb < 4; ++kb) {
#pragma unroll
                for (int qi = 0; qi < QB; ++qi) s[qi][kb] = (f32x4){0.f, 0.f, 0.f, 0.f};
#pragma unroll
                for (int ks = 0; ks < KS; ++ks) {
                    const bf16x8 kf = *(const bf16x8*)(sK + (kb * 16 + fr) * KSTR + ks * 64 + fq * 16);
#pragma unroll
                    for (int qi = 0; qi < QB; ++qi) s[qi][kb] = mfma16(kf, qf[qi][ks], s[qi][kb]);
                }
            }
            bf16x8 pf[QB][2];
#pragma unroll
            for (int qi = 0; qi < QB; ++qi) {
                float mx = -1e30f;
#pragma unroll
                for (int kb = 0; kb < 4; ++kb)
#pragma unroll
                    for (int j = 0; j < 4; ++j) mx = fmaxf(mx, s[qi][kb][j]);
                mx = fmaxf(mx, __shfl_xor(mx, 16)); mx = fmaxf(mx, __shfl_xor(mx, 32));
                const float mnew = fmaxf(mrow[qi], mx);
                const float alpha = __builtin_amdgcn_exp2f(mrow[qi] - mnew);
                mrow[qi] = mnew;
                float ps = 0.f;
#pragma unroll
                for (int kb = 0; kb < 4; ++kb)
#pragma unroll
                    for (int j = 0; j < 4; ++j) { const float e = __builtin_amdgcn_exp2f(s[qi][kb][j] - mnew); s[qi][kb][j] = e; ps += e; }
                lsum[qi] = lsum[qi] * alpha + ps;
#pragma unroll
                for (int db = 0; db < DB; ++db) o[qi][db] *= alpha;
#pragma unroll
                for (int g = 0; g < 2; ++g) {
                    u32x4 w;
                    w.x = cvt_pk_bf16(s[qi][2 * g][0], s[qi][2 * g][1]); w.y = cvt_pk_bf16(s[qi][2 * g][2], s[qi][2 * g][3]);
                    w.z = cvt_pk_bf16(s[qi][2 * g + 1][0], s[qi][2 * g + 1][1]); w.w = cvt_pk_bf16(s[qi][2 * g + 1][2], s[qi][2 * g + 1][3]);
                    pf[qi][g] = as_bf16x8(w);
                }
            }
#pragma unroll
            for (int db = 0; db < DB; ++db) {
#pragma unroll
                for (int g = 0; g < 2; ++g) {
                    const u32x2 v0 = *(const u32x2*)(sV + (db * 16 + fr) * VSTR + ((2 * g) * 16 + fq * 4) * 2);
                    const u32x2 v1 = *(const u32x2*)(sV + (db * 16 + fr) * VSTR + ((2 * g + 1) * 16 + fq * 4) * 2);
                    u32x4 w; w.x = v0.x; w.y = v0.y; w.z = v1.x; w.w = v1.y;
#pragma unroll
                    for (int qi = 0; qi < QB; ++qi) o[qi][db] = mfma16(as_bf16x8(w), pf[qi][g], o[qi][db]);
                }
            }
        }
    }
#pragma unroll
    for (int qi = 0; qi < QB; ++qi) {
        float l = lsum[qi];
        l += __shfl_xor(l, 16); l += __shfl_xor(l, 32);
        const float inv = 1.0f / l;
        bf16_t* orow = out + (size_t)(wid * 16 * QB + qi * 16 + fr) * ldo + fq * 4;
#pragma unroll
        for (int db = 0; db < DB; ++db) {
            u32x2 w; w.x = cvt_pk_bf16(o[qi][db][0] * inv, o[qi][db][1] * inv); w.y = cvt_pk_bf16(o[qi][db][2] * inv, o[qi][db][3] * inv);
            *(u32x2*)(orow + db * 16) = w;
        }
    }
}

#define XB_TMO      128
#define XB_XCNT(j)  (256  + 64 * (j))
#define XB_XSUB(j)  (1280 + 64 * (j))
#define XB_XGEN(j)  (2304 + 64 * (j))
#define XB_TOP      3328
#define XB_TOPGEN   3392
#define XCD_BAR_WORDS 3456
#define XB_SPIN_CAP (1u << 18)
#define LAS __attribute__((address_space(3)))
DEV unsigned xb_ld(unsigned* p)              { return __hip_atomic_load(p, __ATOMIC_RELAXED, __HIP_MEMORY_SCOPE_AGENT); }
DEV unsigned xb_add(unsigned* p, unsigned v) { return __hip_atomic_fetch_add(p, v, __ATOMIC_RELAXED, __HIP_MEMORY_SCOPE_AGENT); }
DEV unsigned xb_xcc_id() { return (unsigned)__builtin_amdgcn_s_getreg((3 << 11) | 20) & 0xFu; }
#define XB_SPIN(cond, bar) do { unsigned _sp = 0; while (cond) { __builtin_amdgcn_s_sleep(1); \
    if ((++_sp & 255u) == 0u) { if (xb_ld(&(bar)[XB_TMO])) break; if (_sp > XB_SPIN_CAP) { atomicAdd(&(bar)[XB_TMO], 1u); break; } } } } while (0)
struct XcdBarrier { unsigned* bar; unsigned x; volatile LAS unsigned* st; };
DEV XcdBarrier xcd_barrier_post(unsigned* bar, volatile LAS unsigned* st) {
    XcdBarrier b; b.bar = bar; b.x = xb_xcc_id(); b.st = st;
    if (threadIdx.x == 0) (void)xb_add(&bar[XB_XCNT(b.x)], 1u);
    return b;
}
DEV void xcd_barrier_complete(unsigned* bar, unsigned x, unsigned& nloc, unsigned& nx) {
    const unsigned G = gridDim.x * gridDim.y * gridDim.z;
    unsigned sum, cnt, mine, sp = 0u;
    for (;;) {
        sum = 0u; cnt = 0u; mine = 0u;
#pragma unroll
        for (unsigned j = 0; j < 16; ++j) { const unsigned c = xb_ld(&bar[XB_XCNT(j)]); sum += c; cnt += (c > 0u) ? 1u : 0u; mine = (j == x) ? c : mine; }
        if (sum == G) break;
        __builtin_amdgcn_s_sleep(1);
        if ((++sp & 255u) == 0u) { if (xb_ld(&bar[XB_TMO])) break; if (sp > XB_SPIN_CAP) { atomicAdd(&bar[XB_TMO], 1u); break; } }
    }
    nloc = mine > 0u ? mine : 1u; nx = cnt > 0u ? cnt : 1u;
}
DEV void xcd_barrier(const XcdBarrier& b) {
    asm volatile("s_waitcnt vmcnt(0)" ::: "memory");
    __syncthreads();
    if (threadIdx.x == 0) {
        unsigned* bar = b.bar;
        __builtin_amdgcn_s_waitcnt(0);
        unsigned nloc = b.st[0], nx = b.st[1];
        if (nloc == 0u) { xcd_barrier_complete(bar, b.x, nloc, nx); b.st[0] = nloc; b.st[1] = nx; }
        const unsigned old = xb_add(&bar[XB_XSUB(b.x)], 1u);
        const unsigned gen = old / nloc;
        if (old + 1u == (gen + 1u) * nloc) {
            __builtin_amdgcn_fence(__ATOMIC_RELEASE, "agent");
            asm volatile("s_waitcnt vmcnt(0)" ::: "memory");
            const unsigned og = xb_add(&bar[XB_TOP], 1u);
            const unsigned tg = og / nx;
            if (og + 1u == (tg + 1u) * nx) xb_add(&bar[XB_TOPGEN], 1u);
            else XB_SPIN(xb_ld(&bar[XB_TOPGEN]) == tg, bar);
            __builtin_amdgcn_fence(__ATOMIC_ACQUIRE, "agent");
            xb_add(&bar[XB_XGEN(b.x)], 1u);
            asm volatile("s_waitcnt vmcnt(0)" ::: "memory");
        } else {
            XB_SPIN(xb_ld(&bar[XB_XGEN(b.x)]) == gen, bar);
            __builtin_amdgcn_fence(__ATOMIC_ACQUIRE, "agent");
            asm volatile("s_waitcnt vmcnt(0)" ::: "memory");
        }
    }
    __syncthreads();
}

DEV unsigned ordkey(float f) { const unsigned u = __float_as_uint(f); return (u & 0x80000000u) ? ~u : (u | 0x80000000u); }
DEV float unordkey(unsigned k) { const unsigned u = (k & 0x80000000u) ? (k & 0x7fffffffu) : ~k; return __uint_as_float(u); }
#define TOPK_INSERT(L, xk) { unsigned x_ = (xk); _Pragma("unroll") for (int s_ = 0; s_ < 16; ++s_) { const unsigned hi_ = max(L[s_], x_); x_ = min(L[s_], x_); L[s_] = hi_; } }
DEV unsigned byte_lookup(unsigned p0, unsigned p1, unsigned p2, unsigned p3, int a) {
    const unsigned w = (a < 8) ? ((a < 4) ? p0 : p1) : ((a < 12) ? p2 : p3);
    return (w >> ((a & 3) * 8)) & 0xffu;
}

DEV void grid_barrier(unsigned* bar, unsigned nblocks, unsigned& gen) {
    __threadfence();
    __syncthreads();
    gen += 1;
    if (threadIdx.x == 0) {
        const unsigned target = gen * nblocks;
        __hip_atomic_fetch_add(bar, 1u, __ATOMIC_RELEASE, __HIP_MEMORY_SCOPE_AGENT);
        while (__hip_atomic_load(bar, __ATOMIC_ACQUIRE, __HIP_MEMORY_SCOPE_AGENT) < target) __builtin_amdgcn_s_sleep(2);
    }
    __syncthreads();
    __threadfence();
}
#ifdef TIMED_MASK
#define GRID_SYNC() do { xcd_barrier(xb); { const long long tn_ = (long long)__builtin_amdgcn_s_memrealtime(); if ((TIMED_MASK >> ph_idx) & 1) t_acc += tn_ - t_last; t_last = tn_; ph_idx++; } } while (0)
#else
#define GRID_SYNC() xcd_barrier(xb)
#endif
#ifndef PH
#define PH 0x0FFF
#endif
constexpr int SMEM_BYTES = 4 * 128 * 144;

__global__ void __launch_bounds__(256, 2) fwd_megakernel(Params P) {
    cg::grid_group grid = cg::this_grid();
    __shared__ __attribute__((aligned(16))) char smem[SMEM_BYTES];
    __shared__ int s_item;
    const int nb = gridDim.x, bid = blockIdx.x;
    const int gsz = nb * 256;
    __shared__ uint4 xb_words;
    if (threadIdx.x == 0) xb_words = make_uint4(0u, 0u, 0u, 0u);
    __syncthreads();
    if (P.ws == nullptr) grid.sync();
    XcdBarrier xb = xcd_barrier_post((unsigned*)(P.ws + O_XBAR), (volatile LAS unsigned*)&xb_words);
#ifdef TIMED_MASK
    long long t_acc = 0, t_last = (long long)__builtin_amdgcn_s_memrealtime(); int ph_idx = 0;
#endif
#define XCD_TILE_LOOP(NM, NN, tm, tn) \
    for (int q_ = (bid % (nb >> 3)), R_ = (NM) >> 3, tm, tn; q_ < R_ * (NN) && ((tn = q_ / R_), (tm = (bid / (nb >> 3)) * R_ + q_ % R_), true); q_ += (nb >> 3))
#define PHASE_IDS int tid = threadIdx.x; asm volatile("" : "+v"(tid)); const int wid = __builtin_amdgcn_readfirstlane(tid >> 6), lane = tid & 63; const int gtid = bid * 256 + tid; (void)wid; (void)lane; (void)gtid;
    char* ws = P.ws;
    float* ssq0 = (float*)(ws + O_SSQ);
    float* ssqm = (float*)(ws + O_SSQ + 65536);
    float* ssqq = (float*)(ws + O_SSQ + 2 * 65536);
    float* ssqkv = (float*)(ws + O_SSQ + 3 * 65536);
    float* ssq1 = (float*)(ws + O_SSQ + 4 * 65536);
    float* ssq2 = (float*)(ws + O_SSQ + 5 * 65536);
    int* counters = (int*)(ws + O_CNT);
    float2* ropetab = (float2*)(ws + O_ROPE);
    bf16_t* p = (bf16_t*)(ws + O_P);
    bf16_t* qmla = (bf16_t*)P.out;
    bf16_t* kfull = (bf16_t*)((char*)P.out + 24 * MB);
    bf16_t* vTm = (bf16_t*)((char*)P.out + 48 * MB);

    auto do_tr = [&](int tile) {
        float* tileS = (float*)smem;

            const float* src; int ldn; bf16_t* dst; int ldk; int KT; int loc; const float* gain = nullptr; int drow_add = 0;
            bool ukv = false;
            if (tile < 560) { loc = tile; src = P.w_in; ldn = 2240; dst = (bf16_t*)(ws + O_WINT); ldk = 1024; KT = 16; gain = P.norm_mix_g; }
            else if (tile < 608) { loc = tile - 560; src = P.w_uq; ldn = 768; dst = (bf16_t*)(ws + O_WUQT); ldk = 256; KT = 4; gain = P.q_norm_g; }
            else if (tile < 640) { loc = tile - 608; src = P.w_ukv; ldn = 1024; dst = (bf16_t*)(ws + O_WUKT); ldk = 128; KT = 2; gain = P.kv_norm_g; ukv = true; }
            else if (tile < 648) { loc = tile - 640; src = P.rw_w_up; ldn = 512; dst = (bf16_t*)(ws + O_WUPT); ldk = 64; KT = 1; }
            else if (tile < 656) { loc = tile - 648; src = P.rw_a_up; ldn = 512; dst = (bf16_t*)(ws + O_AUPT); ldk = 64; KT = 1; }
            else if (tile < 672) { loc = tile - 656; src = P.rw_g_up; ldn = 512; dst = (bf16_t*)(ws + O_GUPT); ldk = 128; KT = 2; }
            else if (tile < 928) { loc = tile - 672; src = P.w_out; ldn = 1024; dst = (bf16_t*)(ws + O_WOUTT); ldk = 1024; KT = 16; }
            else if (tile < 1184) { loc = tile - 928; src = P.xa_wq; ldn = 1024; dst = (bf16_t*)(ws + O_XAQT); ldk = 1024; KT = 16; gain = P.norm_xa_g; }
            else if (tile < 1440) { loc = tile - 1184; src = P.xa_wk; ldn = 1024; dst = (bf16_t*)(ws + O_XAKVT); ldk = 1024; KT = 16; gain = P.norm_mem_g; }
            else if (tile < 1696) { loc = tile - 1440; src = P.xa_wv; ldn = 1024; dst = (bf16_t*)(ws + O_XAKVT); ldk = 1024; KT = 16; gain = P.norm_mem_g; drow_add = 1024; }
            else if (tile < 1952) { loc = tile - 1696; src = P.xa_wo; ldn = 1024; dst = (bf16_t*)(ws + O_XAOT); ldk = 1024; KT = 16; }
            else { loc = tile - 1952; src = P.peer_wq; ldn = 2048; dst = (bf16_t*)(ws + O_PWQT); ldk = 1024; KT = 16; gain = P.norm_ffn_g; }
            const int kt = loc % KT, ntile = loc / KT;
            int n0 = ntile * 64, drow0 = n0 + drow_add;
            if (ukv) {
                const int h = n0 >> 8, part = (n0 >> 7) & 1, d0 = n0 & 127;
                if (part) dst = (bf16_t*)(ws + O_WUVT);
                drow0 = h * 128 + d0;
            }
            tr_tile(src, ldn, dst, ldk, kt * 64, n0, drow0, gain, tileS);
            };
    auto convert_experts = [&](int r0, int r1, int wid, int lane) {
        unsigned char* e8u = (unsigned char*)(ws + O_EUB);
        unsigned char* e8v = (unsigned char*)(ws + O_EVB);
        float* esinv = (float*)(ws + O_SSQ + 6 * 65536);
        for (int r = r0 + wid; r < r1; r += 4) {
            const float* src = (r < 16384) ? (P.expert_u + (size_t)r * 1024) : (P.expert_v + (size_t)(r - 16384) * 1024);
            unsigned char* dst = (r < 16384) ? (e8u + (size_t)r * 1024) : (e8v + (size_t)(r - 16384) * 1024);
            f32x4 v[4]; float amax = 0.f;
#pragma unroll
            for (int i = 0; i < 4; ++i) {
                v[i] = *(const f32x4*)(src + i * 256 + lane * 4);
                amax = fmaxf(amax, fmaxf(fmaxf(fabsf(v[i][0]), fabsf(v[i][1])), fmaxf(fabsf(v[i][2]), fabsf(v[i][3]))));
            }
#pragma unroll
            for (int o = 32; o >= 1; o >>= 1) amax = fmaxf(amax, __shfl_xor(amax, o));
            amax = fmaxf(amax, 1e-30f);
            const float sc = 240.0f / amax;
#pragma unroll
            for (int i = 0; i < 4; ++i) {
                int w = 0;
                w = __builtin_amdgcn_cvt_pk_fp8_f32(v[i][0] * sc, v[i][1] * sc, w, false);
                w = __builtin_amdgcn_cvt_pk_fp8_f32(v[i][2] * sc, v[i][3] * sc, w, true);
                *(int*)(dst + i * 256 + lane * 4) = w;
            }
            if (lane == 0) esinv[r] = amax * (1.0f / 240.0f);
        }
    };
    if (PH & (1 << 0)) {
        PHASE_IDS
        for (int tile = bid; tile < 672 + 512; tile += nb) do_tr(tile < 672 ? tile : tile + 512);
        bf16_t* xb = (bf16_t*)(ws + O_XB);
        bf16_t* memb = (bf16_t*)(ws + O_MEMB);
        for (int r = bid * 4 + wid; r < T + 2048; r += nb * 4) {
            const float* srow = (r < T) ? (P.x + (size_t)r * 1024) : (P.mem + (size_t)(r - T) * 1024);
            bf16_t* drow = (r < T) ? (xb + (size_t)r * 1024) : (memb + (size_t)(r - T) * 1024);
            float ss = 0.f;
#pragma unroll
            for (int i = 0; i < 4; ++i) {
                const f32x4 v = *(const f32x4*)(srow + i * 256 + lane * 4);
                ss += v[0] * v[0] + v[1] * v[1] + v[2] * v[2] + v[3] * v[3];
                u32x2 w; w.x = cvt_pk_bf16(v[0], v[1]); w.y = cvt_pk_bf16(v[2], v[3]);
                *(u32x2*)(drow + i * 256 + lane * 4) = w;
            }
            ss = wave_sum(ss);
            if (lane == 0) { if (r < T) ssq0[r] = ss; else ssqm[r - T] = ss; }
        }
        for (int i = gtid; i < T * 32; i += gsz) {
            const int row = i >> 5, f = i & 31;
            const float inv = exp2f(-(float)f * (13.287712379549449f / 32.0f));
            const float ang = (float)P.pos[row] * inv;
            ropetab[i] = make_float2(cosf(ang), sinf(ang));
        }
        for (int i = gtid; i < T; i += gsz) { ssqq[i] = 0.f; ssqkv[i] = 0.f; ssq1[i] = 0.f; ssq2[i] = 0.f; }
        if (gtid < 64) counters[gtid] = 0;
        {
            bf16_t* keysb = (bf16_t*)(ws + O_KEYS);
            for (int i = gtid; i < 16 * 128 * 128 / 4; i += gsz) {
                const f32x4 v = *(const f32x4*)(P.peer_keys + (size_t)i * 4);
                u32x2 w; w.x = cvt_pk_bf16(v[0], v[1]); w.y = cvt_pk_bf16(v[2], v[3]);
                *(u32x2*)(keysb + (size_t)i * 4) = w;
            }
        }
        {
            u32x4* z = (u32x4*)(ws + O_WINT + (size_t)2240 * 1024 * 2);
            for (int i = gtid; i < 64 * 1024 * 2 / 16; i += gsz) z[i] = (u32x4){0u, 0u, 0u, 0u};
        }
    }
    GRID_SYNC();

    if (PH & (1 << 1)) {
        PHASE_IDS
        const bf16_t* xb = (const bf16_t*)(ws + O_XB);
        const bf16_t* memb = (const bf16_t*)(ws + O_MEMB);
        const bf16_t* winT = (const bf16_t*)(ws + O_WINT);
        const bf16_t* xakvT = (const bf16_t*)(ws + O_XAKVT);
        bf16_t* km = (bf16_t*)(ws + O_KM);
        bf16_t* vmT = (bf16_t*)(ws + O_VMT);
        auto p_epi = [&](const f32x4 (&acc)[4][4], int rbase, int cbase, int fr, int fq) {
#pragma unroll
                        for (int m = 0; m < 4; ++m) {
                            const int row = rbase + m * 16 + fr;
                            const float rs = rsqrtf(ssq0[row] * (1.0f / 1024.0f) + EPS);
                            float ss = 0.f;
#pragma unroll
                            for (int n = 0; n < 4; ++n) {
                                const f32x4 v = acc[m][n] * rs;
                                ss += v[0] * v[0] + v[1] * v[1] + v[2] * v[2] + v[3] * v[3];
                                u32x2 w; w.x = cvt_pk_bf16(v[0], v[1]); w.y = cvt_pk_bf16(v[2], v[3]);
                                *(u32x2*)(p + (size_t)row * 2304 + cbase + n * 16 + fq * 4) = w;
                            }
                            if (cbase < 384) {
                                ss += __shfl_xor(ss, 16); ss += __shfl_xor(ss, 32);
                                if (fq == 0) atomicAdd((cbase < 256) ? &ssqq[row] : &ssqkv[row], ss);
                            }
                        }
                    };
        XCD_TILE_LOOP(64, 16, tm, tn) { gemm_tile_big<true>(xb, 1024, winT, 1024, 1024, tm * 256, tn * 128, smem, p_epi); }
        for (int item = bid; item < 256; item += nb) { const int tm = item >> 1, tn = 16 + (item & 1); gemm_tile_glds<true>(xb, 1024, winT, 1024, 1024, tm * 128, tn * 128, smem, p_epi); }
    }
    GRID_SYNC();

    if (PH & (1 << 2)) {
        PHASE_IDS
        const bf16_t* wuqT = (const bf16_t*)(ws + O_WUQT);
        const bf16_t* wukT = (const bf16_t*)(ws + O_WUKT);
        const bf16_t* wuvT = (const bf16_t*)(ws + O_WUVT);
        const bf16_t* wupT = (const bf16_t*)(ws + O_WUPT);
        const bf16_t* aupT = (const bf16_t*)(ws + O_AUPT);
        const bf16_t* gupT = (const bf16_t*)(ws + O_GUPT);
        bf16_t* gbuf = (bf16_t*)(ws + O_G);
        bf16_t* rwr = (bf16_t*)(ws + O_RW_R);
        bf16_t* rwk = (bf16_t*)(ws + O_RW_K);
        bf16_t* rwv = (bf16_t*)(ws + O_RW_V);
        bf16_t* rwkk = (bf16_t*)(ws + O_RW_KK);
        bf16_t* rwka = (bf16_t*)(ws + O_RW_KA);
        float* decay = (float*)(ws + O_DECAY);
        const float QSCALE = 0.07216878364870322f * 1.4426950408889634f;
        const int N0 = 64 * 6, N1 = N0 + 256, N2 = N1 + 256, N3 = N2 + 512, N4 = N3 + 512, N5 = N4 + 512;
        auto shifted8 = [&](int row, int pc, int j0, float (&o)[8]) {
            const u32x4 cur = *(const u32x4*)(p + (size_t)row * 2304 + pc);
            u32x4 prv = (u32x4){0u, 0u, 0u, 0u};
            if (row & 2047) prv = *(const u32x4*)(p + (size_t)(row - 1) * 2304 + pc);
            const f32x4 m0 = *(const f32x4*)(P.shift_mu + j0), m1 = *(const f32x4*)(P.shift_mu + j0 + 4);
            const unsigned cu[4] = {cur.x, cur.y, cur.z, cur.w}, pu[4] = {prv.x, prv.y, prv.z, prv.w};
#pragma unroll
            for (int i = 0; i < 4; ++i) {
                const float c0 = bf_lo(cu[i]), c1 = bf_hi(cu[i]), p0 = bf_lo(pu[i]), p1 = bf_hi(pu[i]);
                const float mu0 = (i < 2) ? m0[2 * i] : m1[2 * i - 4], mu1 = (i < 2) ? m0[2 * i + 1] : m1[2 * i - 3];
                o[2 * i] = c0 + (p0 - c0) * mu0; o[2 * i + 1] = c1 + (p1 - c1) * mu1;
            }
        };
        auto shifted4 = [&](int row, int pc, int j0, f32x4& o) {
            const u32x2 cur = *(const u32x2*)(p + (size_t)row * 2304 + pc);
            u32x2 prv = (u32x2){0u, 0u};
            if (row & 2047) prv = *(const u32x2*)(p + (size_t)(row - 1) * 2304 + pc);
            const f32x4 mu = *(const f32x4*)(P.shift_mu + j0);
            const float c0 = bf_lo(cur.x), c1 = bf_hi(cur.x), c2 = bf_lo(cur.y), c3 = bf_hi(cur.y);
            const float p0 = bf_lo(prv.x), p1 = bf_hi(prv.x), p2 = bf_lo(prv.y), p3 = bf_hi(prv.y);
            o[0] = c0 + (p0 - c0) * mu[0]; o[1] = c1 + (p1 - c1) * mu[1]; o[2] = c2 + (p2 - c2) * mu[2]; o[3] = c3 + (p3 - c3) * mu[3];
        };
        for (;;) {
            __syncthreads();
            if (tid == 0) s_item = atomicAdd(&counters[1], 1);
            __syncthreads();
            const int item = s_item;
            if (item >= N5) break;
            if (item < N0) {
                const int tm = item / 6, tn = item % 6;
                gemm_tile_big<true>(p, 2304, wuqT, 256, 256, tm * 256, tn * 128, smem,
                    [&](const f32x4 (&acc)[4][4], int rbase, int cbase, int fr, int fq) {
                        const bool rope = (cbase % 192) == 128;
#pragma unroll
                        for (int m = 0; m < 4; ++m) {
                            const int row = rbase + m * 16 + fr;
                            const float rs = rsqrtf(ssqq[row] * (1.0f / 256.0f) + EPS) * QSCALE;
                            f32x4 v[4];
#pragma unroll
                            for (int n = 0; n < 4; ++n) v[n] = acc[m][n] * rs;
                            if (rope) {
#pragma unroll
                                for (int n = 0; n < 2; ++n)
#pragma unroll
                                    for (int j = 0; j < 4; ++j) {
                                        const float2 cs = ropetab[row * 32 + n * 16 + fq * 4 + j];
                                        const float t1 = v[n][j], t2 = v[n + 2][j];
                                        v[n][j] = t1 * cs.x - t2 * cs.y; v[n + 2][j] = t1 * cs.y + t2 * cs.x;
                                    }
                            }
#pragma unroll
                            for (int n = 0; n < 4; ++n) {
                                u32x2 w; w.x = cvt_pk_bf16(v[n][0], v[n][1]); w.y = cvt_pk_bf16(v[n][2], v[n][3]);
                                *(u32x2*)(qmla + (size_t)row * 768 + cbase + n * 16 + fq * 4) = w;
                            }
                        }
                    });
            } else if (item < N1) {
                const int it = item - N0, tm = it >> 2, tn = it & 3;
                gemm_tile_big<true>(p + 256, 2304, wukT, 128, 128, tm * 256, tn * 128, smem,
                    [&](const f32x4 (&acc)[4][4], int rbase, int cbase, int fr, int fq) {
#pragma unroll
                        for (int m = 0; m < 4; ++m) {
                            const int row = rbase + m * 16 + fr;
                            const float rs = rsqrtf(ssqkv[row] * (1.0f / 128.0f) + EPS);
#pragma unroll
                            for (int n = 0; n < 4; ++n) {
                                const int col = cbase + n * 16 + fq * 4, h = col >> 7, d = col & 127;
                                const f32x4 v = acc[m][n] * rs;
                                u32x2 w; w.x = cvt_pk_bf16(v[0], v[1]); w.y = cvt_pk_bf16(v[2], v[3]);
                                *(u32x2*)(kfull + (size_t)row * 768 + h * 192 + d) = w;
                            }
                        }
                    });
            } else if (item < N2) {
                const int it = item - N1, tm = it >> 2, tn = it & 3;
                gemm_tile_big<false>(p + 256, 2304, wuvT, 128, 128, tm * 256, tn * 128, smem,
                    [&](const f32x4 (&acc)[4][4], int rbase, int cbase, int fr, int fq) {
#pragma unroll
                        for (int m = 0; m < 4; ++m) {
                            const int row = rbase + m * 16 + fq * 4;
                            const f32x4 sq = *(const f32x4*)(ssqkv + row);
                            f32x4 rs;
#pragma unroll
                            for (int j = 0; j < 4; ++j) rs[j] = rsqrtf(sq[j] * (1.0f / 128.0f) + EPS);
                            const int b = row >> 11, s = row & 2047;
#pragma unroll
                            for (int n = 0; n < 4; ++n) {
                                const int col = cbase + n * 16 + fr;
                                const f32x4 v = acc[m][n] * rs;
                                u32x2 w; w.x = cvt_pk_bf16(v[0], v[1]); w.y = cvt_pk_bf16(v[2], v[3]);
                                *(u32x2*)(vTm + ((size_t)(b * 512 + col)) * 2048 + s) = w;
                            }
                        }
                    });
            } else if (item < N3) {
                const int it = item - N2, tm = it >> 2, tn = it & 3;
                auto al = [&](int row, int k) -> u32x4 {
                    float o[8]; shifted8(row, 1984 + k, 1536 + k, o);
                    u32x4 w;
                    w.x = cvt_pk_bf16(tanhf(o[0]), tanhf(o[1])); w.y = cvt_pk_bf16(tanhf(o[2]), tanhf(o[3]));
                    w.z = cvt_pk_bf16(tanhf(o[4]), tanhf(o[5])); w.w = cvt_pk_bf16(tanhf(o[6]), tanhf(o[7]));
                    return w;
                };
                gemm_tile<true>(al, wupT, 64, 64, tm * 128, tn * 128, smem,
                    [&](const f32x4 (&acc)[4][4], int rbase, int cbase, int fr, int fq) {
#pragma unroll
                        for (int m = 0; m < 4; ++m) {
                            const int row = rbase + m * 16 + fr;
#pragma unroll
                            for (int n = 0; n < 4; ++n) {
                                const int col = cbase + n * 16 + fq * 4;
                                const f32x4 w0 = *(const f32x4*)(P.rw_w0 + col);
                                f32x4 dv;
#pragma unroll
                                for (int j = 0; j < 4; ++j) {
                                    const float wp = w0[j] + acc[m][n][j];
                                    const float z = -wp;
                                    const float sp = fmaxf(z, 0.f) + log1pf(__expf(-fabsf(z)));
                                    dv[j] = __expf(-__expf(-sp - 0.5f));
                                }
                                *(f32x4*)(decay + (size_t)row * 512 + col) = dv;
                            }
                        }
                    });
            } else if (item < N4) {
                const int it = item - N3, tm = it >> 2, tn = it & 3;
                auto al = [&](int row, int k) -> u32x4 {
                    float o[8]; shifted8(row, 2048 + k, 1600 + k, o);
                    u32x4 w;
                    w.x = cvt_pk_bf16(o[0], o[1]); w.y = cvt_pk_bf16(o[2], o[3]); w.z = cvt_pk_bf16(o[4], o[5]); w.w = cvt_pk_bf16(o[6], o[7]);
                    return w;
                };
                gemm_tile<true>(al, aupT, 64, 64, tm * 128, tn * 128, smem,
                    [&](const f32x4 (&acc)[4][4], int rbase, int cbase, int fr, int fq) {
#pragma unroll
                        for (int m = 0; m < 4; ++m) {
                            const int row = rbase + m * 16 + fr;
                            f32x4 kv[4], kkr[4], av[4];
                            float ss = 0.f;
#pragma unroll
                            for (int n = 0; n < 4; ++n) {
                                const int col = cbase + n * 16 + fq * 4;
                                shifted4(row, 960 + col, 512 + col, kv[n]);
                                const f32x4 kkw = *(const f32x4*)(P.rw_k_k + col);
                                const f32x4 a0 = *(const f32x4*)(P.rw_a0 + col);
#pragma unroll
                                for (int j = 0; j < 4; ++j) {
                                    kkr[n][j] = kv[n][j] * kkw[j]; ss += kkr[n][j] * kkr[n][j];
                                    av[n][j] = sigmoidf_(a0[j] + acc[m][n][j]);
                                }
                            }
                            ss += __shfl_xor(ss, 16); ss += __shfl_xor(ss, 32);
                            const float inv = 1.0f / fmaxf(sqrtf(ss), 1e-12f);
#pragma unroll
                            for (int n = 0; n < 4; ++n) {
                                const int col = cbase + n * 16 + fq * 4;
                                const f32x4 ka = *(const f32x4*)(P.rw_k_a + col);
                                f32x4 rv, vv, kk, k2, kka;
                                shifted4(row, 448 + col, col, rv);
                                shifted4(row, 1472 + col, 1024 + col, vv);
#pragma unroll
                                for (int j = 0; j < 4; ++j) {
                                    kk[j] = kkr[n][j] * inv;
                                    k2[j] = kv[n][j] * (1.0f + (av[n][j] - 1.0f) * ka[j]);
                                    kka[j] = kk[j] * av[n][j];
                                }
                                const size_t o = (size_t)row * 512 + col;
                                u32x2 w;
                                w.x = cvt_pk_bf16(rv[0], rv[1]); w.y = cvt_pk_bf16(rv[2], rv[3]); *(u32x2*)(rwr + o) = w;
                                w.x = cvt_pk_bf16(k2[0], k2[1]); w.y = cvt_pk_bf16(k2[2], k2[3]); *(u32x2*)(rwk + o) = w;
                                w.x = cvt_pk_bf16(vv[0], vv[1]); w.y = cvt_pk_bf16(vv[2], vv[3]); *(u32x2*)(rwv + o) = w;
                                w.x = cvt_pk_bf16(kk[0], kk[1]); w.y = cvt_pk_bf16(kk[2], kk[3]); *(u32x2*)(rwkk + o) = w;
                                w.x = cvt_pk_bf16(kka[0], kka[1]); w.y = cvt_pk_bf16(kka[2], kka[3]); *(u32x2*)(rwka + o) = w;
                            }
                        }
                    });
            } else {
                const int it = item - N4, tm = it >> 2, tn = it & 3;
                auto al = [&](int row, int k) -> u32x4 {
                    float o[8]; shifted8(row, 2112 + k, 1664 + k, o);
                    u32x4 w;
                    w.x = cvt_pk_bf16(sigmoidf_(o[0]), sigmoidf_(o[1])); w.y = cvt_pk_bf16(sigmoidf_(o[2]), sigmoidf_(o[3]));
                    w.z = cvt_pk_bf16(sigmoidf_(o[4]), sigmoidf_(o[5])); w.w = cvt_pk_bf16(sigmoidf_(o[6]), sigmoidf_(o[7]));
                    return w;
                };
                gemm_tile<true>(al, gupT, 128, 128, tm * 128, tn * 128, smem,
                    [&](const f32x4 (&acc)[4][4], int rbase, int cbase, int fr, int fq) {
#pragma unroll
                        for (int m = 0; m < 4; ++m) {
                            const int row = rbase + m * 16 + fr;
#pragma unroll
                            for (int n = 0; n < 4; ++n) {
                                const f32x4 v = acc[m][n];
                                u32x2 w; w.x = cvt_pk_bf16(v[0], v[1]); w.y = cvt_pk_bf16(v[2], v[3]);
                                *(u32x2*)(gbuf + (size_t)row * 512 + cbase + n * 16 + fq * 4) = w;
                            }
                        }
                    });
            }
        }
        for (int i = gtid; i < T * 32; i += gsz) {
            const int row = i >> 5, f = i & 31;
            const float t1 = __uint_as_float((unsigned)p[(size_t)row * 2304 + 384 + f] << 16);
            const float t2 = __uint_as_float((unsigned)p[(size_t)row * 2304 + 416 + f] << 16);
            const float2 cs = ropetab[i];
            const bf16_t o1 = (bf16_t)(cvt_pk_bf16(t1 * cs.x - t2 * cs.y, 0.f) & 0xffffu);
            const bf16_t o2 = (bf16_t)(cvt_pk_bf16(t1 * cs.y + t2 * cs.x, 0.f) & 0xffffu);
#pragma unroll
            for (int h = 0; h < 4; ++h) { kfull[(size_t)row * 768 + h * 192 + 128 + f] = o1; kfull[(size_t)row * 768 + h * 192 + 160 + f] = o2; }
        }
    }
    GRID_SYNC();

    if (PH & (1 << 3)) {
        PHASE_IDS
        const bf16_t* rwr = (const bf16_t*)(ws + O_RW_R);
        const bf16_t* rwk = (const bf16_t*)(ws + O_RW_K);
        const bf16_t* rwv = (const bf16_t*)(ws + O_RW_V);
        const bf16_t* rwkk = (const bf16_t*)(ws + O_RW_KK);
        const bf16_t* rwka = (const bf16_t*)(ws + O_RW_KA);
        const float* decay = (const float*)(ws + O_DECAY);
        bf16_t* yraw = (bf16_t*)(ws + O_YRAW);
        bf16_t* mix = (bf16_t*)(ws + O_MIX);
        for (;;) {
            __syncthreads();
            if (tid == 0) s_item = atomicAdd(&counters[0], 1);
            __syncthreads();
            const int item = s_item;
            if (item >= 256 + 512 + 128 + 320 + 512) break;
            if (item < 256) {
                const int b = item >> 5, h = (item >> 2) & 7, qr = item & 3;
                float* opnd = (float*)smem;
                float* vbuf = (float*)(smem + 40960);
                float* ybuf = (float*)(smem + 40960 + 2048);
                const int seg = lane & 15, rl = wid * 4 + (lane >> 4);
                const int lstep = tid >> 4, lc4 = (tid & 15) * 4;
                const int vstep = (tid & 63) >> 2, vc4 = (tid & 3) * 4;
                const size_t gbase = ((size_t)b * 2048) * 512 + h * 64;
                u32x2 pr_kk, pr_k, pr_r, pr_ka, pr_v; f32x4 pr_w;
                auto prefetch = [&](int ch) {
                    const size_t o = gbase + (size_t)(ch * 16 + lstep) * 512 + lc4;
                    pr_kk = *(const u32x2*)(rwkk + o); pr_k = *(const u32x2*)(rwk + o); pr_r = *(const u32x2*)(rwr + o); pr_ka = *(const u32x2*)(rwka + o);
                    pr_w = *(const f32x4*)(decay + o);
                    if (tid < 64) pr_v = *(const u32x2*)(rwv + gbase + (size_t)(ch * 16 + vstep) * 512 + qr * 16 + vc4);
                };
                auto commit = [&](int buf) {
                    float* ob = opnd + buf * 5120 + lstep * 64 + lc4;
                    *(f32x4*)(ob + 0 * 1024) = (f32x4){bf_lo(pr_kk.x), bf_hi(pr_kk.x), bf_lo(pr_kk.y), bf_hi(pr_kk.y)};
                    *(f32x4*)(ob + 1 * 1024) = pr_w;
                    *(f32x4*)(ob + 2 * 1024) = (f32x4){bf_lo(pr_k.x), bf_hi(pr_k.x), bf_lo(pr_k.y), bf_hi(pr_k.y)};
                    *(f32x4*)(ob + 3 * 1024) = (f32x4){bf_lo(pr_r.x), bf_hi(pr_r.x), bf_lo(pr_r.y), bf_hi(pr_r.y)};
                    *(f32x4*)(ob + 4 * 1024) = (f32x4){bf_lo(pr_ka.x), bf_hi(pr_ka.x), bf_lo(pr_ka.y), bf_hi(pr_ka.y)};
                    if (tid < 64) *(f32x4*)(vbuf + buf * 256 + vstep * 16 + vc4) = (f32x4){bf_lo(pr_v.x), bf_hi(pr_v.x), bf_lo(pr_v.y), bf_hi(pr_v.y)};
                };
                float s0 = 0.f, s1 = 0.f, s2 = 0.f, s3 = 0.f;
                prefetch(0); commit(0);
                __syncthreads();
                for (int ch = 0; ch < 128; ++ch) {
                    if (ch + 1 < 128) prefetch(ch + 1);
                    const float* ob = opnd + (ch & 1) * 5120 + seg * 4;
                    const float* vb = vbuf + (ch & 1) * 256 + rl;
                    float ykeep = 0.f;
                    f32x4 c_kk = *(const f32x4*)(ob + 0 * 1024), c_w = *(const f32x4*)(ob + 1 * 1024), c_k = *(const f32x4*)(ob + 2 * 1024);
                    f32x4 c_r = *(const f32x4*)(ob + 3 * 1024), c_a = *(const f32x4*)(ob + 4 * 1024);
                    float c_v = vb[0];
                    f32x4 r_prev = c_r;
#pragma unroll
                    for (int s = 0; s < 16; ++s) {
                        f32x4 n_kk = c_kk, n_w = c_w, n_k = c_k, n_r = c_r, n_a = c_a; float n_v = c_v;
                        if (s + 1 < 16) {
                            n_kk = *(const f32x4*)(ob + 0 * 1024 + (s + 1) * 64); n_w = *(const f32x4*)(ob + 1 * 1024 + (s + 1) * 64);
                            n_k = *(const f32x4*)(ob + 2 * 1024 + (s + 1) * 64); n_r = *(const f32x4*)(ob + 3 * 1024 + (s + 1) * 64);
                            n_a = *(const f32x4*)(ob + 4 * 1024 + (s + 1) * 64); n_v = vb[(s + 1) * 16];
                        }
                        __builtin_amdgcn_sched_barrier(0);
                        float t0 = opq(s0 * c_kk[0]), u0 = opq(s0 * r_prev[0]);
                        float t1 = opq(s1 * c_kk[1]), u1 = opq(s1 * r_prev[1]);
                        t0 = opq(__builtin_fmaf(s2, c_kk[2], t0)); u0 = opq(__builtin_fmaf(s2, r_prev[2], u0));
                        t1 = opq(__builtin_fmaf(s3, c_kk[3], t1)); u1 = opq(__builtin_fmaf(s3, r_prev[3], u1));
                        float sa = opq(t0 + t1), y = opq(u0 + u1);
                        const float kv0 = opq(c_k[0] * c_v), kv1 = opq(c_k[1] * c_v), kv2 = opq(c_k[2] * c_v), kv3 = opq(c_k[3] * c_v);
                        allreduce16_pair(sa, y);
                        if (s > 0 && (s - 1) == seg) ykeep = y;
                        const float nsa = -sa;
                        s0 = opq(__builtin_fmaf(s0, c_w[0], opq(__builtin_fmaf(c_a[0], nsa, kv0))));
                        s1 = opq(__builtin_fmaf(s1, c_w[1], opq(__builtin_fmaf(c_a[1], nsa, kv1))));
                        s2 = opq(__builtin_fmaf(s2, c_w[2], opq(__builtin_fmaf(c_a[2], nsa, kv2))));
                        s3 = opq(__builtin_fmaf(s3, c_w[3], opq(__builtin_fmaf(c_a[3], nsa, kv3))));
                        r_prev = c_r;
                        c_kk = n_kk; c_w = n_w; c_k = n_k; c_r = n_r; c_a = n_a; c_v = n_v;
                    }
                    {
                        float u0 = opq(s0 * r_prev[0]), u1 = opq(s1 * r_prev[1]);
                        u0 = opq(__builtin_fmaf(s2, r_prev[2], u0)); u1 = opq(__builtin_fmaf(s3, r_prev[3], u1));
                        float y = u0 + u1;
                        y = allreduce16(y);
                        if (seg == 15) ykeep = y;
                    }
                    ybuf[seg * 16 + rl] = ykeep;
                    lds_barrier();
                    yraw[gbase + (size_t)(ch * 16 + (tid >> 4)) * 512 + qr * 16 + (tid & 15)] = (bf16_t)(cvt_pk_bf16(ybuf[tid], 0.f) & 0xffffu);
                    if (ch + 1 < 128) commit((ch + 1) & 1);
                    lds_barrier();
                }
            } else if (item < 768) {
                const int a = item - 256, qb = 15 - (a >> 5), bh = a & 31, b = bh >> 2, h = bh & 3;
                const size_t row0 = (size_t)b * 2048 + qb * 128;
                attn_item<192, 128, false, 2>(qmla + row0 * 768 + h * 192, 768,
                                    kfull + ((size_t)b * 2048) * 768 + h * 192, 768,
                                    vTm + ((size_t)(b * 4 + h) * 128) * 2048, 2048, 2 * qb + 2, 2 * qb + 1,
                                    mix + row0 * 1024 + h * 128, 1024, smem);
            } else if (item < 896) {
                const int i_ = item - 768, tm = i_ >> 4, tn = i_ & 15;
                const bf16_t* memb = (const bf16_t*)(ws + O_MEMB);
                const bf16_t* xakvT = (const bf16_t*)(ws + O_XAKVT);
                bf16_t* km = (bf16_t*)(ws + O_KM);
                bf16_t* vmT = (bf16_t*)(ws + O_VMT);
                if (tn < 8) {
                    gemm_tile_big<true>(memb, 1024, xakvT, 1024, 1024, tm * 256, tn * 128, smem,
                        [&](const f32x4 (&acc)[4][4], int rbase, int cbase, int fr, int fq) {
#pragma unroll
                            for (int m = 0; m < 4; ++m) {
                                const int row = rbase + m * 16 + fr;
                                const float rs = rsqrtf(ssqm[row] * (1.0f / 1024.0f) + EPS);
#pragma unroll
                                for (int n = 0; n < 4; ++n) {
                                    const f32x4 v = acc[m][n] * rs;
                                    u32x2 w; w.x = cvt_pk_bf16(v[0], v[1]); w.y = cvt_pk_bf16(v[2], v[3]);
                                    *(u32x2*)(km + (size_t)row * 1024 + cbase + n * 16 + fq * 4) = w;
                                }
                            }
                        });
                } else {
                    gemm_tile_big<false>(memb, 1024, xakvT, 1024, 1024, tm * 256, tn * 128, smem,
                        [&](const f32x4 (&acc)[4][4], int rbase, int cbase, int fr, int fq) {
#pragma unroll
                            for (int m = 0; m < 4; ++m) {
                                const int row = rbase + m * 16 + fq * 4;
                                const f32x4 sq = *(const f32x4*)(ssqm + row);
                                f32x4 rs;
#pragma unroll
                                for (int j = 0; j < 4; ++j) rs[j] = rsqrtf(sq[j] * (1.0f / 1024.0f) + EPS);
                                const int b = row >> 8, mi = row & 255;
#pragma unroll
                                for (int n = 0; n < 4; ++n) {
                                    const int col = cbase + n * 16 + fr - 1024;
                                    const f32x4 v = acc[m][n] * rs;
                                    u32x2 w; w.x = cvt_pk_bf16(v[0], v[1]); w.y = cvt_pk_bf16(v[2], v[3]);
                                    *(u32x2*)(vmT + ((size_t)(b * 1024 + col)) * 256 + mi) = w;
                                }
                            }
                        });
                }
            } else {
                const int i_ = item - 896;
                if (i_ < 320) { for (int t_ = 0; t_ < 4; ++t_) { const int tl_ = i_ * 4 + t_; do_tr(tl_ < 512 ? 672 + tl_ : 1696 + (tl_ - 512)); } }
                else { const int r0_ = (i_ - 320) * 64; convert_experts(r0_, r0_ + 64, wid, lane); }
            }
        }
    }
    GRID_SYNC();

    if (PH & (1 << 4)) {
        PHASE_IDS
        const bf16_t* rwr = (const bf16_t*)(ws + O_RW_R);
        const bf16_t* rwk = (const bf16_t*)(ws + O_RW_K);
        const bf16_t* rwv = (const bf16_t*)(ws + O_RW_V);
        const bf16_t* gbuf = (const bf16_t*)(ws + O_G);
        const bf16_t* yraw = (const bf16_t*)(ws + O_YRAW);
        bf16_t* mix = (bf16_t*)(ws + O_MIX);
#pragma unroll 4
        for (int i = gtid; i < T * 128; i += gsz) {
            const int row = i >> 7, c4 = (i & 127) * 4;
            const size_t o = (size_t)row * 512 + c4;
            const u32x2 yu = *(const u32x2*)(yraw + o);
            const f32x4 y = (f32x4){bf_lo(yu.x), bf_hi(yu.x), bf_lo(yu.y), bf_hi(yu.y)};
            float s1 = y[0] + y[1] + y[2] + y[3];
#pragma unroll
            for (int d = 1; d < 16; d <<= 1) s1 += __shfl_xor(s1, d);
            const float mu = s1 * (1.0f / 64.0f);
            const f32x4 dy = y - mu;
            float s2 = dy[0] * dy[0] + dy[1] * dy[1] + dy[2] * dy[2] + dy[3] * dy[3];
            const u32x2 ru = *(const u32x2*)(rwr + o), ku = *(const u32x2*)(rwk + o), vu = *(const u32x2*)(rwv + o), gu = *(const u32x2*)(gbuf + o);
            const f32x4 rk = *(const f32x4*)(P.rw_r_k + c4);
            const f32x4 rv = (f32x4){bf_lo(ru.x), bf_hi(ru.x), bf_lo(ru.y), bf_hi(ru.y)};
            const f32x4 kv = (f32x4){bf_lo(ku.x), bf_hi(ku.x), bf_lo(ku.y), bf_hi(ku.y)};
            const f32x4 vv = (f32x4){bf_lo(vu.x), bf_hi(vu.x), bf_lo(vu.y), bf_hi(vu.y)};
            const f32x4 gv = (f32x4){bf_lo(gu.x), bf_hi(gu.x), bf_lo(gu.y), bf_hi(gu.y)};
            float s3 = rv[0] * kv[0] * rk[0] + rv[1] * kv[1] * rk[1] + rv[2] * kv[2] * rk[2] + rv[3] * kv[3] * rk[3];
#pragma unroll
            for (int d = 1; d < 16; d <<= 1) { s2 += __shfl_xor(s2, d); s3 += __shfl_xor(s3, d); }
            const float rstd = rsqrtf(s2 * (1.0f / 64.0f) + 64e-5f);
            const f32x4 lw = *(const f32x4*)(P.rw_lnx_w + c4), lb = *(const f32x4*)(P.rw_lnx_b + c4);
            f32x4 r;
#pragma unroll
            for (int j = 0; j < 4; ++j) {
#ifdef DBG_NOY
                r[j] = (lb[j] + s3 * vv[j]) * gv[j];
#else
                r[j] = (dy[j] * rstd * lw[j] + lb[j] + s3 * vv[j]) * gv[j];
#endif
            }
            u32x2 w; w.x = cvt_pk_bf16(r[0], r[1]); w.y = cvt_pk_bf16(r[2], r[3]);
            *(u32x2*)(mix + (size_t)row * 1024 + 512 + c4) = w;
        }
    }
    GRID_SYNC();

    if (PH & (1 << 5)) {
        PHASE_IDS
        const bf16_t* mix = (const bf16_t*)(ws + O_MIX);
        const bf16_t* woutT = (const bf16_t*)(ws + O_WOUTT);
        bf16_t* h1b = (bf16_t*)(ws + O_H1B);
        XCD_TILE_LOOP(64, 8, tm, tn) {
            auto almix = [&](int row, int k) -> u32x4 {
#ifdef DBG_ZERO_RWKV
                if (k >= 512) return (u32x4){0u, 0u, 0u, 0u};
#endif
#ifdef DBG_ZERO_MLA
                if (k < 512) return (u32x4){0u, 0u, 0u, 0u};
#endif
                return *(const u32x4*)(mix + (size_t)row * 1024 + k);
            };
            (void)almix; gemm_tile_big<true>(mix, 1024, woutT, 1024, 1024, tm * 256, tn * 128, smem,
                [&](const f32x4 (&acc)[4][4], int rbase, int cbase, int fr, int fq) {
#pragma unroll
                    for (int m = 0; m < 4; ++m) {
                        const int row = rbase + m * 16 + fr;
                        float ss = 0.f;
#pragma unroll
                        for (int n = 0; n < 4; ++n) {
                            const size_t o = (size_t)row * 1024 + cbase + n * 16 + fq * 4;
                            const f32x4 v = *(const f32x4*)(P.x + o) + acc[m][n];
                            ss += v[0] * v[0] + v[1] * v[1] + v[2] * v[2] + v[3] * v[3];
                            *(f32x4*)(P.out + o) = v;
                            u32x2 w; w.x = cvt_pk_bf16(v[0], v[1]); w.y = cvt_pk_bf16(v[2], v[3]);
                            *(u32x2*)(h1b + o) = w;
                        }
                        ss += __shfl_xor(ss, 16); ss += __shfl_xor(ss, 32);
                        if (fq == 0) atomicAdd(&ssq1[row], ss);
                    }
                });
        }
    }
    GRID_SYNC();

    if (PH & (1 << 6)) {
        PHASE_IDS
        const bf16_t* h1b = (const bf16_t*)(ws + O_H1B);
        const bf16_t* xaqT = (const bf16_t*)(ws + O_XAQT);
        bf16_t* qxa = (bf16_t*)(ws + O_QXA);
        const float XSCALE = 0.0625f * 1.4426950408889634f;
        XCD_TILE_LOOP(64, 8, tm, tn) {
            gemm_tile_big<true>(h1b, 1024, xaqT, 1024, 1024, tm * 256, tn * 128, smem,
                [&](const f32x4 (&acc)[4][4], int rbase, int cbase, int fr, int fq) {
#pragma unroll
                    for (int m = 0; m < 4; ++m) {
                        const int row = rbase + m * 16 + fr;
                        const float rs = rsqrtf(ssq1[row] * (1.0f / 1024.0f) + EPS) * XSCALE;
#pragma unroll
                        for (int n = 0; n < 4; ++n) {
                            const f32x4 v = acc[m][n] * rs;
                            u32x2 w; w.x = cvt_pk_bf16(v[0], v[1]); w.y = cvt_pk_bf16(v[2], v[3]);
                            *(u32x2*)(qxa + (size_t)row * 1024 + cbase + n * 16 + fq * 4) = w;
                        }
                    }
                });
        }
    }
    GRID_SYNC();

    if (PH & (1 << 7)) {
        PHASE_IDS
        const bf16_t* qxa = (const bf16_t*)(ws + O_QXA);
        const bf16_t* km = (const bf16_t*)(ws + O_KM);
        const bf16_t* vmT = (const bf16_t*)(ws + O_VMT);
        bf16_t* oxa = (bf16_t*)(ws + O_OXA);
        for (int item = bid; item < 8 * 4 * 32; item += nb) {
            const int qt = item >> 5 & 31, bh = item & 31;
            const int b = bh >> 2, h = bh & 3;
            const size_t row0 = (size_t)b * 2048 + qt * 64;
            attn_item<256, 256, true, 1>(qxa + row0 * 1024 + h * 256, 1024,
                                km + ((size_t)b * 256) * 1024 + h * 256, 1024,
                                vmT + ((size_t)(b * 4 + h) * 256) * 256, 256, 4, 4,
                                oxa + row0 * 1024 + h * 256, 1024, smem);
        }
    }
    GRID_SYNC();

    if (PH & (1 << 8)) {
        PHASE_IDS
        const bf16_t* oxa = (const bf16_t*)(ws + O_OXA);
        const bf16_t* xaoT = (const bf16_t*)(ws + O_XAOT);
        bf16_t* h2b = (bf16_t*)(ws + O_H2B);
        XCD_TILE_LOOP(64, 8, tm, tn) {
            gemm_tile_big<true>(oxa, 1024, xaoT, 1024, 1024, tm * 256, tn * 128, smem,
                [&](const f32x4 (&acc)[4][4], int rbase, int cbase, int fr, int fq) {
#pragma unroll
                    for (int m = 0; m < 4; ++m) {
                        const int row = rbase + m * 16 + fr;
                        float ss = 0.f;
#pragma unroll
                        for (int n = 0; n < 4; ++n) {
                            const size_t o = (size_t)row * 1024 + cbase + n * 16 + fq * 4;
                            const f32x4 v = *(const f32x4*)(P.out + o) + acc[m][n];
                            ss += v[0] * v[0] + v[1] * v[1] + v[2] * v[2] + v[3] * v[3];
                            *(f32x4*)(P.out + o) = v;
                            u32x2 w; w.x = cvt_pk_bf16(v[0], v[1]); w.y = cvt_pk_bf16(v[2], v[3]);
                            *(u32x2*)(h2b + o) = w;
                        }
                        ss += __shfl_xor(ss, 16); ss += __shfl_xor(ss, 32);
                        if (fq == 0) atomicAdd(&ssq2[row], ss);
                    }
                });
        }
    }
    GRID_SYNC();

    if (PH & (1 << 9)) {
        PHASE_IDS
        const bf16_t* h2b = (const bf16_t*)(ws + O_H2B);
        const bf16_t* pwqT = (const bf16_t*)(ws + O_PWQT);
        bf16_t* pq = (bf16_t*)(ws + O_PQ);
        const bf16_t* keysb = (const bf16_t*)(ws + O_KEYS);
        bf16_t* scores = (bf16_t*)(ws + O_SCORES);
        (void)pq;
        XCD_TILE_LOOP(64, 16, tm, g) { pq_scores_tile(h2b, 1024, pwqT, 1024, 1024, tm * 256, g, ssq2, keysb, scores, smem); }
    }
    GRID_SYNC();

    if (PH & (1 << 11)) {
        PHASE_IDS
        const bf16_t* scores = (const bf16_t*)(ws + O_SCORES);
        const unsigned char* eu8 = (const unsigned char*)(ws + O_EUB);
        const unsigned char* ev8 = (const unsigned char*)(ws + O_EVB);
        const float* esinv = (const float*)(ws + O_SSQ + 6 * 65536);
        char* wsm = smem + wid * 13824;
        int* eidx = (int*)wsm;
        float* egate = (float*)(wsm + 4096);
        float* esu = (float*)(wsm + 8192);
        unsigned char* xs = (unsigned char*)(wsm + 12288);
        float* acts = (float*)(wsm + 13312);
        const int fr = lane & 15, fq = lane >> 4;
        for (int witem = bid * 4 + wid; witem < T / 8; witem += nb * 4) {
            const int t0 = witem * 8;
            {
                const int tt = lane >> 3, h = lane & 7;
                const bf16_t* sp = scores + (size_t)(t0 + tt) * 2048 + h * 256;
                unsigned L1[16], L2[16];
#pragma unroll
                for (int s = 0; s < 16; ++s) { L1[s] = 0u; L2[s] = 0u; }
                for (int i = 0; i < 128; i += 8) {
                    const u32x4 a = *(const u32x4*)(sp + i);
                    const u32x4 b = *(const u32x4*)(sp + 128 + i);
                    const unsigned au[4] = {a.x, a.y, a.z, a.w}, bu[4] = {b.x, b.y, b.z, b.w};
#pragma unroll
                    for (int e = 0; e < 4; ++e) {
                        const unsigned id0 = 127u - (unsigned)(i + 2 * e), id1 = id0 - 1u;
                        TOPK_INSERT(L1, (ordkey(bf_lo(au[e])) & ~127u) | id0);
                        TOPK_INSERT(L1, (ordkey(bf_hi(au[e])) & ~127u) | id1);
                        TOPK_INSERT(L2, (ordkey(bf_lo(bu[e])) & ~127u) | id0);
                        TOPK_INSERT(L2, (ordkey(bf_hi(bu[e])) & ~127u) | id1);
                    }
                }
                float v1[16], v2[16];
                unsigned pa0 = 0u, pa1 = 0u, pa2 = 0u, pa3 = 0u, pb0 = 0u, pb1 = 0u, pb2 = 0u, pb3 = 0u;
#pragma unroll
                for (int s = 0; s < 16; ++s) {
                    v1[s] = unordkey(L1[s] & ~127u); v2[s] = unordkey(L2[s] & ~127u);
                    const unsigned i1_ = (127u - (L1[s] & 127u)) << ((s & 3) * 8), i2_ = (127u - (L2[s] & 127u)) << ((s & 3) * 8);
                    if ((s >> 2) == 0) { pa0 |= i1_; pb0 |= i2_; } else if ((s >> 2) == 1) { pa1 |= i1_; pb1 |= i2_; }
                    else if ((s >> 2) == 2) { pa2 |= i1_; pb2 |= i2_; } else { pa3 |= i1_; pb3 |= i2_; }
                }
                unsigned C[16];
#pragma unroll
                for (int s = 0; s < 16; ++s) C[s] = 0u;
#pragma unroll
                for (int a = 0; a < 16; ++a)
#pragma unroll
                    for (int b = 0; b < 16; ++b)
                        if ((a + 1) * (b + 1) <= 16) { TOPK_INSERT(C, (ordkey(v1[a] + v2[b]) & ~255u) | (255u - (unsigned)(a * 16 + b))); }
                float cv[16], sum = 0.f;
                {
                    const float mxv = unordkey(C[0] & ~255u);
                    sum = 0.f;
#pragma unroll
                    for (int s = 0; s < 16; ++s) { cv[s] = __expf(unordkey(C[s] & ~255u) - mxv); sum += cv[s]; }
                }
                const float isum = 1.0f / sum;
#pragma unroll
                for (int s = 0; s < 16; ++s) {
                    const int ab = 255 - (int)(C[s] & 255u), a = ab >> 4, b = ab & 15;
                    const int e = (int)(byte_lookup(pa0, pa1, pa2, pa3, a) * 128u + byte_lookup(pb0, pb1, pb2, pb3, b));
                    eidx[tt * 128 + h * 16 + s] = e;
                    egate[tt * 128 + h * 16 + s] = cv[s] * isum * esinv[16384 + e];
                    esu[tt * 128 + h * 16 + s] = esinv[e];
                }
            }
            __builtin_amdgcn_wave_barrier();
            for (int tt = 0; tt < 8; ++tt) {
                const int row = t0 + tt;
                const float* hrow = P.out + (size_t)row * 1024 + lane * 16;
                f32x4 hv[4];
#pragma unroll
                for (int i = 0; i < 4; ++i) hv[i] = *(const f32x4*)(hrow + i * 4);
                const float rs2 = rsqrtf(ssq2[row] * (1.0f / 1024.0f) + EPS);
                float sxinv;
                {
                    f32x4 a[4]; float amax = 0.f;
#pragma unroll
                    for (int i = 0; i < 4; ++i) {
                        a[i] = hv[i] * *(const f32x4*)(P.norm_ffn_g + lane * 16 + i * 4) * rs2;
                        amax = fmaxf(amax, fmaxf(fmaxf(fabsf(a[i][0]), fabsf(a[i][1])), fmaxf(fabsf(a[i][2]), fabsf(a[i][3]))));
                    }
#pragma unroll
                    for (int o = 32; o >= 1; o >>= 1) amax = fmaxf(amax, __shfl_xor(amax, o));
                    amax = fmaxf(amax, 1e-30f);
                    const float sc = 240.0f / amax; sxinv = amax * (1.0f / 240.0f);
                    int w[4];
#pragma unroll
                    for (int i = 0; i < 4; ++i) {
                        w[i] = __builtin_amdgcn_cvt_pk_fp8_f32(a[i][0] * sc, a[i][1] * sc, 0, false);
                        w[i] = __builtin_amdgcn_cvt_pk_fp8_f32(a[i][2] * sc, a[i][3] * sc, w[i], true);
                    }
                    *(u32x4*)(xs + lane * 16) = (u32x4){(unsigned)w[0], (unsigned)w[1], (unsigned)w[2], (unsigned)w[3]};
                }
                __builtin_amdgcn_wave_barrier();
                int er[8];
#pragma unroll
                for (int eg = 0; eg < 8; ++eg) er[eg] = eidx[tt * 128 + eg * 16 + fr];
                f32x4 acc[8];
#pragma unroll
                for (int eg = 0; eg < 8; ++eg) acc[eg] = (f32x4){0.f, 0.f, 0.f, 0.f};
#pragma unroll 2
                for (int it = 0; it < 16; ++it) {
                    const i64x2 xq = *(const i64x2*)(xs + it * 64 + fq * 16);
#pragma unroll
                    for (int eg = 0; eg < 8; ++eg) {
                        const i64x2 uq = *(const i64x2*)(eu8 + (size_t)er[eg] * 1024 + it * 64 + fq * 16);
                        acc[eg] = __builtin_amdgcn_mfma_f32_16x16x32_fp8_fp8(uq.x, xq.x, acc[eg], 0, 0, 0);
                        acc[eg] = __builtin_amdgcn_mfma_f32_16x16x32_fp8_fp8(uq.y, xq.y, acc[eg], 0, 0, 0);
                    }
                }
#pragma unroll
                for (int eg = 0; eg < 8; ++eg) {
                    const f32x4 gt = *(const f32x4*)(egate + tt * 128 + eg * 16 + fq * 4);
                    const f32x4 su = *(const f32x4*)(esu + tt * 128 + eg * 16 + fq * 4);
                    f32x4 av;
#pragma unroll
                    for (int j = 0; j < 4; ++j) { const float pre = acc[eg][j] * su[j] * sxinv; av[j] = 0.5f * pre * (1.0f + erff(pre * 0.70710678118654752f)) * gt[j]; }
                    if (fr == 0) *(f32x4*)(acts + eg * 16 + fq * 4) = av;
                }
                __builtin_amdgcn_wave_barrier();
                f32x4 oa[4];
#pragma unroll
                for (int i = 0; i < 4; ++i) oa[i] = (f32x4){0.f, 0.f, 0.f, 0.f};
                for (int j0 = 0; j0 < 128; j0 += 8) {
                    const f32x4 a4 = *(const f32x4*)(acts + j0), a5 = *(const f32x4*)(acts + j0 + 4);
                    const float as[8] = {a4[0], a4[1], a4[2], a4[3], a5[0], a5[1], a5[2], a5[3]};
                    u32x4 vq[8];
#pragma unroll
                    for (int jj = 0; jj < 8; ++jj) vq[jj] = *(const u32x4*)(ev8 + (size_t)eidx[tt * 128 + j0 + jj] * 1024 + lane * 16);
#pragma unroll
                    for (int jj = 0; jj < 8; ++jj) {
                        const float a = as[jj];
                        const unsigned q4[4] = {vq[jj].x, vq[jj].y, vq[jj].z, vq[jj].w};
#pragma unroll
                        for (int i = 0; i < 4; ++i) {
                            const f32x2_t lo = __builtin_amdgcn_cvt_pk_f32_fp8((int)q4[i], false), hi = __builtin_amdgcn_cvt_pk_f32_fp8((int)q4[i], true);
                            oa[i][0] += a * lo[0]; oa[i][1] += a * lo[1]; oa[i][2] += a * hi[0]; oa[i][3] += a * hi[1];
                        }
                    }
                }
                float ss = 0.f;
#pragma unroll
                for (int i = 0; i < 4; ++i) { hv[i] = hv[i] + oa[i]; ss += hv[i][0] * hv[i][0] + hv[i][1] * hv[i][1] + hv[i][2] * hv[i][2] + hv[i][3] * hv[i][3]; }
                ss = wave_sum(ss);
                const float rs3 = rsqrtf(ss * (1.0f / 1024.0f) + EPS);
                float* orow = P.out + (size_t)row * 1024 + lane * 16;
#pragma unroll
                for (int i = 0; i < 4; ++i) *(f32x4*)(orow + i * 4) = hv[i] * rs3 * *(const f32x4*)(P.final_norm_g + lane * 16 + i * 4);
                __builtin_amdgcn_wave_barrier();
            }
        }
    }
#ifdef TIMED_MASK
    {
        xcd_barrier(xb);
        const long long tn_ = (long long)__builtin_amdgcn_s_memrealtime();
        if ((TIMED_MASK >> ph_idx) & 1) t_acc += tn_ - t_last;
        const long long t_end = tn_ + t_acc;
        while ((long long)__builtin_amdgcn_s_memrealtime() < t_end) __builtin_amdgcn_s_sleep(8);
    }
#endif
    if (PH & (1 << 12)) {
        PHASE_IDS
        GRID_SYNC();
        const float* src = (PH & (1 << 5)) ? (const float*)P.out : P.x;
        for (int r = bid * 4 + wid; r < T; r += nb * 4) {
            const float* srow = src + (size_t)r * 1024;
            f32x4 v[4]; float ss = 0.f;
#pragma unroll
            for (int i = 0; i < 4; ++i) { v[i] = *(const f32x4*)(srow + i * 256 + lane * 4); ss += v[i][0] * v[i][0] + v[i][1] * v[i][1] + v[i][2] * v[i][2] + v[i][3] * v[i][3]; }
            ss = wave_sum(ss);
            const float rs = rsqrtf(ss * (1.0f / 1024.0f) + EPS);
#pragma unroll
            for (int i = 0; i < 4; ++i) *(f32x4*)(P.out + (size_t)r * 1024 + i * 256 + lane * 4) = v[i] * rs * *(const f32x4*)(P.final_norm_g + i * 256 + lane * 4);
        }
    }
}

extern "C" void kernel_launch(void* const* d_in, const int* in_sizes, int n_in, void* d_out, int out_size, void* d_ws, size_t ws_size,
                              hipStream_t stream) {
    (void)in_sizes; (void)n_in; (void)out_size;
    if (ws_size < WS_NEED) { fprintf(stderr, "workspace too small: %zu\n", ws_size); return; }
    static int grid_blocks = 0;
    if (!grid_blocks) {
        int dev = 0, cus = 0, per_cu = 0;
        hipGetDevice(&dev);
        hipDeviceGetAttribute(&cus, hipDeviceAttributeMultiprocessorCount, dev);
        hipOccupancyMaxActiveBlocksPerMultiprocessor(&per_cu, fwd_megakernel, 256, 0);
        if (per_cu > 2) per_cu = 2;
        grid_blocks = cus * per_cu;
    }
    Params p{};
    const float** fp = (const float**)&p;
    (void)fp;
    p.x = (const float*)d_in[0]; p.mem = (const float*)d_in[1]; p.pos = (const int*)d_in[2];
    p.norm_mix_g = (const float*)d_in[3]; p.w_in = (const float*)d_in[4]; p.shift_mu = (const float*)d_in[5];
    p.q_norm_g = (const float*)d_in[6]; p.kv_norm_g = (const float*)d_in[7]; p.w_uq = (const float*)d_in[8]; p.w_ukv = (const float*)d_in[9];
    p.rw_w0 = (const float*)d_in[10]; p.rw_w_up = (const float*)d_in[11]; p.rw_a0 = (const float*)d_in[12]; p.rw_a_up = (const float*)d_in[13];
    p.rw_g_up = (const float*)d_in[14]; p.rw_k_k = (const float*)d_in[15]; p.rw_k_a = (const float*)d_in[16]; p.rw_r_k = (const float*)d_in[17];
    p.rw_lnx_w = (const float*)d_in[18]; p.rw_lnx_b = (const float*)d_in[19]; p.w_out = (const float*)d_in[20];
    p.norm_xa_g = (const float*)d_in[21]; p.norm_mem_g = (const float*)d_in[22]; p.xa_wq = (const float*)d_in[23]; p.xa_wk = (const float*)d_in[24];
    p.xa_wv = (const float*)d_in[25]; p.xa_wo = (const float*)d_in[26]; p.norm_ffn_g = (const float*)d_in[27]; p.peer_wq = (const float*)d_in[28];
    p.peer_keys = (const float*)d_in[29]; p.expert_u = (const float*)d_in[30]; p.expert_v = (const float*)d_in[31]; p.final_norm_g = (const float*)d_in[32];
    p.out = (float*)d_out; p.ws = (char*)d_ws;
    hipMemsetAsync((char*)d_ws + O_XBAR, 0, XCD_BAR_WORDS_BYTES, stream);
    void* args[] = {&p};
    hipError_t e = hipLaunchCooperativeKernel((void*)fwd_megakernel, dim3(grid_blocks), dim3(256), args, 0, stream);
    if (e != hipSuccess) fprintf(stderr, "cooperative launch failed: %s (grid %d)\n", hipGetErrorString(e), grid_blocks);
}
```

```cpp
#include <hip/hip_runtime.h>
#include <hip/hip_cooperative_groups.h>
#include <cstdio>
namespace cg = cooperative_groups;

typedef unsigned short bf16_t;
typedef short bf16x8 __attribute__((ext_vector_type(8)));
typedef float f32x4 __attribute__((ext_vector_type(4)));
typedef unsigned u32x4 __attribute__((ext_vector_type(4)));
typedef unsigned u32x2 __attribute__((ext_vector_type(2)));
typedef long i64x2 __attribute__((ext_vector_type(2)));

#define DEV __device__ __forceinline__

constexpr int T = 16384;
constexpr float EPS = 1e-6f;
constexpr size_t MB = 1u << 20;
constexpr size_t XCD_BAR_WORDS_BYTES = 3456 * 4;

constexpr size_t O_WINT  = 0;
constexpr size_t O_WUQT  = O_WINT  + (size_t)2304 * 1024 * 2;
constexpr size_t O_WUKT  = O_WUQT  + (size_t)768 * 256 * 2;
constexpr size_t O_WUVT  = O_WUKT  + (size_t)512 * 128 * 2;
constexpr size_t O_WUPT  = O_WUVT  + (size_t)512 * 128 * 2;
constexpr size_t O_AUPT  = O_WUPT  + (size_t)512 * 64 * 2;
constexpr size_t O_GUPT  = O_AUPT  + (size_t)512 * 64 * 2;
constexpr size_t O_WOUTT = O_GUPT  + (size_t)512 * 128 * 2;
constexpr size_t O_XAQT  = O_WOUTT + (size_t)1024 * 1024 * 2;
constexpr size_t O_XAKVT = O_XAQT  + (size_t)1024 * 1024 * 2;
constexpr size_t O_XAOT  = O_XAKVT + (size_t)2048 * 1024 * 2;
constexpr size_t O_PWQT  = O_XAOT  + (size_t)1024 * 1024 * 2;
constexpr size_t O_KEYS  = O_PWQT  + (size_t)2048 * 1024 * 2;
constexpr size_t O_SSQ   = O_KEYS  + (size_t)16 * 128 * 128 * 2;
constexpr size_t O_CNT   = O_SSQ   + (size_t)8 * 65536;
constexpr size_t O_ROPE  = O_CNT   + 4096;
constexpr size_t O_KM    = O_ROPE  + (size_t)T * 32 * 8;
constexpr size_t O_VMT   = O_KM    + (size_t)2048 * 1024 * 2;
constexpr size_t O_MEMB  = O_VMT   + (size_t)2048 * 1024 * 2;
constexpr size_t O_PERSIST_END = O_MEMB + (size_t)2048 * 1024 * 2;
constexpr size_t O_XBAR = O_PERSIST_END;
static_assert(O_XBAR + XCD_BAR_WORDS_BYTES <= 40 * MB, "persistent region too large");
constexpr size_t O_P     = 40 * MB;
constexpr size_t O_YRAW  = 40 * MB;
constexpr size_t O_MIX   = 72 * MB;
constexpr size_t O_OXA   = 144 * MB;
constexpr size_t O_H2B   = 72 * MB;
constexpr size_t O_SCORES= 144 * MB;
constexpr size_t O_SCORES_OLD_UNUSED = 40 * MB;
constexpr size_t O_XB    = 112 * MB;
constexpr size_t O_G     = 112 * MB;
constexpr size_t O_QXA   = 72 * MB;
constexpr size_t O_RW_R  = 144 * MB;
constexpr size_t O_RW_K  = 160 * MB;
constexpr size_t O_RW_V  = 176 * MB;
constexpr size_t O_RW_KK = 192 * MB;
constexpr size_t O_RW_KA = 208 * MB;
constexpr size_t O_DECAY = 224 * MB;
constexpr size_t O_H1B   = 144 * MB;
constexpr size_t O_EUB   = 128 * MB;
constexpr size_t O_EUB_OLD = 176 * MB;
constexpr size_t O_EVB   = 56 * MB;
constexpr size_t O_EVB_OLD = 208 * MB;
constexpr size_t O_PQ    = 104 * MB;
constexpr size_t WS_NEED = 256 * MB;

struct Params {
    const float *x, *mem; const int* pos;
    const float *norm_mix_g, *w_in, *shift_mu, *q_norm_g, *kv_norm_g, *w_uq, *w_ukv;
    const float *rw_w0, *rw_w_up, *rw_a0, *rw_a_up, *rw_g_up, *rw_k_k, *rw_k_a, *rw_r_k, *rw_lnx_w, *rw_lnx_b;
    const float *w_out, *norm_xa_g, *norm_mem_g, *xa_wq, *xa_wk, *xa_wv, *xa_wo;
    const float *norm_ffn_g, *peer_wq, *peer_keys, *expert_u, *expert_v, *final_norm_g;
    float* out; char* ws;
};

typedef __bf16 bf16x2_t __attribute__((ext_vector_type(2)));
typedef float f32x2_t __attribute__((ext_vector_type(2)));
DEV unsigned cvt_pk_bf16(float lo, float hi) { const f32x2_t f = {lo, hi}; const bf16x2_t b = __builtin_convertvector(f, bf16x2_t); unsigned r; __builtin_memcpy(&r, &b, 4); return r; }
DEV float bf_lo(unsigned u) { return __uint_as_float(u << 16); }
DEV float bf_hi(unsigned u) { return __uint_as_float(u & 0xffff0000u); }
DEV f32x4 mfma16(bf16x8 a, bf16x8 b, f32x4 c) { return __builtin_amdgcn_mfma_f32_16x16x32_bf16(a, b, c, 0, 0, 0); }
DEV float sigmoidf_(float v) { return 1.0f / (1.0f + __expf(-v)); }
DEV float wave_sum(float v) {
#pragma unroll
    for (int o = 32; o >= 1; o >>= 1) v += __shfl_xor(v, o);
    return v;
}
DEV float allreduce8(float x) {
    x += __int_as_float(__builtin_amdgcn_update_dpp(0, __float_as_int(x), 0xB1, 0xF, 0xF, true));
    x += __int_as_float(__builtin_amdgcn_update_dpp(0, __float_as_int(x), 0x4E, 0xF, 0xF, true));
    x += __int_as_float(__builtin_amdgcn_update_dpp(0, __float_as_int(x), 0x141, 0xF, 0xF, true));
    return x;
}
DEV float opq(float x) { asm("" : "+v"(x)); return x; }
DEV void lds_barrier() { asm volatile("s_waitcnt lgkmcnt(0)\n\ts_barrier" ::: "memory"); }
DEV float allreduce16(float x) {
    x += __int_as_float(__builtin_amdgcn_update_dpp(0, __float_as_int(x), 0xB1, 0xF, 0xF, true));
    x += __int_as_float(__builtin_amdgcn_update_dpp(0, __float_as_int(x), 0x4E, 0xF, 0xF, true));
    x += __int_as_float(__builtin_amdgcn_update_dpp(0, __float_as_int(x), 0x141, 0xF, 0xF, true));
    x += __int_as_float(__builtin_amdgcn_update_dpp(0, __float_as_int(x), 0x140, 0xF, 0xF, true));
    return x;
}
DEV void allreduce16_pair(float& a, float& b) {
    a += __int_as_float(__builtin_amdgcn_update_dpp(0, __float_as_int(a), 0xB1, 0xF, 0xF, true));
    b += __int_as_float(__builtin_amdgcn_update_dpp(0, __float_as_int(b), 0xB1, 0xF, 0xF, true));
    a += __int_as_float(__builtin_amdgcn_update_dpp(0, __float_as_int(a), 0x4E, 0xF, 0xF, true));
    b += __int_as_float(__builtin_amdgcn_update_dpp(0, __float_as_int(b), 0x4E, 0xF, 0xF, true));
    a += __int_as_float(__builtin_amdgcn_update_dpp(0, __float_as_int(a), 0x141, 0xF, 0xF, true));
    b += __int_as_float(__builtin_amdgcn_update_dpp(0, __float_as_int(b), 0x141, 0xF, 0xF, true));
    a += __int_as_float(__builtin_amdgcn_update_dpp(0, __float_as_int(a), 0x140, 0xF, 0xF, true));
    b += __int_as_float(__builtin_amdgcn_update_dpp(0, __float_as_int(b), 0x140, 0xF, 0xF, true));
}
DEV bf16x8 as_bf16x8(u32x4 v) { bf16x8 r; __builtin_memcpy(&r, &v, 16); return r; }

template <bool SWAP, class AL, class EP>
DEV void gemm_tile(AL aload, const bf16_t* __restrict__ Bt, int ldb, int K, int row0, int col0, char* smem, EP epi) {
    int tid = threadIdx.x; asm volatile("" : "+v"(tid));
    const int wid = __builtin_amdgcn_readfirstlane(tid >> 6), lane = tid & 63, wr = wid >> 1, wc = wid & 1, fr = lane & 15, fq = lane >> 4;
    constexpr int RS = 144;
    constexpr int TB = 128 * RS;
    char* sA = smem; char* sB = smem + 2 * TB;
    f32x4 acc[4][4];
#pragma unroll
    for (int m = 0; m < 4; ++m)
#pragma unroll
        for (int n = 0; n < 4; ++n) acc[m][n] = (f32x4){0.f, 0.f, 0.f, 0.f};
    const int lr = tid >> 3, lk = (tid & 7) * 8;
    const bf16_t* bp = Bt + (size_t)(col0 + lr) * ldb + lk;
    const int lo = lr * RS + (tid & 7) * 16;
    u32x4 ra[4], rb[4];
#pragma unroll
    for (int i = 0; i < 4; ++i) { ra[i] = aload(row0 + lr + 32 * i, lk); rb[i] = *(const u32x4*)(bp + (size_t)(32 * i) * ldb); }
#pragma unroll
    for (int i = 0; i < 4; ++i) { *(u32x4*)(sA + lo + i * 32 * RS) = ra[i]; *(u32x4*)(sB + lo + i * 32 * RS) = rb[i]; }
    __syncthreads();
    const int nt = K >> 6;
    for (int t = 0; t < nt; ++t) {
        const bool more = (t + 1 < nt);
        if (more) {
            const int kb = (t + 1) << 6;
#pragma unroll
            for (int i = 0; i < 4; ++i) { ra[i] = aload(row0 + lr + 32 * i, kb + lk); rb[i] = *(const u32x4*)(bp + (size_t)(32 * i) * ldb + kb); }
        }
        const char* a = sA + (t & 1) * TB; const char* b = sB + (t & 1) * TB;
#pragma unroll
        for (int kh = 0; kh < 2; ++kh) {
            bf16x8 af[4], bfr[4];
#pragma unroll
            for (int m = 0; m < 4; ++m) af[m] = *(const bf16x8*)(a + (wr * 64 + m * 16 + fr) * RS + kh * 64 + fq * 16);
#pragma unroll
            for (int n = 0; n < 4; ++n) bfr[n] = *(const bf16x8*)(b + (wc * 64 + n * 16 + fr) * RS + kh * 64 + fq * 16);
#pragma unroll
            for (int m = 0; m < 4; ++m)
#pragma unroll
                for (int n = 0; n < 4; ++n)
                    acc[m][n] = SWAP ? mfma16(bfr[n], af[m], acc[m][n]) : mfma16(af[m], bfr[n], acc[m][n]);
        }
        if (more) {
            const int o = ((t + 1) & 1) * TB;
#pragma unroll
            for (int i = 0; i < 4; ++i) { *(u32x4*)(sA + o + lo + i * 32 * RS) = ra[i]; *(u32x4*)(sB + o + lo + i * 32 * RS) = rb[i]; }
        }
        __syncthreads();
    }
    int rb_ = row0 + wr * 64, cb_ = col0 + wc * 64;
    asm volatile("" : "+s"(rb_), "+s"(cb_));
    epi(acc, rb_, cb_, fr, fq);
}

#define GLDS16(gp, lp) __builtin_amdgcn_global_load_lds((const unsigned*)(gp), (__attribute__((address_space(3))) unsigned*)(lp), 16, 0, 0)
template <bool SWAP, class EP>
DEV void gemm_tile_glds(const bf16_t* __restrict__ A, int lda, const bf16_t* __restrict__ Bt, int ldb, int K, int row0, int col0, char* smem, EP epi) {
    int tid = threadIdx.x; asm volatile("" : "+v"(tid));
    const int wid = __builtin_amdgcn_readfirstlane(tid >> 6), lane = tid & 63, wr = wid >> 1, wc = wid & 1, fr = lane & 15, fq = lane >> 4;
    constexpr int ST = 16384;
    f32x4 acc[4][4];
#pragma unroll
    for (int m = 0; m < 4; ++m)
#pragma unroll
        for (int n = 0; n < 4; ++n) acc[m][n] = (f32x4){0.f, 0.f, 0.f, 0.f};
    const int b0 = tid * 16, r0 = b0 >> 6, c0 = (b0 & 63) >> 1;
    const bf16_t* ap0 = A + (size_t)(row0 + r0) * lda + c0;
    const bf16_t* ap1 = ap0 + (size_t)64 * lda;
    const bf16_t* bp0 = Bt + (size_t)(col0 + r0) * ldb + c0;
    const bf16_t* bp1 = bp0 + (size_t)64 * ldb;
    auto issue = [&](int kt) {
        char* st = smem + (kt & 3) * ST + b0;
        GLDS16(ap0 + kt * 32, st); GLDS16(ap1 + kt * 32, st + 4096);
        GLDS16(bp0 + kt * 32, st + 8192); GLDS16(bp1 + kt * 32, st + 8192 + 4096);
    };
    const int nt = K >> 5;
    asm volatile("s_waitcnt vmcnt(0) lgkmcnt(0)\n\ts_barrier" ::: "memory");
    issue(0);
    if (nt > 1) issue(1);
    if (nt > 2) issue(2);
    for (int t = 0; t < nt; ++t) {
        if (t + 2 < nt) asm volatile("s_waitcnt vmcnt(8)" ::: "memory");
        else if (t + 1 < nt) asm volatile("s_waitcnt vmcnt(4)" ::: "memory");
        else asm volatile("s_waitcnt vmcnt(0)" ::: "memory");
        asm volatile("s_barrier" ::: "memory");
        if (t + 3 < nt) issue(t + 3);
        const char* a = smem + (t & 3) * ST; const char* b = a + 8192;
        bf16x8 af[4], bfr[4];
#pragma unroll
        for (int m = 0; m < 4; ++m) af[m] = *(const bf16x8*)(a + (wr * 64 + m * 16 + fr) * 64 + fq * 16);
#pragma unroll
        for (int n = 0; n < 4; ++n) bfr[n] = *(const bf16x8*)(b + (wc * 64 + n * 16 + fr) * 64 + fq * 16);
#pragma unroll
        for (int m = 0; m < 4; ++m)
#pragma unroll
            for (int n = 0; n < 4; ++n)
                acc[m][n] = SWAP ? mfma16(bfr[n], af[m], acc[m][n]) : mfma16(af[m], bfr[n], acc[m][n]);
    }
    int rb_ = row0 + wr * 64, cb_ = col0 + wc * 64;
    asm volatile("" : "+s"(rb_), "+s"(cb_));
    epi(acc, rb_, cb_, fr, fq);
}

template <bool SWAP, class EP>
DEV void gemm_tile_big(const bf16_t* __restrict__ A, int lda, const bf16_t* __restrict__ Bt, int ldb, int K, int row0, int col0, char* smem, EP epi) {
    int tid = threadIdx.x; asm volatile("" : "+v"(tid));
    const int wid = __builtin_amdgcn_readfirstlane(tid >> 6), lane = tid & 63, wr = wid >> 1, wc = wid & 1, fr = lane & 15, fq = lane >> 4;
    constexpr int ST = 24576;
    f32x4 acc[2][4][4];
#pragma unroll
    for (int h = 0; h < 2; ++h)
#pragma unroll
        for (int m = 0; m < 4; ++m)
#pragma unroll
            for (int n = 0; n < 4; ++n) acc[h][m][n] = (f32x4){0.f, 0.f, 0.f, 0.f};
    const int b0 = tid * 16, r0 = b0 >> 6, c0 = (b0 & 63) >> 1;
    const bf16_t* ap = A + (size_t)(row0 + r0) * lda + c0;
    const bf16_t* bp = Bt + (size_t)(col0 + r0) * ldb + c0;
    const size_t a64 = (size_t)64 * lda, b64 = (size_t)64 * ldb;
    auto issue = [&](int kt) {
        char* st = smem + (kt % 3) * ST + b0;
        GLDS16(ap + kt * 32, st); GLDS16(ap + a64 + kt * 32, st + 4096);
        GLDS16(ap + 2 * a64 + kt * 32, st + 8192); GLDS16(ap + 3 * a64 + kt * 32, st + 12288);
        GLDS16(bp + kt * 32, st + 16384); GLDS16(bp + b64 + kt * 32, st + 16384 + 4096);
    };
    const int nt = K >> 5;
    asm volatile("s_waitcnt vmcnt(0) lgkmcnt(0)\n\ts_barrier" ::: "memory");
    issue(0);
    if (nt > 1) issue(1);
    for (int t = 0; t < nt; ++t) {
        if (t + 1 < nt) asm volatile("s_waitcnt vmcnt(6)" ::: "memory");
        else asm volatile("s_waitcnt vmcnt(0)" ::: "memory");
        asm volatile("s_barrier" ::: "memory");
        if (t + 2 < nt) issue(t + 2);
        const char* a = smem + (t % 3) * ST; const char* b = a + 16384;
        bf16x8 bfr[4], af[2][4];
#pragma unroll
        for (int n = 0; n < 4; ++n) bfr[n] = *(const bf16x8*)(b + (wc * 64 + n * 16 + fr) * 64 + fq * 16);
#pragma unroll
        for (int h = 0; h < 2; ++h)
#pragma unroll
            for (int m = 0; m < 4; ++m) af[h][m] = *(const bf16x8*)(a + (wr * 128 + h * 64 + m * 16 + fr) * 64 + fq * 16);
#pragma unroll
        for (int h = 0; h < 2; ++h)
#pragma unroll
            for (int m = 0; m < 4; ++m)
#pragma unroll
                for (int n = 0; n < 4; ++n)
                    acc[h][m][n] = SWAP ? mfma16(bfr[n], af[h][m], acc[h][m][n]) : mfma16(af[h][m], bfr[n], acc[h][m][n]);
        __builtin_amdgcn_iglp_opt(0);
    }
    int rb_ = row0 + wr * 128, cb_ = col0 + wc * 64;
    asm volatile("" : "+s"(rb_), "+s"(cb_));
    epi(acc[0], rb_, cb_, fr, fq);
    epi(acc[1], rb_ + 64, cb_, fr, fq);
}

DEV void pq_scores_tile(const bf16_t* __restrict__ A, int lda, const bf16_t* __restrict__ Bt, int ldb, int K, int row0, int g,
                        const float* __restrict__ ssq2, const bf16_t* __restrict__ keysb, bf16_t* __restrict__ scores, char* smem) {
    int tid = threadIdx.x; asm volatile("" : "+v"(tid));
    const int wid = __builtin_amdgcn_readfirstlane(tid >> 6), lane = tid & 63, wr = wid >> 1, wc = wid & 1, fr = lane & 15, fq = lane >> 4;
    constexpr int ST = 24576;
    const int col0 = g * 128;
    f32x4 acc[2][4][4];
#pragma unroll
    for (int h = 0; h < 2; ++h)
#pragma unroll
        for (int m = 0; m < 4; ++m)
#pragma unroll
            for (int n = 0; n < 4; ++n) acc[h][m][n] = (f32x4){0.f, 0.f, 0.f, 0.f};
    const int b0 = tid * 16, r0 = b0 >> 6, c0 = (b0 & 63) >> 1;
    const bf16_t* ap = A + (size_t)(row0 + r0) * lda + c0;
    const bf16_t* bp = Bt + (size_t)(col0 + r0) * ldb + c0;
    const size_t a64 = (size_t)64 * lda, b64 = (size_t)64 * ldb;
    auto issue = [&](int kt) {
        char* st = smem + (kt % 3) * ST + b0;
        GLDS16(ap + kt * 32, st); GLDS16(ap + a64 + kt * 32, st + 4096);
        GLDS16(ap + 2 * a64 + kt * 32, st + 8192); GLDS16(ap + 3 * a64 + kt * 32, st + 12288);
        GLDS16(bp + kt * 32, st + 16384); GLDS16(bp + b64 + kt * 32, st + 16384 + 4096);
    };
    const int nt = K >> 5;
    asm volatile("s_waitcnt vmcnt(0) lgkmcnt(0)\n\ts_barrier" ::: "memory");
    issue(0);
    if (nt > 1) issue(1);
    for (int t = 0; t < nt; ++t) {
        if (t + 1 < nt) asm volatile("s_waitcnt vmcnt(6)" ::: "memory");
        else asm volatile("s_waitcnt vmcnt(0)" ::: "memory");
        asm volatile("s_barrier" ::: "memory");
        if (t + 2 < nt) issue(t + 2);
        const char* a = smem + (t % 3) * ST; const char* b = a + 16384;
        bf16x8 bfr[4];
#pragma unroll
        for (int n = 0; n < 4; ++n) bfr[n] = *(const bf16x8*)(b + (wc * 64 + n * 16 + fr) * 64 + fq * 16);
#pragma unroll
        for (int h = 0; h < 2; ++h) {
            bf16x8 af[4];
#pragma unroll
            for (int m = 0; m < 4; ++m) af[m] = *(const bf16x8*)(a + (wr * 128 + h * 64 + m * 16 + fr) * 64 + fq * 16);
#pragma unroll
            for (int m = 0; m < 4; ++m)
#pragma unroll
                for (int n = 0; n < 4; ++n) acc[h][m][n] = mfma16(bfr[n], af[m], acc[h][m][n]);
        }
    }
    u32x2 pk[2][4][4];
#pragma unroll
    for (int h = 0; h < 2; ++h)
#pragma unroll
        for (int m = 0; m < 4; ++m) {
            const int row = row0 + wr * 128 + h * 64 + m * 16 + fr;
            const float rs = rsqrtf(ssq2[row] * (1.0f / 1024.0f) + EPS);
#pragma unroll
            for (int n = 0; n < 4; ++n) {
                const f32x4 v = acc[h][m][n] * rs;
                pk[h][m][n].x = cvt_pk_bf16(v[0], v[1]); pk[h][m][n].y = cvt_pk_bf16(v[2], v[3]);
            }
        }
    constexpr int RS2 = 272;
    char* sA2 = smem; char* sKy = smem + 128 * RS2;
    asm volatile("s_waitcnt lgkmcnt(0)\n\ts_barrier" ::: "memory");
    {
        const bf16_t* kg = keysb + (size_t)g * 128 * 128;
#pragma unroll
        for (int i = 0; i < 8; ++i) { const int c = tid + i * 256, key = c >> 4, cc = c & 15; *(u32x4*)(sKy + key * RS2 + cc * 16) = *(const u32x4*)(kg + (size_t)key * 128 + cc * 8); }
    }
#pragma unroll 1
    for (int half = 0; half < 2; ++half) {
        if (wr == half) {
#pragma unroll
            for (int h = 0; h < 2; ++h)
#pragma unroll
                for (int m = 0; m < 4; ++m)
#pragma unroll
                    for (int n = 0; n < 4; ++n)
                        *(u32x2*)(sA2 + (h * 64 + m * 16 + fr) * RS2 + (wc * 64 + n * 16 + fq * 4) * 2) = pk[h][m][n];
        }
        __syncthreads();
        f32x4 acc2[4][4];
#pragma unroll
        for (int m = 0; m < 4; ++m)
#pragma unroll
            for (int n = 0; n < 4; ++n) acc2[m][n] = (f32x4){0.f, 0.f, 0.f, 0.f};
#pragma unroll
        for (int ks = 0; ks < 4; ++ks) {
            bf16x8 af[4], bfr[4];
#pragma unroll
            for (int m = 0; m < 4; ++m) af[m] = *(const bf16x8*)(sA2 + (wr * 64 + m * 16 + fr) * RS2 + ks * 64 + fq * 16);
#pragma unroll
            for (int n = 0; n < 4; ++n) bfr[n] = *(const bf16x8*)(sKy + (wc * 64 + n * 16 + fr) * RS2 + ks * 64 + fq * 16);
#pragma unroll
            for (int m = 0; m < 4; ++m)
#pragma unroll
                for (int n = 0; n < 4; ++n) acc2[m][n] = mfma16(bfr[n], af[m], acc2[m][n]);
        }
#pragma unroll
        for (int m = 0; m < 4; ++m) {
            const int row = row0 + half * 128 + wr * 64 + m * 16 + fr;
#pragma unroll
            for (int n = 0; n < 4; ++n) {
                const f32x4 v = acc2[m][n];
                u32x2 w; w.x = cvt_pk_bf16(v[0], v[1]); w.y = cvt_pk_bf16(v[2], v[3]);
                *(u32x2*)(scores + (size_t)row * 2048 + col0 + wc * 64 + n * 16 + fq * 4) = w;
            }
        }
        __syncthreads();
    }
}

struct PlainA {
    const bf16_t* A; int lda;
    DEV u32x4 operator()(int row, int k) const { return *(const u32x4*)(A + (size_t)row * lda + k); }
};

DEV void tr_tile(const float* __restrict__ src, int ldn, bf16_t* __restrict__ dst, int ldk, int k0, int n0, int drow0,
                 const float* __restrict__ gain, float* tileS) {
    int tid = threadIdx.x; asm volatile("" : "+v"(tid));
    __syncthreads();
#pragma unroll 4
    for (int i = 0; i < 16; ++i) {
        const int kk = i * 4 + (tid >> 6), nn = tid & 63;
        float v = src[(size_t)(k0 + kk) * ldn + n0 + nn];
        if (gain) v *= gain[k0 + kk];
        tileS[kk * 65 + nn] = v;
    }
    __syncthreads();
#pragma unroll 4
    for (int i = 0; i < 16; ++i) {
        const int nn = i * 4 + (tid >> 6), kk = tid & 63;
        const float v = tileS[kk * 65 + nn];
        dst[(size_t)(drow0 + nn) * ldk + k0 + kk] = (bf16_t)(cvt_pk_bf16(v, 0.f) & 0xffffu);
    }
}

template <int DQK, int DV, bool PREF, int QB>
DEV void attn_item(const bf16_t* __restrict__ q, int ldq, const bf16_t* __restrict__ k, int ldk,
                   const bf16_t* __restrict__ vT, int ldv, int ntiles, int tiles_lo, bf16_t* __restrict__ out, int ldo, char* smem) {
    constexpr int KS = DQK / 32, DB = DV / 16;
    constexpr int KSTR = DQK * 2 + 16;
    constexpr int VSTR = 144;
    constexpr int KCH = 64 * DQK / 8 / 256, VCH = DV * 64 / 8 / 256, KCW = DQK / 8;
    char* sK = smem; char* sV = smem + 64 * KSTR;
    int tid = threadIdx.x; asm volatile("" : "+v"(tid));
    const int wid = __builtin_amdgcn_readfirstlane(tid >> 6), lane = tid & 63, fr = lane & 15, fq = lane >> 4;
    const int my_tiles = (wid < 2) ? tiles_lo : ntiles;
    bf16x8 qf[QB][KS];
#pragma unroll
    for (int qi = 0; qi < QB; ++qi) {
        const bf16_t* qrow = q + (size_t)(wid * 16 * QB + qi * 16 + fr) * ldq;
#pragma unroll
        for (int ks = 0; ks < KS; ++ks) qf[qi][ks] = *(const bf16x8*)(qrow + ks * 32 + fq * 8);
    }
    f32x4 o[QB][DB];
    float mrow[QB], lsum[QB];
#pragma unroll
    for (int qi = 0; qi < QB; ++qi) {
        mrow[qi] = -1e30f; lsum[qi] = 0.f;
#pragma unroll
        for (int db = 0; db < DB; ++db) o[qi][db] = (f32x4){0.f, 0.f, 0.f, 0.f};
    }
    constexpr bool PREFV = PREF && (DV <= 128);
    u32x4 kr[PREF ? KCH : 1], vr[PREFV ? VCH : 1];
    if (PREF) {
#pragma unroll
        for (int i = 0; i < KCH; ++i) { const int c = tid + i * 256, key = c / KCW, cc = c % KCW; kr[PREF ? i : 0] = *(const u32x4*)(k + (size_t)key * ldk + cc * 8); }
        if (PREFV) {
#pragma unroll
            for (int i = 0; i < VCH; ++i) { const int c = tid + i * 256, d = c >> 3, cc = c & 7; vr[PREFV ? i : 0] = *(const u32x4*)(vT + (size_t)d * ldv + cc * 8); }
        }
    }
    for (int kt = 0; kt < ntiles; ++kt) {
        __syncthreads();
        {
            const int kn = kt * 64;
            if (PREF) {
#pragma unroll
                for (int i = 0; i < KCH; ++i) { const int c = tid + i * 256, key = c / KCW, cc = c % KCW; *(u32x4*)(sK + key * KSTR + cc * 16) = kr[PREF ? i : 0]; }
            } else {
#pragma unroll 4
                for (int i = 0; i < KCH; ++i) { const int c = tid + i * 256, key = c / KCW, cc = c % KCW; *(u32x4*)(sK + key * KSTR + cc * 16) = *(const u32x4*)(k + (size_t)(kn + key) * ldk + cc * 8); }
            }
            if (PREFV) {
#pragma unroll
                for (int i = 0; i < VCH; ++i) { const int c = tid + i * 256, d = c >> 3, cc = c & 7; *(u32x4*)(sV + d * VSTR + cc * 16) = vr[PREFV ? i : 0]; }
            } else {
#pragma unroll 4
                for (int i = 0; i < VCH; ++i) { const int c = tid + i * 256, d = c >> 3, cc = c & 7; *(u32x4*)(sV + d * VSTR + cc * 16) = *(const u32x4*)(vT + (size_t)d * ldv + kn + cc * 8); }
            }
        }
        __syncthreads();
        if (PREF && kt + 1 < ntiles) {
            const int kn = (kt + 1) * 64;
#pragma unroll
            for (int i = 0; i < KCH; ++i) { const int c = tid + i * 256, key = c / KCW, cc = c % KCW; kr[PREF ? i : 0] = *(const u32x4*)(k + (size_t)(kn + key) * ldk + cc * 8); }
            if (PREFV) {
#pragma unroll
                for (int i = 0; i < VCH; ++i) { const int c = tid + i * 256, d = c >> 3, cc = c & 7; vr[PREFV ? i : 0] = *(const u32x4*)(vT + (size_t)d * ldv + kn + cc * 8); }
            }
        }
        if (kt < my_tiles) {
            f32x4 s[QB][4];
#pragma unroll
            for (int kb = 0; kb < 4; ++kb) {
#pragma unroll
                for (int qi = 0; qi < QB; ++qi) s[qi][kb] = (f32x4){0.f, 0.f, 0.f, 0.f};
#pragma unroll
                for (int ks = 0; ks < KS; ++ks) {
                    const bf16x8 kf = *(const bf16x8*)(sK + (kb * 16 + fr) * KSTR + ks * 64 + fq * 16);
#pragma unroll
                    for (int qi = 0; qi < QB; ++qi) s[qi][kb] = mfma16(kf, qf[qi][ks], s[qi][kb]);
                }
            }
            bf16x8 pf[QB][2];
#pragma unroll
            for (int qi = 0; qi < QB; ++qi) {
                float mx = -1e30f;
#pragma unroll
                for (int kb = 0; kb < 4; ++kb)
#pragma unroll
                    for (int j = 0; j < 4; ++j) mx = fmaxf(mx, s[qi][kb][j]);
                mx = fmaxf(mx, __shfl_xor(mx, 16)); mx = fmaxf(mx, __shfl_xor(mx, 32));
                const float mnew = fmaxf(mrow[qi], mx);
                const float alpha = __builtin_amdgcn_exp2f(mrow[qi] - mnew);
                mrow[qi] = mnew;
                float ps = 0.f;
#pragma unroll
                for (int kb = 0; kb < 4; ++kb)
#pragma unroll
                    for (int j = 0; j < 4; ++j) { const float e = __builtin_amdgcn_exp2f(s[qi][kb][j] - mnew); s[qi][kb][j] = e; ps += e; }
                lsum[qi] = lsum[qi] * alpha + ps;
#pragma unroll
                for (int db = 0; db < DB; ++db) o[qi][db] *= alpha;
#pragma unroll
                for (int g = 0; g < 2; ++g) {
                    u32x4 w;
                    w.x = cvt_pk_bf16(s[qi][2 * g][0], s[qi][2 * g][1]); w.y = cvt_pk_bf16(s[qi][2 * g][2], s[qi][2 * g][3]);
                    w.z = cvt_pk_bf16(s[qi][2 * g + 1][0], s[qi][2 * g + 1][1]); w.w = cvt_pk_bf16(s[qi][2 * g + 1][2], s[qi][2 * g + 1][3]);
                    pf[qi][g] = as_bf16x8(w);
                }
            }
#pragma unroll
            for (int db = 0; db < DB; ++db) {
#pragma unroll
                for (int g = 0; g < 2; ++g) {
                    const u32x2 v0 = *(const u32x2*)(sV + (db * 16 + fr) * VSTR + ((2 * g) * 16 + fq * 4) * 2);
                    const u32x2 v1 = *(const u32x2*)(sV + (db * 16 + fr) * VSTR + ((2 * g + 1) * 16 + fq * 4) * 2);
                    u32x4 w; w.x = v0.x; w.y = v0.y; w.z = v1.x; w.w = v1.y;
#pragma unroll
                    for (int qi = 0; qi < QB; ++qi) o[qi][db] = mfma16(as_bf16x8(w), pf[qi][g], o[qi][db]);
                }
            }
        }
    }
#pragma unroll
    for (int qi = 0; qi < QB; ++qi) {
        float l = lsum[qi];
        l += __shfl_xor(l, 16); l += __shfl_xor(l, 32);
        const float inv = 1.0f / l;
        bf16_t* orow = out + (size_t)(wid * 16 * QB + qi * 16 + fr) * ldo + fq * 4;
#pragma unroll
        for (int db = 0; db < DB; ++db) {
            u32x2 w; w.x = cvt_pk_bf16(o[qi][db][0] * inv, o[qi][db][1] * inv); w.y = cvt_pk_bf16(o[qi][db][2] * inv, o[qi][db][3] * inv);
            *(u32x2*)(orow + db * 16) = w;
        }
    }
}

#define XB_TMO      128
#define XB_XCNT(j)  (256  + 64 * (j))
#define XB_XSUB(j)  (1280 + 64 * (j))
#define XB_XGEN(j)  (2304 + 64 * (j))
#define XB_TOP      3328
#define XB_TOPGEN   3392
#define XCD_BAR_WORDS 3456
#define XB_SPIN_CAP (1u << 18)
#define LAS __attribute__((address_space(3)))
DEV unsigned xb_ld(unsigned* p)              { return __hip_atomic_load(p, __ATOMIC_RELAXED, __HIP_MEMORY_SCOPE_AGENT); }
DEV unsigned xb_add(unsigned* p, unsigned v) { return __hip_atomic_fetch_add(p, v, __ATOMIC_RELAXED, __HIP_MEMORY_SCOPE_AGENT); }
DEV unsigned xb_xcc_id() { return (unsigned)__builtin_amdgcn_s_getreg((3 << 11) | 20) & 0xFu; }
#define XB_SPIN(cond, bar) do { unsigned _sp = 0; while (cond) { __builtin_amdgcn_s_sleep(1); \
    if ((++_sp & 255u) == 0u) { if (xb_ld(&(bar)[XB_TMO])) break; if (_sp > XB_SPIN_CAP) { atomicAdd(&(bar)[XB_TMO], 1u); break; } } } } while (0)
struct XcdBarrier { unsigned* bar; unsigned x; volatile LAS unsigned* st; };
DEV XcdBarrier xcd_barrier_post(unsigned* bar, volatile LAS unsigned* st) {
    XcdBarrier b; b.bar = bar; b.x = xb_xcc_id(); b.st = st;
    if (threadIdx.x == 0) (void)xb_add(&bar[XB_XCNT(b.x)], 1u);
    return b;
}
DEV void xcd_barrier_complete(unsigned* bar, unsigned x, unsigned& nloc, unsigned& nx) {
    const unsigned G = gridDim.x * gridDim.y * gridDim.z;
    unsigned sum, cnt, mine, sp = 0u;
    for (;;) {
        sum = 0u; cnt = 0u; mine = 0u;
#pragma unroll
        for (unsigned j = 0; j < 16; ++j) { const unsigned c = xb_ld(&bar[XB_XCNT(j)]); sum += c; cnt += (c > 0u) ? 1u : 0u; mine = (j == x) ? c : mine; }
        if (sum == G) break;
        __builtin_amdgcn_s_sleep(1);
        if ((++sp & 255u) == 0u) { if (xb_ld(&bar[XB_TMO])) break; if (sp > XB_SPIN_CAP) { atomicAdd(&bar[XB_TMO], 1u); break; } }
    }
    nloc = mine > 0u ? mine : 1u; nx = cnt > 0u ? cnt : 1u;
}
DEV void xcd_barrier(const XcdBarrier& b) {
    asm volatile("s_waitcnt vmcnt(0)" ::: "memory");
    __syncthreads();
    if (threadIdx.x == 0) {
        unsigned* bar = b.bar;
        __builtin_amdgcn_s_waitcnt(0);
        unsigned nloc = b.st[0], nx = b.st[1];
        if (nloc == 0u) { xcd_barrier_complete(bar, b.x, nloc, nx); b.st[0] = nloc; b.st[1] = nx; }
        const unsigned old = xb_add(&bar[XB_XSUB(b.x)], 1u);
        const unsigned gen = old / nloc;
        if (old + 1u == (gen + 1u) * nloc) {
            __builtin_amdgcn_fence(__ATOMIC_RELEASE, "agent");
            asm volatile("s_waitcnt vmcnt(0)" ::: "memory");
            const unsigned og = xb_add(&bar[XB_TOP], 1u);
            const unsigned tg = og / nx;
            if (og + 1u == (tg + 1u) * nx) xb_add(&bar[XB_TOPGEN], 1u);
            else XB_SPIN(xb_ld(&bar[XB_TOPGEN]) == tg, bar);
            __builtin_amdgcn_fence(__ATOMIC_ACQUIRE, "agent");
            xb_add(&bar[XB_XGEN(b.x)], 1u);
            asm volatile("s_waitcnt vmcnt(0)" ::: "memory");
        } else {
            XB_SPIN(xb_ld(&bar[XB_XGEN(b.x)]) == gen, bar);
            __builtin_amdgcn_fence(__ATOMIC_ACQUIRE, "agent");
            asm volatile("s_waitcnt vmcnt(0)" ::: "memory");
        }
    }
    __syncthreads();
}

DEV unsigned ordkey(float f) { const unsigned u = __float_as_uint(f); return (u & 0x80000000u) ? ~u : (u | 0x80000000u); }
DEV float unordkey(unsigned k) { const unsigned u = (k & 0x80000000u) ? (k & 0x7fffffffu) : ~k; return __uint_as_float(u); }
#define TOPK_INSERT(L, xk) { unsigned x_ = (xk); _Pragma("unroll") for (int s_ = 0; s_ < 16; ++s_) { const unsigned hi_ = max(L[s_], x_); x_ = min(L[s_], x_); L[s_] = hi_; } }
DEV unsigned byte_lookup(unsigned p0, unsigned p1, unsigned p2, unsigned p3, int a) {
    const unsigned w = (a < 8) ? ((a < 4) ? p0 : p1) : ((a < 12) ? p2 : p3);
    return (w >> ((a & 3) * 8)) & 0xffu;
}

DEV void grid_barrier(unsigned* bar, unsigned nblocks, unsigned& gen) {
    __threadfence();
    __syncthreads();
    gen += 1;
    if (threadIdx.x == 0) {
        const unsigned target = gen * nblocks;
        __hip_atomic_fetch_add(bar, 1u, __ATOMIC_RELEASE, __HIP_MEMORY_SCOPE_AGENT);
        while (__hip_atomic_load(bar, __ATOMIC_ACQUIRE, __HIP_MEMORY_SCOPE_AGENT) < target) __builtin_amdgcn_s_sleep(2);
    }
    __syncthreads();
    __threadfence();
}
#ifdef TIMED_MASK
#define GRID_SYNC() do { xcd_barrier(xb); { const long long tn_ = (long long)__builtin_amdgcn_s_memrealtime(); if ((TIMED_MASK >> ph_idx) & 1) t_acc += tn_ - t_last; t_last = tn_; ph_idx++; } } while (0)
#else
#define GRID_SYNC() xcd_barrier(xb)
#endif
#ifndef PH
#define PH 0x0FFF
#endif
constexpr int SMEM_BYTES = 4 * 128 * 144;

__global__ void __launch_bounds__(256, 2) fwd_megakernel(Params P) {
    cg::grid_group grid = cg::this_grid();
    __shared__ __attribute__((aligned(16))) char smem[SMEM_BYTES];
    __shared__ int s_item;
    const int nb = gridDim.x, bid = blockIdx.x;
    const int gsz = nb * 256;
    __shared__ uint4 xb_words;
    if (threadIdx.x == 0) xb_words = make_uint4(0u, 0u, 0u, 0u);
    __syncthreads();
    if (P.ws == nullptr) grid.sync();
    XcdBarrier xb = xcd_barrier_post((unsigned*)(P.ws + O_XBAR), (volatile LAS unsigned*)&xb_words);
#ifdef TIMED_MASK
    long long t_acc = 0, t_last = (long long)__builtin_amdgcn_s_memrealtime(); int ph_idx = 0;
#endif
#define XCD_TILE_LOOP(NM, NN, tm, tn) \
    for (int q_ = (bid % (nb >> 3)), R_ = (NM) >> 3, tm, tn; q_ < R_ * (NN) && ((tn = q_ / R_), (tm = (bid / (nb >> 3)) * R_ + q_ % R_), true); q_ += (nb >> 3))
#define PHASE_IDS int tid = threadIdx.x; asm volatile("" : "+v"(tid)); const int wid = __builtin_amdgcn_readfirstlane(tid >> 6), lane = tid & 63; const int gtid = bid * 256 + tid; (void)wid; (void)lane; (void)gtid;
    char* ws = P.ws;
    float* ssq0 = (float*)(ws + O_SSQ);
    float* ssqm = (float*)(ws + O_SSQ + 65536);
    float* ssqq = (float*)(ws + O_SSQ + 2 * 65536);
    float* ssqkv = (float*)(ws + O_SSQ + 3 * 65536);
    float* ssq1 = (float*)(ws + O_SSQ + 4 * 65536);
    float* ssq2 = (float*)(ws + O_SSQ + 5 * 65536);
    int* counters = (int*)(ws + O_CNT);
    float2* ropetab = (float2*)(ws + O_ROPE);
    bf16_t* p = (bf16_t*)(ws + O_P);
    bf16_t* qmla = (bf16_t*)P.out;
    bf16_t* kfull = (bf16_t*)((char*)P.out + 24 * MB);
    bf16_t* vTm = (bf16_t*)((char*)P.out + 48 * MB);

    auto do_tr = [&](int tile) {
        float* tileS = (float*)smem;

            const float* src; int ldn; bf16_t* dst; int ldk; int KT; int loc; const float* gain = nullptr; int drow_add = 0;
            bool ukv = false;
            if (tile < 560) { loc = tile; src = P.w_in; ldn = 2240; dst = (bf16_t*)(ws + O_WINT); ldk = 1024; KT = 16; gain = P.norm_mix_g; }
            else if (tile < 608) { loc = tile - 560; src = P.w_uq; ldn = 768; dst = (bf16_t*)(ws + O_WUQT); ldk = 256; KT = 4; gain = P.q_norm_g; }
            else if (tile < 640) { loc = tile - 608; src = P.w_ukv; ldn = 1024; dst = (bf16_t*)(ws + O_WUKT); ldk = 128; KT = 2; gain = P.kv_norm_g; ukv = true; }
            else if (tile < 648) { loc = tile - 640; src = P.rw_w_up; ldn = 512; dst = (bf16_t*)(ws + O_WUPT); ldk = 64; KT = 1; }
            else if (tile < 656) { loc = tile - 648; src = P.rw_a_up; ldn = 512; dst = (bf16_t*)(ws + O_AUPT); ldk = 64; KT = 1; }
            else if (tile < 672) { loc = tile - 656; src = P.rw_g_up; ldn = 512; dst = (bf16_t*)(ws + O_GUPT); ldk = 128; KT = 2; }
            else if (tile < 928) { loc = tile - 672; src = P.w_out; ldn = 1024; dst = (bf16_t*)(ws + O_WOUTT); ldk = 1024; KT = 16; }
            else if (tile < 1184) { loc = tile - 928; src = P.xa_wq; ldn = 1024; dst = (bf16_t*)(ws + O_XAQT); ldk = 1024; KT = 16; gain = P.norm_xa_g; }
            else if (tile < 1440) { loc = tile - 1184; src = P.xa_wk; ldn = 1024; dst = (bf16_t*)(ws + O_XAKVT); ldk = 1024; KT = 16; gain = P.norm_mem_g; }
            else if (tile < 1696) { loc = tile - 1440; src = P.xa_wv; ldn = 1024; dst = (bf16_t*)(ws + O_XAKVT); ldk = 1024; KT = 16; gain = P.norm_mem_g; drow_add = 1024; }
            else if (tile < 1952) { loc = tile - 1696; src = P.xa_wo; ldn = 1024; dst = (bf16_t*)(ws + O_XAOT); ldk = 1024; KT = 16; }
            else { loc = tile - 1952; src = P.peer_wq; ldn = 2048; dst = (bf16_t*)(ws + O_PWQT); ldk = 1024; KT = 16; gain = P.norm_ffn_g; }
            const int kt = loc % KT, ntile = loc / KT;
            int n0 = ntile * 64, drow0 = n0 + drow_add;
            if (ukv) {
                const int h = n0 >> 8, part = (n0 >> 7) & 1, d0 = n0 & 127;
                if (part) dst = (bf16_t*)(ws + O_WUVT);
                drow0 = h * 128 + d0;
            }
            tr_tile(src, ldn, dst, ldk, kt * 64, n0, drow0, gain, tileS);
            };
    auto convert_experts = [&](int r0, int r1, int wid, int lane) {
        unsigned char* e8u = (unsigned char*)(ws + O_EUB);
        unsigned char* e8v = (unsigned char*)(ws + O_EVB);
        float* esinv = (float*)(ws + O_SSQ + 6 * 65536);
        for (int r = r0 + wid; r < r1; r += 4) {
            const float* src = (r < 16384) ? (P.expert_u + (size_t)r * 1024) : (P.expert_v + (size_t)(r - 16384) * 1024);
            unsigned char* dst = (r < 16384) ? (e8u + (size_t)r * 1024) : (e8v + (size_t)(r - 16384) * 1024);
            f32x4 v[4]; float amax = 0.f;
#pragma unroll
            for (int i = 0; i < 4; ++i) {
                v[i] = *(const f32x4*)(src + i * 256 + lane * 4);
                amax = fmaxf(amax, fmaxf(fmaxf(fabsf(v[i][0]), fabsf(v[i][1])), fmaxf(fabsf(v[i][2]), fabsf(v[i][3]))));
            }
#pragma unroll
            for (int o = 32; o >= 1; o >>= 1) amax = fmaxf(amax, __shfl_xor(amax, o));
            amax = fmaxf(amax, 1e-30f);
            const float sc = 240.0f / amax;
#pragma unroll
            for (int i = 0; i < 4; ++i) {
                int w = 0;
                w = __builtin_amdgcn_cvt_pk_fp8_f32(v[i][0] * sc, v[i][1] * sc, w, false);
                w = __builtin_amdgcn_cvt_pk_fp8_f32(v[i][2] * sc, v[i][3] * sc, w, true);
                *(int*)(dst + i * 256 + lane * 4) = w;
            }
            if (lane == 0) esinv[r] = amax * (1.0f / 240.0f);
        }
    };
    if (PH & (1 << 0)) {
        PHASE_IDS
        for (int tile = bid; tile < 672 + 512; tile += nb) do_tr(tile < 672 ? tile : tile + 512);
        bf16_t* xb = (bf16_t*)(ws + O_XB);
        bf16_t* memb = (bf16_t*)(ws + O_MEMB);
        for (int r = bid * 4 + wid; r < T + 2048; r += nb * 4) {
            const float* srow = (r < T) ? (P.x + (size_t)r * 1024) : (P.mem + (size_t)(r - T) * 1024);
            bf16_t* drow = (r < T) ? (xb + (size_t)r * 1024) : (memb + (size_t)(r - T) * 1024);
            float ss = 0.f;
#pragma unroll
            for (int i = 0; i < 4; ++i) {
                const f32x4 v = *(const f32x4*)(srow + i * 256 + lane * 4);
                ss += v[0] * v[0] + v[1] * v[1] + v[2] * v[2] + v[3] * v[3];
                u32x2 w; w.x = cvt_pk_bf16(v[0], v[1]); w.y = cvt_pk_bf16(v[2], v[3]);
                *(u32x2*)(drow + i * 256 + lane * 4) = w;
            }
            ss = wave_sum(ss);
            if (lane == 0) { if (r < T) ssq0[r] = ss; else ssqm[r - T] = ss; }
        }
        for (int i = gtid; i < T * 32; i += gsz) {
            const int row = i >> 5, f = i & 31;
            const float inv = exp2f(-(float)f * (13.287712379549449f / 32.0f));
            const float ang = (float)P.pos[row] * inv;
            ropetab[i] = make_float2(cosf(ang), sinf(ang));
        }
        for (int i = gtid; i < T; i += gsz) { ssqq[i] = 0.f; ssqkv[i] = 0.f; ssq1[i] = 0.f; ssq2[i] = 0.f; }
        if (gtid < 64) counters[gtid] = 0;
        {
            bf16_t* keysb = (bf16_t*)(ws + O_KEYS);
            for (int i = gtid; i < 16 * 128 * 128 / 4; i += gsz) {
                const f32x4 v = *(const f32x4*)(P.peer_keys + (size_t)i * 4);
                u32x2 w; w.x = cvt_pk_bf16(v[0], v[1]); w.y = cvt_pk_bf16(v[2], v[3]);
                *(u32x2*)(keysb + (size_t)i * 4) = w;
            }
        }
        {
            u32x4* z = (u32x4*)(ws + O_WINT + (size_t)2240 * 1024 * 2);
            for (int i = gtid; i < 64 * 1024 * 2 / 16; i += gsz) z[i] = (u32x4){0u, 0u, 0u, 0u};
        }
    }
    GRID_SYNC();

    if (PH & (1 << 1)) {
        PHASE_IDS
        const bf16_t* xb = (const bf16_t*)(ws + O_XB);
        const bf16_t* memb = (const bf16_t*)(ws + O_MEMB);
        const bf16_t* winT = (const bf16_t*)(ws + O_WINT);
        const bf16_t* xakvT = (const bf16_t*)(ws + O_XAKVT);
        bf16_t* km = (bf16_t*)(ws + O_KM);
        bf16_t* vmT = (bf16_t*)(ws + O_VMT);
        auto p_epi = [&](const f32x4 (&acc)[4][4], int rbase, int cbase, int fr, int fq) {
#pragma unroll
                        for (int m = 0; m < 4; ++m) {
                            const int row = rbase + m * 16 + fr;
                            const float rs = rsqrtf(ssq0[row] * (1.0f / 1024.0f) + EPS);
                            float ss = 0.f;
#pragma unroll
                            for (int n = 0; n < 4; ++n) {
                                const f32x4 v = acc[m][n] * rs;
                                ss += v[0] * v[0] + v[1] * v[1] + v[2] * v[2] + v[3] * v[3];
                                u32x2 w; w.x = cvt_pk_bf16(v[0], v[1]); w.y = cvt_pk_bf16(v[2], v[3]);
                                *(u32x2*)(p + (size_t)row * 2304 + cbase + n * 16 + fq * 4) = w;
                            }
                            if (cbase < 384) {
                                ss += __shfl_xor(ss, 16); ss += __shfl_xor(ss, 32);
                                if (fq == 0) atomicAdd((cbase < 256) ? &ssqq[row] : &ssqkv[row], ss);
                            }
                        }
                    };
        XCD_TILE_LOOP(64, 16, tm, tn) { gemm_tile_big<true>(xb, 1024, winT, 1024, 1024, tm * 256, tn * 128, smem, p_epi); }
        for (int item = bid; item < 256; item += nb) { const int tm = item >> 1, tn = 16 + (item & 1); gemm_tile_glds<true>(xb, 1024, winT, 1024, 1024, tm * 128, tn * 128, smem, p_epi); }
    }
    GRID_SYNC();

    if (PH & (1 << 2)) {
        PHASE_IDS
        const bf16_t* wuqT = (const bf16_t*)(ws + O_WUQT);
        const bf16_t* wukT = (const bf16_t*)(ws + O_WUKT);
        const bf16_t* wuvT = (const bf16_t*)(ws + O_WUVT);
        const bf16_t* wupT = (const bf16_t*)(ws + O_WUPT);
        const bf16_t* aupT = (const bf16_t*)(ws + O_AUPT);
        const bf16_t* gupT = (const bf16_t*)(ws + O_GUPT);
        bf16_t* gbuf = (bf16_t*)(ws + O_G);
        bf16_t* rwr = (bf16_t*)(ws + O_RW_R);
        bf16_t* rwk = (bf16_t*)(ws + O_RW_K);
        bf16_t* rwv = (bf16_t*)(ws + O_RW_V);
        bf16_t* rwkk = (bf16_t*)(ws + O_RW_KK);
        bf16_t* rwka = (bf16_t*)(ws + O_RW_KA);
        float* decay = (float*)(ws + O_DECAY);
        const float QSCALE = 0.07216878364870322f * 1.4426950408889634f;
        const int N0 = 64 * 6, N1 = N0 + 256, N2 = N1 + 256, N3 = N2 + 512, N4 = N3 + 512, N5 = N4 + 512;
        auto shifted8 = [&](int row, int pc, int j0, float (&o)[8]) {
            const u32x4 cur = *(const u32x4*)(p + (size_t)row * 2304 + pc);
            u32x4 prv = (u32x4){0u, 0u, 0u, 0u};
            if (row & 2047) prv = *(const u32x4*)(p + (size_t)(row - 1) * 2304 + pc);
            const f32x4 m0 = *(const f32x4*)(P.shift_mu + j0), m1 = *(const f32x4*)(P.shift_mu + j0 + 4);
            const unsigned cu[4] = {cur.x, cur.y, cur.z, cur.w}, pu[4] = {prv.x, prv.y, prv.z, prv.w};
#pragma unroll
            for (int i = 0; i < 4; ++i) {
                const float c0 = bf_lo(cu[i]), c1 = bf_hi(cu[i]), p0 = bf_lo(pu[i]), p1 = bf_hi(pu[i]);
                const float mu0 = (i < 2) ? m0[2 * i] : m1[2 * i - 4], mu1 = (i < 2) ? m0[2 * i + 1] : m1[2 * i - 3];
                o[2 * i] = c0 + (p0 - c0) * mu0; o[2 * i + 1] = c1 + (p1 - c1) * mu1;
            }
        };
        auto shifted4 = [&](int row, int pc, int j0, f32x4& o) {
            const u32x2 cur = *(const u32x2*)(p + (size_t)row * 2304 + pc);
            u32x2 prv = (u32x2){0u, 0u};
            if (row & 2047) prv = *(const u32x2*)(p + (size_t)(row - 1) * 2304 + pc);
            const f32x4 mu = *(const f32x4*)(P.shift_mu + j0);
            const float c0 = bf_lo(cur.x), c1 = bf_hi(cur.x), c2 = bf_lo(cur.y), c3 = bf_hi(cur.y);
            const float p0 = bf_lo(prv.x), p1 = bf_hi(prv.x), p2 = bf_lo(prv.y), p3 = bf_hi(prv.y);
            o[0] = c0 + (p0 - c0) * mu[0]; o[1] = c1 + (p1 - c1) * mu[1]; o[2] = c2 + (p2 - c2) * mu[2]; o[3] = c3 + (p3 - c3) * mu[3];
        };
        for (;;) {
            __syncthreads();
            if (tid == 0) s_item = atomicAdd(&counters[1], 1);
            __syncthreads();
            const int item = s_item;
            if (item >= N5) break;
            if (item < N0) {
                const int tm = item / 6, tn = item % 6;
                gemm_tile_big<true>(p, 2304, wuqT, 256, 256, tm * 256, tn * 128, smem,
                    [&](const f32x4 (&acc)[4][4], int rbase, int cbase, int fr, int fq) {
                        const bool rope = (cbase % 192) == 128;
#pragma unroll
                        for (int m = 0; m < 4; ++m) {
                            const int row = rbase + m * 16 + fr;
                            const float rs = rsqrtf(ssqq[row] * (1.0f / 256.0f) + EPS) * QSCALE;
                            f32x4 v[4];
#pragma unroll
                            for (int n = 0; n < 4; ++n) v[n] = acc[m][n] * rs;
                            if (rope) {
#pragma unroll
                                for (int n = 0; n < 2; ++n)
#pragma unroll
                                    for (int j = 0; j < 4; ++j) {
                                        const float2 cs = ropetab[row * 32 + n * 16 + fq * 4 + j];
                                        const float t1 = v[n][j], t2 = v[n + 2][j];
                                        v[n][j] = t1 * cs.x - t2 * cs.y; v[n + 2][j] = t1 * cs.y + t2 * cs.x;
                                    }
                            }
#pragma unroll
                            for (int n = 0; n < 4; ++n) {
                                u32x2 w; w.x = cvt_pk_bf16(v[n][0], v[n][1]); w.y = cvt_pk_bf16(v[n][2], v[n][3]);
                                *(u32x2*)(qmla + (size_t)row * 768 + cbase + n * 16 + fq * 4) = w;
                            }
                        }
                    });
            } else if (item < N1) {
                const int it = item - N0, tm = it >> 2, tn = it & 3;
                gemm_tile_big<true>(p + 256, 2304, wukT, 128, 128, tm * 256, tn * 128, smem,
                    [&](const f32x4 (&acc)[4][4], int rbase, int cbase, int fr, int fq) {
#pragma unroll
                        for (int m = 0; m < 4; ++m) {
                            const int row = rbase + m * 16 + fr;
                            const float rs = rsqrtf(ssqkv[row] * (1.0f / 128.0f) + EPS);
#pragma unroll
                            for (int n = 0; n < 4; ++n) {
                                const int col = cbase + n * 16 + fq * 4, h = col >> 7, d = col & 127;
                                const f32x4 v = acc[m][n] * rs;
                                u32x2 w; w.x = cvt_pk_bf16(v[0], v[1]); w.y = cvt_pk_bf16(v[2], v[3]);
                                *(u32x2*)(kfull + (size_t)row * 768 + h * 192 + d) = w;
                            }
                        }
                    });
            } else if (item < N2) {
                const int it = item - N1, tm = it >> 2, tn = it & 3;
                gemm_tile_big<false>(p + 256, 2304, wuvT, 128, 128, tm * 256, tn * 128, smem,
                    [&](const f32x4 (&acc)[4][4], int rbase, int cbase, int fr, int fq) {
#pragma unroll
                        for (int m = 0; m < 4; ++m) {
                            const int row = rbase + m * 16 + fq * 4;
                            const f32x4 sq = *(const f32x4*)(ssqkv + row);
                            f32x4 rs;
#pragma unroll
                            for (int j = 0; j < 4; ++j) rs[j] = rsqrtf(sq[j] * (1.0f / 128.0f) + EPS);
                            const int b = row >> 11, s = row & 2047;
#pragma unroll
                            for (int n = 0; n < 4; ++n) {
                                const int col = cbase + n * 16 + fr;
                                const f32x4 v = acc[m][n] * rs;
                                u32x2 w; w.x = cvt_pk_bf16(v[0], v[1]); w.y = cvt_pk_bf16(v[2], v[3]);
                                *(u32x2*)(vTm + ((size_t)(b * 512 + col)) * 2048 + s) = w;
                            }
                        }
                    });
            } else if (item < N3) {
                const int it = item - N2, tm = it >> 2, tn = it & 3;
                auto al = [&](int row, int k) -> u32x4 {
                    float o[8]; shifted8(row, 1984 + k, 1536 + k, o);
                    u32x4 w;
                    w.x = cvt_pk_bf16(tanhf(o[0]), tanhf(o[1])); w.y = cvt_pk_bf16(tanhf(o[2]), tanhf(o[3]));
                    w.z = cvt_pk_bf16(tanhf(o[4]), tanhf(o[5])); w.w = cvt_pk_bf16(tanhf(o[6]), tanhf(o[7]));
                    return w;
                };
                gemm_tile<true>(al, wupT, 64, 64, tm * 128, tn * 128, smem,
                    [&](const f32x4 (&acc)[4][4], int rbase, int cbase, int fr, int fq) {
#pragma unroll
                        for (int m = 0; m < 4; ++m) {
                            const int row = rbase + m * 16 + fr;
#pragma unroll
                            for (int n = 0; n < 4; ++n) {
                                const int col = cbase + n * 16 + fq * 4;
                                const f32x4 w0 = *(const f32x4*)(P.rw_w0 + col);
                                f32x4 dv;
#pragma unroll
                                for (int j = 0; j < 4; ++j) {
                                    const float wp = w0[j] + acc[m][n][j];
                                    const float z = -wp;
                                    const float sp = fmaxf(z, 0.f) + log1pf(__expf(-fabsf(z)));
                                    dv[j] = __expf(-__expf(-sp - 0.5f));
                                }
                                *(f32x4*)(decay + (size_t)row * 512 + col) = dv;
                            }
                        }
                    });
            } else if (item < N4) {
                const int it = item - N3, tm = it >> 2, tn = it & 3;
                auto al = [&](int row, int k) -> u32x4 {
                    float o[8]; shifted8(row, 2048 + k, 1600 + k, o);
                    u32x4 w;
                    w.x = cvt_pk_bf16(o[0], o[1]); w.y = cvt_pk_bf16(o[2], o[3]); w.z = cvt_pk_bf16(o[4], o[5]); w.w = cvt_pk_bf16(o[6], o[7]);
                    return w;
                };
                gemm_tile<true>(al, aupT, 64, 64, tm * 128, tn * 128, smem,
                    [&](const f32x4 (&acc)[4][4], int rbase, int cbase, int fr, int fq) {
#pragma unroll
                        for (int m = 0; m < 4; ++m) {
                            const int row = rbase + m * 16 + fr;
                            f32x4 kv[4], kkr[4], av[4];
                            float ss = 0.f;
#pragma unroll
                            for (int n = 0; n < 4; ++n) {
                                const int col = cbase + n * 16 + fq * 4;
                                shifted4(row, 960 + col, 512 + col, kv[n]);
                                const f32x4 kkw = *(const f32x4*)(P.rw_k_k + col);
                                const f32x4 a0 = *(const f32x4*)(P.rw_a0 + col);
#pragma unroll
                                for (int j = 0; j < 4; ++j) {
                                    kkr[n][j] = kv[n][j] * kkw[j]; ss += kkr[n][j] * kkr[n][j];
                                    av[n][j] = sigmoidf_(a0[j] + acc[m][n][j]);
                                }
                            }
                            ss += __shfl_xor(ss, 16); ss += __shfl_xor(ss, 32);
                            const float inv = 1.0f / fmaxf(sqrtf(ss), 1e-12f);
#pragma unroll
                            for (int n = 0; n < 4; ++n) {
                                const int col = cbase + n * 16 + fq * 4;
                                const f32x4 ka = *(const f32x4*)(P.rw_k_a + col);
                                f32x4 rv, vv, kk, k2, kka;
                                shifted4(row, 448 + col, col, rv);
                                shifted4(row, 1472 + col, 1024 + col, vv);
#pragma unroll
                                for (int j = 0; j < 4; ++j) {
                                    kk[j] = kkr[n][j] * inv;
                                    k2[j] = kv[n][j] * (1.0f + (av[n][j] - 1.0f) * ka[j]);
                                    kka[j] = kk[j] * av[n][j];
                                }
                                const size_t o = (size_t)row * 512 + col;
                                u32x2 w;
                                w.x = cvt_pk_bf16(rv[0], rv[1]); w.y = cvt_pk_bf16(rv[2], rv[3]); *(u32x2*)(rwr + o) = w;
                                w.x = cvt_pk_bf16(k2[0], k2[1]); w.y = cvt_pk_bf16(k2[2], k2[3]); *(u32x2*)(rwk + o) = w;
                                w.x = cvt_pk_bf16(vv[0], vv[1]); w.y = cvt_pk_bf16(vv[2], vv[3]); *(u32x2*)(rwv + o) = w;
                                w.x = cvt_pk_bf16(kk[0], kk[1]); w.y = cvt_pk_bf16(kk[2], kk[3]); *(u32x2*)(rwkk + o) = w;
                                w.x = cvt_pk_bf16(kka[0], kka[1]); w.y = cvt_pk_bf16(kka[2], kka[3]); *(u32x2*)(rwka + o) = w;
                            }
                        }
                    });
            } else {
                const int it = item - N4, tm = it >> 2, tn = it & 3;
                auto al = [&](int row, int k) -> u32x4 {
                    float o[8]; shifted8(row, 2112 + k, 1664 + k, o);
                    u32x4 w;
                    w.x = cvt_pk_bf16(sigmoidf_(o[0]), sigmoidf_(o[1])); w.y = cvt_pk_bf16(sigmoidf_(o[2]), sigmoidf_(o[3]));
                    w.z = cvt_pk_bf16(sigmoidf_(o[4]), sigmoidf_(o[5])); w.w = cvt_pk_bf16(sigmoidf_(o[6]), sigmoidf_(o[7]));
                    return w;
                };
                gemm_tile<true>(al, gupT, 128, 128, tm * 128, tn * 128, smem,
                    [&](const f32x4 (&acc)[4][4], int rbase, int cbase, int fr, int fq) {
#pragma unroll
                        for (int m = 0; m < 4; ++m) {
                            const int row = rbase + m * 16 + fr;
#pragma unroll
                            for (int n = 0; n < 4; ++n) {
                                const f32x4 v = acc[m][n];
                                u32x2 w; w.x = cvt_pk_bf16(v[0], v[1]); w.y = cvt_pk_bf16(v[2], v[3]);
                                *(u32x2*)(gbuf + (size_t)row * 512 + cbase + n * 16 + fq * 4) = w;
                            }
                        }
                    });
            }
        }
        for (int i = gtid; i < T * 32; i += gsz) {
            const int row = i >> 5, f = i & 31;
            const float t1 = __uint_as_float((unsigned)p[(size_t)row * 2304 + 384 + f] << 16);
            const float t2 = __uint_as_float((unsigned)p[(size_t)row * 2304 + 416 + f] << 16);
            const float2 cs = ropetab[i];
            const bf16_t o1 = (bf16_t)(cvt_pk_bf16(t1 * cs.x - t2 * cs.y, 0.f) & 0xffffu);
            const bf16_t o2 = (bf16_t)(cvt_pk_bf16(t1 * cs.y + t2 * cs.x, 0.f) & 0xffffu);
#pragma unroll
            for (int h = 0; h < 4; ++h) { kfull[(size_t)row * 768 + h * 192 + 128 + f] = o1; kfull[(size_t)row * 768 + h * 192 + 160 + f] = o2; }
        }
    }
    GRID_SYNC();

    if (PH & (1 << 3)) {
        PHASE_IDS
        const bf16_t* rwr = (const bf16_t*)(ws + O_RW_R);
        const bf16_t* rwk = (const bf16_t*)(ws + O_RW_K);
        const bf16_t* rwv = (const bf16_t*)(ws + O_RW_V);
        const bf16_t* rwkk = (const bf16_t*)(ws + O_RW_KK);
        const bf16_t* rwka = (const bf16_t*)(ws + O_RW_KA);
        const float* decay = (const float*)(ws + O_DECAY);
        bf16_t* yraw = (bf16_t*)(ws + O_YRAW);
        bf16_t* mix = (bf16_t*)(ws + O_MIX);
        for (;;) {
            __syncthreads();
            if (tid == 0) s_item = atomicAdd(&counters[0], 1);
            __syncthreads();
            const int item = s_item;
            if (item >= 256 + 512 + 128 + 320 + 512) break;
            if (item < 256) {
                const int b = item >> 5, h = (item >> 2) & 7, qr = item & 3;
                float* opnd = (float*)smem;
                float* vbuf = (float*)(smem + 40960);
                float* ybuf = (float*)(smem + 40960 + 2048);
                const int seg = lane & 15, rl = wid * 4 + (lane >> 4);
                const int lstep = tid >> 4, lc4 = (tid & 15) * 4;
                const int vstep = (tid & 63) >> 2, vc4 = (tid & 3) * 4;
                const size_t gbase = ((size_t)b * 2048) * 512 + h * 64;
                u32x2 pr_kk, pr_k, pr_r, pr_ka, pr_v; f32x4 pr_w;
                auto prefetch = [&](int ch) {
                    const size_t o = gbase + (size_t)(ch * 16 + lstep) * 512 + lc4;
                    pr_kk = *(const u32x2*)(rwkk + o); pr_k = *(const u32x2*)(rwk + o); pr_r = *(const u32x2*)(rwr + o); pr_ka = *(const u32x2*)(rwka + o);
                    pr_w = *(const f32x4*)(decay + o);
                    if (tid < 64) pr_v = *(const u32x2*)(rwv + gbase + (size_t)(ch * 16 + vstep) * 512 + qr * 16 + vc4);
                };
                auto commit = [&](int buf) {
                    float* ob = opnd + buf * 5120 + lstep * 64 + lc4;
                    *(f32x4*)(ob + 0 * 1024) = (f32x4){bf_lo(pr_kk.x), bf_hi(pr_kk.x), bf_lo(pr_kk.y), bf_hi(pr_kk.y)};
                    *(f32x4*)(ob + 1 * 1024) = pr_w;
                    *(f32x4*)(ob + 2 * 1024) = (f32x4){bf_lo(pr_k.x), bf_hi(pr_k.x), bf_lo(pr_k.y), bf_hi(pr_k.y)};
                    *(f32x4*)(ob + 3 * 1024) = (f32x4){bf_lo(pr_r.x), bf_hi(pr_r.x), bf_lo(pr_r.y), bf_hi(pr_r.y)};
                    *(f32x4*)(ob + 4 * 1024) = (f32x4){bf_lo(pr_ka.x), bf_hi(pr_ka.x), bf_lo(pr_ka.y), bf_hi(pr_ka.y)};
                    if (tid < 64) *(f32x4*)(vbuf + buf * 256 + vstep * 16 + vc4) = (f32x4){bf_lo(pr_v.x), bf_hi(pr_v.x), bf_lo(pr_v.y), bf_hi(pr_v.y)};
                };
                float s0 = 0.f, s1 = 0.f, s2 = 0.f, s3 = 0.f;
                prefetch(0); commit(0);
                __syncthreads();
                for (int ch = 0; ch < 128; ++ch) {
                    if (ch + 1 < 128) prefetch(ch + 1);
                    const float* ob = opnd + (ch & 1) * 5120 + seg * 4;
                    const float* vb = vbuf + (ch & 1) * 256 + rl;
                    float ykeep = 0.f;
                    f32x4 c_kk = *(const f32x4*)(ob + 0 * 1024), c_w = *(const f32x4*)(ob + 1 * 1024), c_k = *(const f32x4*)(ob + 2 * 1024);
                    f32x4 c_r = *(const f32x4*)(ob + 3 * 1024), c_a = *(const f32x4*)(ob + 4 * 1024);
                    float c_v = vb[0];
                    f32x4 r_prev = c_r;
#pragma unroll
                    for (int s = 0; s < 16; ++s) {
                        f32x4 n_kk = c_kk, n_w = c_w, n_k = c_k, n_r = c_r, n_a = c_a; float n_v = c_v;
                        if (s + 1 < 16) {
                            n_kk = *(const f32x4*)(ob + 0 * 1024 + (s + 1) * 64); n_w = *(const f32x4*)(ob + 1 * 1024 + (s + 1) * 64);
                            n_k = *(const f32x4*)(ob + 2 * 1024 + (s + 1) * 64); n_r = *(const f32x4*)(ob + 3 * 1024 + (s + 1) * 64);
                            n_a = *(const f32x4*)(ob + 4 * 1024 + (s + 1) * 64); n_v = vb[(s + 1) * 16];
                        }
                        __builtin_amdgcn_sched_barrier(0);
                        float t0 = opq(s0 * c_kk[0]), u0 = opq(s0 * r_prev[0]);
                        float t1 = opq(s1 * c_kk[1]), u1 = opq(s1 * r_prev[1]);
                        t0 = opq(__builtin_fmaf(s2, c_kk[2], t0)); u0 = opq(__builtin_fmaf(s2, r_prev[2], u0));
                        t1 = opq(__builtin_fmaf(s3, c_kk[3], t1)); u1 = opq(__builtin_fmaf(s3, r_prev[3], u1));
                        float sa = opq(t0 + t1), y = opq(u0 + u1);
                        const float kv0 = opq(c_k[0] * c_v), kv1 = opq(c_k[1] * c_v), kv2 = opq(c_k[2] * c_v), kv3 = opq(c_k[3] * c_v);
                        allreduce16_pair(sa, y);
                        if (s > 0 && (s - 1) == seg) ykeep = y;
                        const float nsa = -sa;
                        s0 = opq(__builtin_fmaf(s0, c_w[0], opq(__builtin_fmaf(c_a[0], nsa, kv0))));
                        s1 = opq(__builtin_fmaf(s1, c_w[1], opq(__builtin_fmaf(c_a[1], nsa, kv1))));
                        s2 = opq(__builtin_fmaf(s2, c_w[2], opq(__builtin_fmaf(c_a[2], nsa, kv2))));
                        s3 = opq(__builtin_fmaf(s3, c_w[3], opq(__builtin_fmaf(c_a[3], nsa, kv3))));
                        r_prev = c_r;
                        c_kk = n_kk; c_w = n_w; c_k = n_k; c_r = n_r; c_a = n_a; c_v = n_v;
                    }
                    {
                        float u0 = opq(s0 * r_prev[0]), u1 = opq(s1 * r_prev[1]);
                        u0 = opq(__builtin_fmaf(s2, r_prev[2], u0)); u1 = opq(__builtin_fmaf(s3, r_prev[3], u1));
                        float y = u0 + u1;
                        y = allreduce16(y);
                        if (seg == 15) ykeep = y;
                    }
                    ybuf[seg * 16 + rl] = ykeep;
                    lds_barrier();
                    yraw[gbase + (size_t)(ch * 16 + (tid >> 4)) * 512 + qr * 16 + (tid & 15)] = (bf16_t)(cvt_pk_bf16(ybuf[tid], 0.f) & 0xffffu);
                    if (ch + 1 < 128) commit((ch + 1) & 1);
                    lds_barrier();
                }
            } else if (item < 768) {
                const int a = item - 256, qb = 15 - (a >> 5), bh = a & 31, b = bh >> 2, h = bh & 3;
                const size_t row0 = (size_t)b * 2048 + qb * 128;
                attn_item<192, 128, false, 2>(qmla + row0 * 768 + h * 192, 768,
                                    kfull + ((size_t)b * 2048) * 768 + h * 192, 768,
                                    vTm + ((size_t)(b * 4 + h) * 128) * 2048, 2048, 2 * qb + 2, 2 * qb + 1,
                                    mix + row0 * 1024 + h * 128, 1024, smem);
            } else if (item < 896) {
                const int i_ = item - 768, tm = i_ >> 4, tn = i_ & 15;
                const bf16_t* memb = (const bf16_t*)(ws + O_MEMB);
                const bf16_t* xakvT = (const bf16_t*)(ws + O_XAKVT);
                bf16_t* km = (bf16_t*)(ws + O_KM);
                bf16_t* vmT = (bf16_t*)(ws + O_VMT);
                if (tn < 8) {
                    gemm_tile_big<true>(memb, 1024, xakvT, 1024, 1024, tm * 256, tn * 128, smem,
                        [&](const f32x4 (&acc)[4][4], int rbase, int cbase, int fr, int fq) {
#pragma unroll
                            for (int m = 0; m < 4; ++m) {
                                const int row = rbase + m * 16 + fr;
                                const float rs = rsqrtf(ssqm[row] * (1.0f / 1024.0f) + EPS);
#pragma unroll
                                for (int n = 0; n < 4; ++n) {
                                    const f32x4 v = acc[m][n] * rs;
                                    u32x2 w; w.x = cvt_pk_bf16(v[0], v[1]); w.y = cvt_pk_bf16(v[2], v[3]);
                                    *(u32x2*)(km + (size_t)row * 1024 + cbase + n * 16 + fq * 4) = w;
                                }
                            }
                        });
                } else {
                    gemm_tile_big<false>(memb, 1024, xakvT, 1024, 1024, tm * 256, tn * 128, smem,
                        [&](const f32x4 (&acc)[4][4], int rbase, int cbase, int fr, int fq) {
#pragma unroll
                            for (int m = 0; m < 4; ++m) {
                                const int row = rbase + m * 16 + fq * 4;
                                const f32x4 sq = *(const f32x4*)(ssqm + row);
                                f32x4 rs;
#pragma unroll
                                for (int j = 0; j < 4; ++j) rs[j] = rsqrtf(sq[j] * (1.0f / 1024.0f) + EPS);
                                const int b = row >> 8, mi = row & 255;
#pragma unroll
                                for (int n = 0; n < 4; ++n) {
                                    const int col = cbase + n * 16 + fr - 1024;
                                    const f32x4 v = acc[m][n] * rs;
                                    u32x2 w; w.x = cvt_pk_bf16(v[0], v[1]); w.y = cvt_pk_bf16(v[2], v[3]);
                                    *(u32x2*)(vmT + ((size_t)(b * 1024 + col)) * 256 + mi) = w;
                                }
                            }
                        });
                }
            } else {
                const int i_ = item - 896;
                if (i_ < 320) { for (int t_ = 0; t_ < 4; ++t_) { const int tl_ = i_ * 4 + t_; do_tr(tl_ < 512 ? 672 + tl_ : 1696 + (tl_ - 512)); } }
                else { const int r0_ = (i_ - 320) * 64; convert_experts(r0_, r0_ + 64, wid, lane); }
            }
        }
    }
    GRID_SYNC();

    if (PH & (1 << 4)) {
        PHASE_IDS
        const bf16_t* rwr = (const bf16_t*)(ws + O_RW_R);
        const bf16_t* rwk = (const bf16_t*)(ws + O_RW_K);
        const bf16_t* rwv = (const bf16_t*)(ws + O_RW_V);
        const bf16_t* gbuf = (const bf16_t*)(ws + O_G);
        const bf16_t* yraw = (const bf16_t*)(ws + O_YRAW);
        bf16_t* mix = (bf16_t*)(ws + O_MIX);
#pragma unroll 4
        for (int i = gtid; i < T * 128; i += gsz) {
            const int row = i >> 7, c4 = (i & 127) * 4;
            const size_t o = (size_t)row * 512 + c4;
            const u32x2 yu = *(const u32x2*)(yraw + o);
            const f32x4 y = (f32x4){bf_lo(yu.x), bf_hi(yu.x), bf_lo(yu.y), bf_hi(yu.y)};
            float s1 = y[0] + y[1] + y[2] + y[3];
#pragma unroll
            for (int d = 1; d < 16; d <<= 1) s1 += __shfl_xor(s1, d);
            const float mu = s1 * (1.0f / 64.0f);
            const f32x4 dy = y - mu;
            float s2 = dy[0] * dy[0] + dy[1] * dy[1] + dy[2] * dy[2] + dy[3] * dy[3];
            const u32x2 ru = *(const u32x2*)(rwr + o), ku = *(const u32x2*)(rwk + o), vu = *(const u32x2*)(rwv + o), gu = *(const u32x2*)(gbuf + o);
            const f32x4 rk = *(const f32x4*)(P.rw_r_k + c4);
            const f32x4 rv = (f32x4){bf_lo(ru.x), bf_hi(ru.x), bf_lo(ru.y), bf_hi(ru.y)};
            const f32x4 kv = (f32x4){bf_lo(ku.x), bf_hi(ku.x), bf_lo(ku.y), bf_hi(ku.y)};
            const f32x4 vv = (f32x4){bf_lo(vu.x), bf_hi(vu.x), bf_lo(vu.y), bf_hi(vu.y)};
            const f32x4 gv = (f32x4){bf_lo(gu.x), bf_hi(gu.x), bf_lo(gu.y), bf_hi(gu.y)};
            float s3 = rv[0] * kv[0] * rk[0] + rv[1] * kv[1] * rk[1] + rv[2] * kv[2] * rk[2] + rv[3] * kv[3] * rk[3];
#pragma unroll
            for (int d = 1; d < 16; d <<= 1) { s2 += __shfl_xor(s2, d); s3 += __shfl_xor(s3, d); }
            const float rstd = rsqrtf(s2 * (1.0f / 64.0f) + 64e-5f);
            const f32x4 lw = *(const f32x4*)(P.rw_lnx_w + c4), lb = *(const f32x4*)(P.rw_lnx_b + c4);
            f32x4 r;
#pragma unroll
            for (int j = 0; j < 4; ++j) {
#ifdef DBG_NOY
                r[j] = (lb[j] + s3 * vv[j]) * gv[j];
#else
                r[j] = (dy[j] * rstd * lw[j] + lb[j] + s3 * vv[j]) * gv[j];
#endif
            }
            u32x2 w; w.x = cvt_pk_bf16(r[0], r[1]); w.y = cvt_pk_bf16(r[2], r[3]);
            *(u32x2*)(mix + (size_t)row * 1024 + 512 + c4) = w;
        }
    }
    GRID_SYNC();

    if (PH & (1 << 5)) {
        PHASE_IDS
        const bf16_t* mix = (const bf16_t*)(ws + O_MIX);
        const bf16_t* woutT = (const bf16_t*)(ws + O_WOUTT);
        bf16_t* h1b = (bf16_t*)(ws + O_H1B);
        XCD_TILE_LOOP(64, 8, tm, tn) {
            auto almix = [&](int row, int k) -> u32x4 {
#ifdef DBG_ZERO_RWKV
                if (k >= 512) return (u32x4){0u, 0u, 0u, 0u};
#endif
#ifdef DBG_ZERO_MLA
                if (k < 512) return (u32x4){0u, 0u, 0u, 0u};
#endif
                return *(const u32x4*)(mix + (size_t)row * 1024 + k);
            };
            (void)almix; gemm_tile_big<true>(mix, 1024, woutT, 1024, 1024, tm * 256, tn * 128, smem,
                [&](const f32x4 (&acc)[4][4], int rbase, int cbase, int fr, int fq) {
#pragma unroll
                    for (int m = 0; m < 4; ++m) {
                        const int row = rbase + m * 16 + fr;
                        float ss = 0.f;
#pragma unroll
                        for (int n = 0; n < 4; ++n) {
                            const size_t o = (size_t)row * 1024 + cbase + n * 16 + fq * 4;
                            const f32x4 v = *(const f32x4*)(P.x + o) + acc[m][n];
                            ss += v[0] * v[0] + v[1] * v[1] + v[2] * v[2] + v[3] * v[3];
                            *(f32x4*)(P.out + o) = v;
                            u32x2 w; w.x = cvt_pk_bf16(v[0], v[1]); w.y = cvt_pk_bf16(v[2], v[3]);
                            *(u32x2*)(h1b + o) = w;
                        }
                        ss += __shfl_xor(ss, 16); ss += __shfl_xor(ss, 32);
                        if (fq == 0) atomicAdd(&ssq1[row], ss);
                    }
                });
        }
    }
    GRID_SYNC();

    if (PH & (1 << 6)) {
        PHASE_IDS
        const bf16_t* h1b = (const bf16_t*)(ws + O_H1B);
        const bf16_t* xaqT = (const bf16_t*)(ws + O_XAQT);
        bf16_t* qxa = (bf16_t*)(ws + O_QXA);
        const float XSCALE = 0.0625f * 1.4426950408889634f;
        XCD_TILE_LOOP(64, 8, tm, tn) {
            gemm_tile_big<true>(h1b, 1024, xaqT, 1024, 1024, tm * 256, tn * 128, smem,
                [&](const f32x4 (&acc)[4][4], int rbase, int cbase, int fr, int fq) {
#pragma unroll
                    for (int m = 0; m < 4; ++m) {
                        const int row = rbase + m * 16 + fr;
                        const float rs = rsqrtf(ssq1[row] * (1.0f / 1024.0f) + EPS) * XSCALE;
#pragma unroll
                        for (int n = 0; n < 4; ++n) {
                            const f32x4 v = acc[m][n] * rs;
                            u32x2 w; w.x = cvt_pk_bf16(v[0], v[1]); w.y = cvt_pk_bf16(v[2], v[3]);
                            *(u32x2*)(qxa + (size_t)row * 1024 + cbase + n * 16 + fq * 4) = w;
                        }
                    }
                });
        }
    }
    GRID_SYNC();

    if (PH & (1 << 7)) {
        PHASE_IDS
        const bf16_t* qxa = (const bf16_t*)(ws + O_QXA);
        const bf16_t* km = (const bf16_t*)(ws + O_KM);
        const bf16_t* vmT = (const bf16_t*)(ws + O_VMT);
        bf16_t* oxa = (bf16_t*)(ws + O_OXA);
        for (int item = bid; item < 8 * 4 * 32; item += nb) {
            const int qt = item >> 5 & 31, bh = item & 31;
            const int b = bh >> 2, h = bh & 3;
            const size_t row0 = (size_t)b * 2048 + qt * 64;
            attn_item<256, 256, true, 1>(qxa + row0 * 1024 + h * 256, 1024,
                                km + ((size_t)b * 256) * 1024 + h * 256, 1024,
                                vmT + ((size_t)(b * 4 + h) * 256) * 256, 256, 4, 4,
                                oxa + row0 * 1024 + h * 256, 1024, smem);
        }
    }
    GRID_SYNC();

    if (PH & (1 << 8)) {
        PHASE_IDS
        const bf16_t* oxa = (const bf16_t*)(ws + O_OXA);
        const bf16_t* xaoT = (const bf16_t*)(ws + O_XAOT);
        bf16_t* h2b = (bf16_t*)(ws + O_H2B);
        XCD_TILE_LOOP(64, 8, tm, tn) {
            gemm_tile_big<true>(oxa, 1024, xaoT, 1024, 1024, tm * 256, tn * 128, smem,
                [&](const f32x4 (&acc)[4][4], int rbase, int cbase, int fr, int fq) {
#pragma unroll
                    for (int m = 0; m < 4; ++m) {
                        const int row = rbase + m * 16 + fr;
                        float ss = 0.f;
#pragma unroll
                        for (int n = 0; n < 4; ++n) {
                            const size_t o = (size_t)row * 1024 + cbase + n * 16 + fq * 4;
                            const f32x4 v = *(const f32x4*)(P.out + o) + acc[m][n];
                            ss += v[0] * v[0] + v[1] * v[1] + v[2] * v[2] + v[3] * v[3];
                            *(f32x4*)(P.out + o) = v;
                            u32x2 w; w.x = cvt_pk_bf16(v[0], v[1]); w.y = cvt_pk_bf16(v[2], v[3]);
                            *(u32x2*)(h2b + o) = w;
                        }
                        ss += __shfl_xor(ss, 16); ss += __shfl_xor(ss, 32);
                        if (fq == 0) atomicAdd(&ssq2[row], ss);
                    }
                });
        }
    }
    GRID_SYNC();

    if (PH & (1 << 9)) {
        PHASE_IDS
        const bf16_t* h2b = (const bf16_t*)(ws + O_H2B);
        const bf16_t* pwqT = (const bf16_t*)(ws + O_PWQT);
        bf16_t* pq = (bf16_t*)(ws + O_PQ);
        const bf16_t* keysb = (const bf16_t*)(ws + O_KEYS);
        bf16_t* scores = (bf16_t*)(ws + O_SCORES);
        (void)pq;
        XCD_TILE_LOOP(64, 16, tm, g) { pq_scores_tile(h2b, 1024, pwqT, 1024, 1024, tm * 256, g, ssq2, keysb, scores, smem); }
    }
    GRID_SYNC();

    if (PH & (1 << 11)) {
        PHASE_IDS
        const bf16_t* scores = (const bf16_t*)(ws + O_SCORES);
        const unsigned char* eu8 = (const unsigned char*)(ws + O_EUB);
        const unsigned char* ev8 = (const unsigned char*)(ws + O_EVB);
        const float* esinv = (const float*)(ws + O_SSQ + 6 * 65536);
        char* wsm = smem + wid * 13824;
        int* eidx = (int*)wsm;
        float* egate = (float*)(wsm + 4096);
        float* esu = (float*)(wsm + 8192);
        unsigned char* xs = (unsigned char*)(wsm + 12288);
        float* acts = (float*)(wsm + 13312);
        const int fr = lane & 15, fq = lane >> 4;
        for (int witem = bid * 4 + wid; witem < T / 8; witem += nb * 4) {
            const int t0 = witem * 8;
            {
                const int tt = lane >> 3, h = lane & 7;
                const bf16_t* sp = scores + (size_t)(t0 + tt) * 2048 + h * 256;
                unsigned L1[16], L2[16];
#pragma unroll
                for (int s = 0; s < 16; ++s) { L1[s] = 0u; L2[s] = 0u; }
                for (int i = 0; i < 128; i += 8) {
                    const u32x4 a = *(const u32x4*)(sp + i);
                    const u32x4 b = *(const u32x4*)(sp + 128 + i);
                    const unsigned au[4] = {a.x, a.y, a.z, a.w}, bu[4] = {b.x, b.y, b.z, b.w};
#pragma unroll
                    for (int e = 0; e < 4; ++e) {
                        const unsigned id0 = 127u - (unsigned)(i + 2 * e), id1 = id0 - 1u;
                        TOPK_INSERT(L1, (ordkey(bf_lo(au[e])) & ~127u) | id0);
                        TOPK_INSERT(L1, (ordkey(bf_hi(au[e])) & ~127u) | id1);
                        TOPK_INSERT(L2, (ordkey(bf_lo(bu[e])) & ~127u) | id0);
                        TOPK_INSERT(L2, (ordkey(bf_hi(bu[e])) & ~127u) | id1);
                    }
                }
                float v1[16], v2[16];
                unsigned pa0 = 0u, pa1 = 0u, pa2 = 0u, pa3 = 0u, pb0 = 0u, pb1 = 0u, pb2 = 0u, pb3 = 0u;
#pragma unroll
                for (int s = 0; s < 16; ++s) {
                    v1[s] = unordkey(L1[s] & ~127u); v2[s] = unordkey(L2[s] & ~127u);
                    const unsigned i1_ = (127u - (L1[s] & 127u)) << ((s & 3) * 8), i2_ = (127u - (L2[s] & 127u)) << ((s & 3) * 8);
                    if ((s >> 2) == 0) { pa0 |= i1_; pb0 |= i2_; } else if ((s >> 2) == 1) { pa1 |= i1_; pb1 |= i2_; }
                    else if ((s >> 2) == 2) { pa2 |= i1_; pb2 |= i2_; } else { pa3 |= i1_; pb3 |= i2_; }
                }
                unsigned C[16];
#pragma unroll
                for (int s = 0; s < 16; ++s) C[s] = 0u;
#pragma unroll
                for (int a = 0; a < 16; ++a)
#pragma unroll
                    for (int b = 0; b < 16; ++b)
                        if ((a + 1) * (b + 1) <= 16) { TOPK_INSERT(C, (ordkey(v1[a] + v2[b]) & ~255u) | (255u - (unsigned)(a * 16 + b))); }
                float cv[16], sum = 0.f;
                {
                    const float mxv = unordkey(C[0] & ~255u);
                    sum = 0.f;
#pragma unroll
                    for (int s = 0; s < 16; ++s) { cv[s] = __expf(unordkey(C[s] & ~255u) - mxv); sum += cv[s]; }
                }
                const float isum = 1.0f / sum;
#pragma unroll
                for (int s = 0; s < 16; ++s) {
                    const int ab = 255 - (int)(C[s] & 255u), a = ab >> 4, b = ab & 15;
                    const int e = (int)(byte_lookup(pa0, pa1, pa2, pa3, a) * 128u + byte_lookup(pb0, pb1, pb2, pb3, b));
                    eidx[tt * 128 + h * 16 + s] = e;
                    egate[tt * 128 + h * 16 + s] = cv[s] * isum * esinv[16384 + e];
                    esu[tt * 128 + h * 16 + s] = esinv[e];
                }
            }
            __builtin_amdgcn_wave_barrier();
            for (int tt = 0; tt < 8; ++tt) {
                const int row = t0 + tt;
                const float* hrow = P.out + (size_t)row * 1024 + lane * 16;
                f32x4 hv[4];
#pragma unroll
                for (int i = 0; i < 4; ++i) hv[i] = *(const f32x4*)(hrow + i * 4);
                const float rs2 = rsqrtf(ssq2[row] * (1.0f / 1024.0f) + EPS);
                float sxinv;
                {
                    f32x4 a[4]; float amax = 0.f;
#pragma unroll
                    for (int i = 0; i < 4; ++i) {
                        a[i] = hv[i] * *(const f32x4*)(P.norm_ffn_g + lane * 16 + i * 4) * rs2;
                        amax = fmaxf(amax, fmaxf(fmaxf(fabsf(a[i][0]), fabsf(a[i][1])), fmaxf(fabsf(a[i][2]), fabsf(a[i][3]))));
                    }
#pragma unroll
                    for (int o = 32; o >= 1; o >>= 1) amax = fmaxf(amax, __shfl_xor(amax, o));
                    amax = fmaxf(amax, 1e-30f);
                    const float sc = 240.0f / amax; sxinv = amax * (1.0f / 240.0f);
                    int w[4];
#pragma unroll
                    for (int i = 0; i < 4; ++i) {
                        w[i] = __builtin_amdgcn_cvt_pk_fp8_f32(a[i][0] * sc, a[i][1] * sc, 0, false);
                        w[i] = __builtin_amdgcn_cvt_pk_fp8_f32(a[i][2] * sc, a[i][3] * sc, w[i], true);
                    }
                    *(u32x4*)(xs + lane * 16) = (u32x4){(unsigned)w[0], (unsigned)w[1], (unsigned)w[2], (unsigned)w[3]};
                }
                __builtin_amdgcn_wave_barrier();
                int er[8];
#pragma unroll
                for (int eg = 0; eg < 8; ++eg) er[eg] = eidx[tt * 128 + eg * 16 + fr];
                f32x4 acc[8];
#pragma unroll
                for (int eg = 0; eg < 8; ++eg) acc[eg] = (f32x4){0.f, 0.f, 0.f, 0.f};
#pragma unroll 2
                for (int it = 0; it < 16; ++it) {
                    const i64x2 xq = *(const i64x2*)(xs + it * 64 + fq * 16);
#pragma unroll
                    for (int eg = 0; eg < 8; ++eg) {
                        const i64x2 uq = *(const i64x2*)(eu8 + (size_t)er[eg] * 1024 + it * 64 + fq * 16);
                        acc[eg] = __builtin_amdgcn_mfma_f32_16x16x32_fp8_fp8(uq.x, xq.x, acc[eg], 0, 0, 0);
                        acc[eg] = __builtin_amdgcn_mfma_f32_16x16x32_fp8_fp8(uq.y, xq.y, acc[eg], 0, 0, 0);
                    }
                }
                {
                    const int my_eg = fr & 7, my_jp = fr >> 3;
                    float p0 = 0.f, p1 = 0.f;
#pragma unroll
                    for (int eg = 0; eg < 8; ++eg) {
                        const float q0 = my_jp ? acc[eg][2] : acc[eg][0], q1 = my_jp ? acc[eg][3] : acc[eg][1];
                        p0 = (eg == my_eg) ? q0 : p0; p1 = (eg == my_eg) ? q1 : p1;
                    }
                    const int sidx = my_eg * 16 + fq * 4 + my_jp * 2;
                    const f32x2_t gt = *(const f32x2_t*)(egate + tt * 128 + sidx), su = *(const f32x2_t*)(esu + tt * 128 + sidx);
                    const float pre0 = p0 * su[0] * sxinv, pre1 = p1 * su[1] * sxinv;
                    f32x2_t av;
                    av[0] = 0.5f * pre0 * (1.0f + erff(pre0 * 0.70710678118654752f)) * gt[0];
                    av[1] = 0.5f * pre1 * (1.0f + erff(pre1 * 0.70710678118654752f)) * gt[1];
                    *(f32x2_t*)(acts + sidx) = av;
                }
                __builtin_amdgcn_wave_barrier();
                f32x4 oa[4];
#pragma unroll
                for (int i = 0; i < 4; ++i) oa[i] = (f32x4){0.f, 0.f, 0.f, 0.f};
                for (int j0 = 0; j0 < 128; j0 += 8) {
                    const f32x4 a4 = *(const f32x4*)(acts + j0), a5 = *(const f32x4*)(acts + j0 + 4);
                    const float as[8] = {a4[0], a4[1], a4[2], a4[3], a5[0], a5[1], a5[2], a5[3]};
                    u32x4 vq[8];
#pragma unroll
                    for (int jj = 0; jj < 8; ++jj) vq[jj] = *(const u32x4*)(ev8 + (size_t)eidx[tt * 128 + j0 + jj] * 1024 + lane * 16);
#pragma unroll
                    for (int jj = 0; jj < 8; ++jj) {
                        const float a = as[jj];
                        const unsigned q4[4] = {vq[jj].x, vq[jj].y, vq[jj].z, vq[jj].w};
#pragma unroll
                        for (int i = 0; i < 4; ++i) {
                            const f32x2_t lo = __builtin_amdgcn_cvt_pk_f32_fp8((int)q4[i], false), hi = __builtin_amdgcn_cvt_pk_f32_fp8((int)q4[i], true);
                            oa[i][0] += a * lo[0]; oa[i][1] += a * lo[1]; oa[i][2] += a * hi[0]; oa[i][3] += a * hi[1];
                        }
                    }
                }
                float ss = 0.f;
#pragma unroll
                for (int i = 0; i < 4; ++i) { hv[i] = hv[i] + oa[i]; ss += hv[i][0] * hv[i][0] + hv[i][1] * hv[i][1] + hv[i][2] * hv[i][2] + hv[i][3] * hv[i][3]; }
                ss = wave_sum(ss);
                const float rs3 = rsqrtf(ss * (1.0f / 1024.0f) + EPS);
                float* orow = P.out + (size_t)row * 1024 + lane * 16;
#pragma unroll
                for (int i = 0; i < 4; ++i) *(f32x4*)(orow + i * 4) = hv[i] * rs3 * *(const f32x4*)(P.final_norm_g + lane * 16 + i * 4);
                __builtin_amdgcn_wave_barrier();
            }
        }
    }
#ifdef TIMED_MASK
    {
        xcd_barrier(xb);
        const long long tn_ = (long long)__builtin_amdgcn_s_memrealtime();
        if ((TIMED_MASK >> ph_idx) & 1) t_acc += tn_ - t_last;
        const long long t_end = tn_ + t_acc;
        while ((long long)__builtin_amdgcn_s_memrealtime() < t_end) __builtin_amdgcn_s_sleep(8);
    }
#endif
    if (PH & (1 << 12)) {
        PHASE_IDS
        GRID_SYNC();
        const float* src = (PH & (1 << 5)) ? (const float*)P.out : P.x;
        for (int r = bid * 4 + wid; r < T; r += nb * 4) {
            const float* srow = src + (size_t)r * 1024;
            f32x4 v[4]; float ss = 0.f;
#pragma unroll
            for (int i = 0; i < 4; ++i) { v[i] = *(const f32x4*)(srow + i * 256 + lane * 4); ss += v[i][0] * v[i][0] + v[i][1] * v[i][1] + v[i][2] * v[i][2] + v[i][3] * v[i][3]; }
            ss = wave_sum(ss);
            const float rs = rsqrtf(ss * (1.0f / 1024.0f) + EPS);
#pragma unroll
            for (int i = 0; i < 4; ++i) *(f32x4*)(P.out + (size_t)r * 1024 + i * 256 + lane * 4) = v[i] * rs * *(const f32x4*)(P.final_norm_g + i * 256 + lane * 4);
        }
    }
}

extern "C" void kernel_launch(void* const* d_in, const int* in_sizes, int n_in, void* d_out, int out_size, void* d_ws, size_t ws_size,
                              hipStream_t stream) {
    (void)in_sizes; (void)n_in; (void)out_size;
    if (ws_size < WS_NEED) { fprintf(stderr, "workspace too small: %zu\n", ws_size); return; }
    static int grid_blocks = 0;
    if (!grid_blocks) {
        int dev = 0, cus = 0, per_cu = 0;
        hipGetDevice(&dev);
        hipDeviceGetAttribute(&cus, hipDeviceAttributeMultiprocessorCount, dev);
        hipOccupancyMaxActiveBlocksPerMultiprocessor(&per_cu, fwd_megakernel, 256, 0);
        if (per_cu > 2) per_cu = 2;
        grid_blocks = cus * per_cu;
    }
    Params p{};
    const float** fp = (const float**)&p;
    (void)fp;
    p.x = (const float*)d_in[0]; p.mem = (const float*)d_in[1]; p.pos = (const int*)d_in[2];
    p.norm_mix_g = (const float*)d_in[3]; p.w_in = (const float*)d_in[4]; p.shift_mu = (const float*)d_in[5];
    p.q_norm_g = (const float*)d_in[6]; p.kv_norm_g = (const float*)d_in[7]; p.w_uq = (const float*)d_in[8]; p.w_ukv = (const float*)d_in[9];
    p.rw_w0 = (const float*)d_in[10]; p.rw_w_up = (const float*)d_in[11]; p.rw_a0 = (const float*)d_in[12]; p.rw_a_up = (const float*)d_in[13];
    p.rw_g_up = (const float*)d_in[14]; p.rw_k_k = (const float*)d_in[15]; p.rw_k_a = (const float*)d_in[16]; p.rw_r_k = (const float*)d_in[17];
    p.rw_lnx_w = (const float*)d_in[18]; p.rw_lnx_b = (const float*)d_in[19]; p.w_out = (const float*)d_in[20];
    p.norm_xa_g = (const float*)d_in[21]; p.norm_mem_g = (const float*)d_in[22]; p.xa_wq = (const float*)d_in[23]; p.xa_wk = (const float*)d_in[24];
    p.xa_wv = (const float*)d_in[25]; p.xa_wo = (const float*)d_in[26]; p.norm_ffn_g = (const float*)d_in[27]; p.peer_wq = (const float*)d_in[28];
    p.peer_keys = (const float*)d_in[29]; p.expert_u = (const float*)d_in[30]; p.expert_v = (const float*)d_in[31]; p.final_norm_g = (const float*)d_in[32];
    p.out = (float*)d_out; p.ws = (char*)d_ws;
    hipMemsetAsync((char*)d_ws + O_XBAR, 0, XCD_BAR_WORDS_BYTES, stream);
    void* args[] = {&p};
    hipError_t e = hipLaunchCooperativeKernel((void*)fwd_megakernel, dim3(grid_blocks), dim3(256), args, 0, stream);
    if (e != hipSuccess) fprintf(stderr, "cooperative launch failed: %s (grid %d)\n", hipGetErrorString(e), grid_blocks);
}
```

```cpp
#include <hip/hip_runtime.h>
#include <hip/hip_cooperative_groups.h>
#include <cstdio>
namespace cg = cooperative_groups;

typedef unsigned short bf16_t;
typedef short bf16x8 __attribute__((ext_vector_type(8)));
typedef float f32x4 __attribute__((ext_vector_type(4)));
typedef unsigned u32x4 __attribute__((ext_vector_type(4)));
typedef unsigned u32x2 __attribute__((ext_vector_type(2)));
typedef long i64x2 __attribute__((ext_vector_type(2)));

#define DEV __device__ __forceinline__

constexpr int T = 16384;
constexpr float EPS = 1e-6f;
constexpr size_t MB = 1u << 20;
constexpr size_t XCD_BAR_WORDS_BYTES = 3456 * 4;

constexpr size_t O_WINT  = 0;
constexpr size_t O_WUQT  = O_WINT  + (size_t)2304 * 1024 * 2;
constexpr size_t O_WUKT  = O_WUQT  + (size_t)768 * 256 * 2;
constexpr size_t O_WUVT  = O_WUKT  + (size_t)512 * 128 * 2;
constexpr size_t O_WUPT  = O_WUVT  + (size_t)512 * 128 * 2;
constexpr size_t O_AUPT  = O_WUPT  + (size_t)512 * 64 * 2;
constexpr size_t O_GUPT  = O_AUPT  + (size_t)512 * 64 * 2;
constexpr size_t O_WOUTT = O_GUPT  + (size_t)512 * 128 * 2;
constexpr size_t O_XAQT  = O_WOUTT + (size_t)1024 * 1024 * 2;
constexpr size_t O_XAKVT = O_XAQT  + (size_t)1024 * 1024 * 2;
constexpr size_t O_XAOT  = O_XAKVT + (size_t)2048 * 1024 * 2;
constexpr size_t O_PWQT  = O_XAOT  + (size_t)1024 * 1024 * 2;
constexpr size_t O_KEYS  = O_PWQT  + (size_t)2048 * 1024 * 2;
constexpr size_t O_SSQ   = O_KEYS  + (size_t)16 * 128 * 128 * 2;
constexpr size_t O_CNT   = O_SSQ   + (size_t)8 * 65536;
constexpr size_t O_ROPE  = O_CNT   + 4096;
constexpr size_t O_KM    = O_ROPE  + (size_t)T * 32 * 8;
constexpr size_t O_VMT   = O_KM    + (size_t)2048 * 1024 * 2;
constexpr size_t O_MEMB  = O_VMT   + (size_t)2048 * 1024 * 2;
constexpr size_t O_PERSIST_END = O_MEMB + (size_t)2048 * 1024 * 2;
constexpr size_t O_XBAR = O_PERSIST_END;
static_assert(O_XBAR + XCD_BAR_WORDS_BYTES <= 40 * MB, "persistent region too large");
constexpr size_t O_P     = 40 * MB;
constexpr size_t O_YRAW  = 40 * MB;
constexpr size_t O_MIX   = 72 * MB;
constexpr size_t O_OXA   = 144 * MB;
constexpr size_t O_H2B   = 72 * MB;
constexpr size_t O_SCORES= 144 * MB;
constexpr size_t O_SCORES_OLD_UNUSED = 40 * MB;
constexpr size_t O_XB    = 112 * MB;
constexpr size_t O_G     = 112 * MB;
constexpr size_t O_QXA   = 72 * MB;
constexpr size_t O_RW_R  = 144 * MB;
constexpr size_t O_RW_K  = 160 * MB;
constexpr size_t O_RW_V  = 176 * MB;
constexpr size_t O_RW_KK = 192 * MB;
constexpr size_t O_RW_KA = 208 * MB;
constexpr size_t O_DECAY = 224 * MB;
constexpr size_t O_H1B   = 144 * MB;
constexpr size_t O_EUB   = 128 * MB;
constexpr size_t O_EUB_OLD = 176 * MB;
constexpr size_t O_EVB   = 56 * MB;
constexpr size_t O_EVB_OLD = 208 * MB;
constexpr size_t O_PQ    = 104 * MB;
constexpr size_t WS_NEED = 256 * MB;

struct Params {
    const float *x, *mem; const int* pos;
    const float *norm_mix_g, *w_in, *shift_mu, *q_norm_g, *kv_norm_g, *w_uq, *w_ukv;
    const float *rw_w0, *rw_w_up, *rw_a0, *rw_a_up, *rw_g_up, *rw_k_k, *rw_k_a, *rw_r_k, *rw_lnx_w, *rw_lnx_b;
    const float *w_out, *norm_xa_g, *norm_mem_g, *xa_wq, *xa_wk, *xa_wv, *xa_wo;
    const float *norm_ffn_g, *peer_wq, *peer_keys, *expert_u, *expert_v, *final_norm_g;
    float* out; char* ws;
};

typedef __bf16 bf16x2_t __attribute__((ext_vector_type(2)));
typedef float f32x2_t __attribute__((ext_vector_type(2)));
DEV unsigned cvt_pk_bf16(float lo, float hi) { const f32x2_t f = {lo, hi}; const bf16x2_t b = __builtin_convertvector(f, bf16x2_t); unsigned r; __builtin_memcpy(&r, &b, 4); return r; }
DEV float bf_lo(unsigned u) { return __uint_as_float(u << 16); }
DEV float bf_hi(unsigned u) { return __uint_as_float(u & 0xffff0000u); }
DEV f32x4 mfma16(bf16x8 a, bf16x8 b, f32x4 c) { return __builtin_amdgcn_mfma_f32_16x16x32_bf16(a, b, c, 0, 0, 0); }
DEV float sigmoidf_(float v) { return 1.0f / (1.0f + __expf(-v)); }
DEV float wave_sum(float v) {
#pragma unroll
    for (int o = 32; o >= 1; o >>= 1) v += __shfl_xor(v, o);
    return v;
}
DEV float allreduce8(float x) {
    x += __int_as_float(__builtin_amdgcn_update_dpp(0, __float_as_int(x), 0xB1, 0xF, 0xF, true));
    x += __int_as_float(__builtin_amdgcn_update_dpp(0, __float_as_int(x), 0x4E, 0xF, 0xF, true));
    x += __int_as_float(__builtin_amdgcn_update_dpp(0, __float_as_int(x), 0x141, 0xF, 0xF, true));
    return x;
}
DEV float opq(float x) { asm("" : "+v"(x)); return x; }
DEV void lds_barrier() { asm volatile("s_waitcnt lgkmcnt(0)\n\ts_barrier" ::: "memory"); }
DEV float allreduce16(float x) {
    x += __int_as_float(__builtin_amdgcn_update_dpp(0, __float_as_int(x), 0xB1, 0xF, 0xF, true));
    x += __int_as_float(__builtin_amdgcn_update_dpp(0, __float_as_int(x), 0x4E, 0xF, 0xF, true));
    x += __int_as_float(__builtin_amdgcn_update_dpp(0, __float_as_int(x), 0x141, 0xF, 0xF, true));
    x += __int_as_float(__builtin_amdgcn_update_dpp(0, __float_as_int(x), 0x140, 0xF, 0xF, true));
    return x;
}
DEV void allreduce16_pair(float& a, float& b) {
    a += __int_as_float(__builtin_amdgcn_update_dpp(0, __float_as_int(a), 0xB1, 0xF, 0xF, true));
    b += __int_as_float(__builtin_amdgcn_update_dpp(0, __float_as_int(b), 0xB1, 0xF, 0xF, true));
    a += __int_as_float(__builtin_amdgcn_update_dpp(0, __float_as_int(a), 0x4E, 0xF, 0xF, true));
    b += __int_as_float(__builtin_amdgcn_update_dpp(0, __float_as_int(b), 0x4E, 0xF, 0xF, true));
    a += __int_as_float(__builtin_amdgcn_update_dpp(0, __float_as_int(a), 0x141, 0xF, 0xF, true));
    b += __int_as_float(__builtin_amdgcn_update_dpp(0, __float_as_int(b), 0x141, 0xF, 0xF, true));
    a += __int_as_float(__builtin_amdgcn_update_dpp(0, __float_as_int(a), 0x140, 0xF, 0xF, true));
    b += __int_as_float(__builtin_amdgcn_update_dpp(0, __float_as_int(b), 0x140, 0xF, 0xF, true));
}
DEV bf16x8 as_bf16x8(u32x4 v) { bf16x8 r; __builtin_memcpy(&r, &v, 16); return r; }

template <bool SWAP, class AL, class EP>
DEV void gemm_tile(AL aload, const bf16_t* __restrict__ Bt, int ldb, int K, int row0, int col0, char* smem, EP epi) {
    int tid = threadIdx.x; asm volatile("" : "+v"(tid));
    const int wid = __builtin_amdgcn_readfirstlane(tid >> 6), lane = tid & 63, wr = wid >> 1, wc = wid & 1, fr = lane & 15, fq = lane >> 4;
    constexpr int RS = 144;
    constexpr int TB = 128 * RS;
    char* sA = smem; char* sB = smem + 2 * TB;
    f32x4 acc[4][4];
#pragma unroll
    for (int m = 0; m < 4; ++m)
#pragma unroll
        for (int n = 0; n < 4; ++n) acc[m][n] = (f32x4){0.f, 0.f, 0.f, 0.f};
    const int lr = tid >> 3, lk = (tid & 7) * 8;
    const bf16_t* bp = Bt + (size_t)(col0 + lr) * ldb + lk;
    const int lo = lr * RS + (tid & 7) * 16;
    u32x4 ra[4], rb[4];
#pragma unroll
    for (int i = 0; i < 4; ++i) { ra[i] = aload(row0 + lr + 32 * i, lk); rb[i] = *(const u32x4*)(bp + (size_t)(32 * i) * ldb); }
#pragma unroll
    for (int i = 0; i < 4; ++i) { *(u32x4*)(sA + lo + i * 32 * RS) = ra[i]; *(u32x4*)(sB + lo + i * 32 * RS) = rb[i]; }
    __syncthreads();
    const int nt = K >> 6;
    for (int t = 0; t < nt; ++t) {
        const bool more = (t + 1 < nt);
        if (more) {
            const int kb = (t + 1) << 6;
#pragma unroll
            for (int i = 0; i < 4; ++i) { ra[i] = aload(row0 + lr + 32 * i, kb + lk); rb[i] = *(const u32x4*)(bp + (size_t)(32 * i) * ldb + kb); }
        }
        const char* a = sA + (t & 1) * TB; const char* b = sB + (t & 1) * TB;
#pragma unroll
        for (int kh = 0; kh < 2; ++kh) {
            bf16x8 af[4], bfr[4];
#pragma unroll
            for (int m = 0; m < 4; ++m) af[m] = *(const bf16x8*)(a + (wr * 64 + m * 16 + fr) * RS + kh * 64 + fq * 16);
#pragma unroll
            for (int n = 0; n < 4; ++n) bfr[n] = *(const bf16x8*)(b + (wc * 64 + n * 16 + fr) * RS + kh * 64 + fq * 16);
#pragma unroll
            for (int m = 0; m < 4; ++m)
#pragma unroll
                for (int n = 0; n < 4; ++n)
                    acc[m][n] = SWAP ? mfma16(bfr[n], af[m], acc[m][n]) : mfma16(af[m], bfr[n], acc[m][n]);
        }
        if (more) {
            const int o = ((t + 1) & 1) * TB;
#pragma unroll
            for (int i = 0; i < 4; ++i) { *(u32x4*)(sA + o + lo + i * 32 * RS) = ra[i]; *(u32x4*)(sB + o + lo + i * 32 * RS) = rb[i]; }
        }
        __syncthreads();
    }
    int rb_ = row0 + wr * 64, cb_ = col0 + wc * 64;
    asm volatile("" : "+s"(rb_), "+s"(cb_));
    epi(acc, rb_, cb_, fr, fq);
}

#define GLDS16(gp, lp) __builtin_amdgcn_global_load_lds((const unsigned*)(gp), (__attribute__((address_space(3))) unsigned*)(lp), 16, 0, 0)
template <bool SWAP, class EP>
DEV void gemm_tile_glds(const bf16_t* __restrict__ A, int lda, const bf16_t* __restrict__ Bt, int ldb, int K, int row0, int col0, char* smem, EP epi) {
    int tid = threadIdx.x; asm volatile("" : "+v"(tid));
    const int wid = __builtin_amdgcn_readfirstlane(tid >> 6), lane = tid & 63, wr = wid >> 1, wc = wid & 1, fr = lane & 15, fq = lane >> 4;
    constexpr int ST = 16384;
    f32x4 acc[4][4];
#pragma unroll
    for (int m = 0; m < 4; ++m)
#pragma unroll
        for (int n = 0; n < 4; ++n) acc[m][n] = (f32x4){0.f, 0.f, 0.f, 0.f};
    const int b0 = tid * 16, r0 = b0 >> 6, c0 = (b0 & 63) >> 1;
    const bf16_t* ap0 = A + (size_t)(row0 + r0) * lda + c0;
    const bf16_t* ap1 = ap0 + (size_t)64 * lda;
    const bf16_t* bp0 = Bt + (size_t)(col0 + r0) * ldb + c0;
    const bf16_t* bp1 = bp0 + (size_t)64 * ldb;
    auto issue = [&](int kt) {
        char* st = smem + (kt & 3) * ST + b0;
        GLDS16(ap0 + kt * 32, st); GLDS16(ap1 + kt * 32, st + 4096);
        GLDS16(bp0 + kt * 32, st + 8192); GLDS16(bp1 + kt * 32, st + 8192 + 4096);
    };
    const int nt = K >> 5;
    asm volatile("s_waitcnt vmcnt(0) lgkmcnt(0)\n\ts_barrier" ::: "memory");
    issue(0);
    if (nt > 1) issue(1);
    if (nt > 2) issue(2);
    for (int t = 0; t < nt; ++t) {
        if (t + 2 < nt) asm volatile("s_waitcnt vmcnt(8)" ::: "memory");
        else if (t + 1 < nt) asm volatile("s_waitcnt vmcnt(4)" ::: "memory");
        else asm volatile("s_waitcnt vmcnt(0)" ::: "memory");
        asm volatile("s_barrier" ::: "memory");
        if (t + 3 < nt) issue(t + 3);
        const char* a = smem + (t & 3) * ST; const char* b = a + 8192;
        bf16x8 af[4], bfr[4];
#pragma unroll
        for (int m = 0; m < 4; ++m) af[m] = *(const bf16x8*)(a + (wr * 64 + m * 16 + fr) * 64 + fq * 16);
#pragma unroll
        for (int n = 0; n < 4; ++n) bfr[n] = *(const bf16x8*)(b + (wc * 64 + n * 16 + fr) * 64 + fq * 16);
#pragma unroll
        for (int m = 0; m < 4; ++m)
#pragma unroll
            for (int n = 0; n < 4; ++n)
                acc[m][n] = SWAP ? mfma16(bfr[n], af[m], acc[m][n]) : mfma16(af[m], bfr[n], acc[m][n]);
    }
    int rb_ = row0 + wr * 64, cb_ = col0 + wc * 64;
    asm volatile("" : "+s"(rb_), "+s"(cb_));
    epi(acc, rb_, cb_, fr, fq);
}

template <bool SWAP, class EP>
DEV void gemm_tile_big(const bf16_t* __restrict__ A, int lda, const bf16_t* __restrict__ Bt, int ldb, int K, int row0, int col0, char* smem, EP epi) {
    int tid = threadIdx.x; asm volatile("" : "+v"(tid));
    const int wid = __builtin_amdgcn_readfirstlane(tid >> 6), lane = tid & 63, wr = wid >> 1, wc = wid & 1, fr = lane & 15, fq = lane >> 4;
    constexpr int ST = 24576;
    f32x4 acc[2][4][4];
#pragma unroll
    for (int h = 0; h < 2; ++h)
#pragma unroll
        for (int m = 0; m < 4; ++m)
#pragma unroll
            for (int n = 0; n < 4; ++n) acc[h][m][n] = (f32x4){0.f, 0.f, 0.f, 0.f};
    const int b0 = tid * 16, r0 = b0 >> 6, c0 = (b0 & 63) >> 1;
    const bf16_t* ap = A + (size_t)(row0 + r0) * lda + c0;
    const bf16_t* bp = Bt + (size_t)(col0 + r0) * ldb + c0;
    const size_t a64 = (size_t)64 * lda, b64 = (size_t)64 * ldb;
    auto issue = [&](int kt) {
        char* st = smem + (kt % 3) * ST + b0;
        GLDS16(ap + kt * 32, st); GLDS16(ap + a64 + kt * 32, st + 4096);
        GLDS16(ap + 2 * a64 + kt * 32, st + 8192); GLDS16(ap + 3 * a64 + kt * 32, st + 12288);
        GLDS16(bp + kt * 32, st + 16384); GLDS16(bp + b64 + kt * 32, st + 16384 + 4096);
    };
    const int nt = K >> 5;
    asm volatile("s_waitcnt vmcnt(0) lgkmcnt(0)\n\ts_barrier" ::: "memory");
    issue(0);
    if (nt > 1) issue(1);
    for (int t = 0; t < nt; ++t) {
        if (t + 1 < nt) asm volatile("s_waitcnt vmcnt(6)" ::: "memory");
        else asm volatile("s_waitcnt vmcnt(0)" ::: "memory");
        asm volatile("s_barrier" ::: "memory");
        if (t + 2 < nt) issue(t + 2);
        const char* a = smem + (t % 3) * ST; const char* b = a + 16384;
        bf16x8 bfr[4], af[2][4];
#pragma unroll
        for (int n = 0; n < 4; ++n) bfr[n] = *(const bf16x8*)(b + (wc * 64 + n * 16 + fr) * 64 + fq * 16);
#pragma unroll
        for (int h = 0; h < 2; ++h)
#pragma unroll
            for (int m = 0; m < 4; ++m) af[h][m] = *(const bf16x8*)(a + (wr * 128 + h * 64 + m * 16 + fr) * 64 + fq * 16);
#pragma unroll
        for (int h = 0; h < 2; ++h)
#pragma unroll
            for (int m = 0; m < 4; ++m)
#pragma unroll
                for (int n = 0; n < 4; ++n)
                    acc[h][m][n] = SWAP ? mfma16(bfr[n], af[h][m], acc[h][m][n]) : mfma16(af[h][m], bfr[n], acc[h][m][n]);
        __builtin_amdgcn_iglp_opt(0);
    }
    int rb_ = row0 + wr * 128, cb_ = col0 + wc * 64;
    asm volatile("" : "+s"(rb_), "+s"(cb_));
    epi(acc[0], rb_, cb_, fr, fq);
    epi(acc[1], rb_ + 64, cb_, fr, fq);
}

DEV void pq_scores_tile(const bf16_t* __restrict__ A, int lda, const bf16_t* __restrict__ Bt, int ldb, int K, int row0, int g,
                        const float* __restrict__ ssq2, const bf16_t* __restrict__ keysb, bf16_t* __restrict__ scores, char* smem) {
    int tid = threadIdx.x; asm volatile("" : "+v"(tid));
    const int wid = __builtin_amdgcn_readfirstlane(tid >> 6), lane = tid & 63, wr = wid >> 1, wc = wid & 1, fr = lane & 15, fq = lane >> 4;
    constexpr int ST = 24576;
    const int col0 = g * 128;
    f32x4 acc[2][4][4];
#pragma unroll
    for (int h = 0; h < 2; ++h)
#pragma unroll
        for (int m = 0; m < 4; ++m)
#pragma unroll
            for (int n = 0; n < 4; ++n) acc[h][m][n] = (f32x4){0.f, 0.f, 0.f, 0.f};
    const int b0 = tid * 16, r0 = b0 >> 6, c0 = (b0 & 63) >> 1;
    const bf16_t* ap = A + (size_t)(row0 + r0) * lda + c0;
    const bf16_t* bp = Bt + (size_t)(col0 + r0) * ldb + c0;
    const size_t a64 = (size_t)64 * lda, b64 = (size_t)64 * ldb;
    auto issue = [&](int kt) {
        char* st = smem + (kt % 3) * ST + b0;
        GLDS16(ap + kt * 32, st); GLDS16(ap + a64 + kt * 32, st + 4096);
        GLDS16(ap + 2 * a64 + kt * 32, st + 8192); GLDS16(ap + 3 * a64 + kt * 32, st + 12288);
        GLDS16(bp + kt * 32, st + 16384); GLDS16(bp + b64 + kt * 32, st + 16384 + 4096);
    };
    const int nt = K >> 5;
    asm volatile("s_waitcnt vmcnt(0) lgkmcnt(0)\n\ts_barrier" ::: "memory");
    issue(0);
    if (nt > 1) issue(1);
    for (int t = 0; t < nt; ++t) {
        if (t + 1 < nt) asm volatile("s_waitcnt vmcnt(6)" ::: "memory");
        else asm volatile("s_waitcnt vmcnt(0)" ::: "memory");
        asm volatile("s_barrier" ::: "memory");
        if (t + 2 < nt) issue(t + 2);
        const char* a = smem + (t % 3) * ST; const char* b = a + 16384;
        bf16x8 bfr[4];
#pragma unroll
        for (int n = 0; n < 4; ++n) bfr[n] = *(const bf16x8*)(b + (wc * 64 + n * 16 + fr) * 64 + fq * 16);
#pragma unroll
        for (int h = 0; h < 2; ++h) {
            bf16x8 af[4];
#pragma unroll
            for (int m = 0; m < 4; ++m) af[m] = *(const bf16x8*)(a + (wr * 128 + h * 64 + m * 16 + fr) * 64 + fq * 16);
#pragma unroll
            for (int m = 0; m < 4; ++m)
#pragma unroll
                for (int n = 0; n < 4; ++n) acc[h][m][n] = mfma16(bfr[n], af[m], acc[h][m][n]);
        }
    }
    u32x2 pk[2][4][4];
#pragma unroll
    for (int h = 0; h < 2; ++h)
#pragma unroll
        for (int m = 0; m < 4; ++m) {
            const int row = row0 + wr * 128 + h * 64 + m * 16 + fr;
            const float rs = rsqrtf(ssq2[row] * (1.0f / 1024.0f) + EPS);
#pragma unroll
            for (int n = 0; n < 4; ++n) {
                const f32x4 v = acc[h][m][n] * rs;
                pk[h][m][n].x = cvt_pk_bf16(v[0], v[1]); pk[h][m][n].y = cvt_pk_bf16(v[2], v[3]);
            }
        }
    constexpr int RS2 = 272;
    char* sA2 = smem; char* sKy = smem + 128 * RS2;
    asm volatile("s_waitcnt lgkmcnt(0)\n\ts_barrier" ::: "memory");
    {
        const bf16_t* kg = keysb + (size_t)g * 128 * 128;
#pragma unroll
        for (int i = 0; i < 8; ++i) { const int c = tid + i * 256, key = c >> 4, cc = c & 15; *(u32x4*)(sKy + key * RS2 + cc * 16) = *(const u32x4*)(kg + (size_t)key * 128 + cc * 8); }
    }
#pragma unroll 1
    for (int half = 0; half < 2; ++half) {
        if (wr == half) {
#pragma unroll
            for (int h = 0; h < 2; ++h)
#pragma unroll
                for (int m = 0; m < 4; ++m)
#pragma unroll
                    for (int n = 0; n < 4; ++n)
                        *(u32x2*)(sA2 + (h * 64 + m * 16 + fr) * RS2 + (wc * 64 + n * 16 + fq * 4) * 2) = pk[h][m][n];
        }
        __syncthreads();
        f32x4 acc2[4][4];
#pragma unroll
        for (int m = 0; m < 4; ++m)
#pragma unroll
            for (int n = 0; n < 4; ++n) acc2[m][n] = (f32x4){0.f, 0.f, 0.f, 0.f};
#pragma unroll
        for (int ks = 0; ks < 4; ++ks) {
            bf16x8 af[4], bfr[4];
#pragma unroll
            for (int m = 0; m < 4; ++m) af[m] = *(const bf16x8*)(sA2 + (wr * 64 + m * 16 + fr) * RS2 + ks * 64 + fq * 16);
#pragma unroll
            for (int n = 0; n < 4; ++n) bfr[n] = *(const bf16x8*)(sKy + (wc * 64 + n * 16 + fr) * RS2 + ks * 64 + fq * 16);
#pragma unroll
            for (int m = 0; m < 4; ++m)
#pragma unroll
                for (int n = 0; n < 4; ++n) acc2[m][n] = mfma16(bfr[n], af[m], acc2[m][n]);
        }
#pragma unroll
        for (int m = 0; m < 4; ++m) {
            const int row = row0 + half * 128 + wr * 64 + m * 16 + fr;
#pragma unroll
            for (int n = 0; n < 4; ++n) {
                const f32x4 v = acc2[m][n];
                u32x2 w; w.x = cvt_pk_bf16(v[0], v[1]); w.y = cvt_pk_bf16(v[2], v[3]);
                *(u32x2*)(scores + (size_t)row * 2048 + col0 + wc * 64 + n * 16 + fq * 4) = w;
            }
        }
        __syncthreads();
    }
}

struct PlainA {
    const bf16_t* A; int lda;
    DEV u32x4 operator()(int row, int k) const { return *(const u32x4*)(A + (size_t)row * lda + k); }
};

DEV void tr_tile(const float* __restrict__ src, int ldn, bf16_t* __restrict__ dst, int ldk, int k0, int n0, int drow0,
                 const float* __restrict__ gain, float* tileS) {
    int tid = threadIdx.x; asm volatile("" : "+v"(tid));
    __syncthreads();
#pragma unroll 4
    for (int i = 0; i < 16; ++i) {
        const int kk = i * 4 + (tid >> 6), nn = tid & 63;
        float v = src[(size_t)(k0 + kk) * ldn + n0 + nn];
        if (gain) v *= gain[k0 + kk];
        tileS[kk * 65 + nn] = v;
    }
    __syncthreads();
#pragma unroll 4
    for (int i = 0; i < 16; ++i) {
        const int nn = i * 4 + (tid >> 6), kk = tid & 63;
        const float v = tileS[kk * 65 + nn];
        dst[(size_t)(drow0 + nn) * ldk + k0 + kk] = (bf16_t)(cvt_pk_bf16(v, 0.f) & 0xffffu);
    }
}

template <int DQK, int DV, bool PREF, int QB>
DEV void attn_item(const bf16_t* __restrict__ q, int ldq, const bf16_t* __restrict__ k, int ldk,
                   const bf16_t* __restrict__ vT, int ldv, int ntiles, int tiles_lo, bf16_t* __restrict__ out, int ldo, char* smem) {
    constexpr int KS = DQK / 32, DB = DV / 16;
    constexpr int KSTR = DQK * 2 + 16;
    constexpr int VSTR = 144;
    constexpr int KCH = 64 * DQK / 8 / 256, VCH = DV * 64 / 8 / 256, KCW = DQK / 8;
    char* sK = smem; char* sV = smem + 64 * KSTR;
    int tid = threadIdx.x; asm volatile("" : "+v"(tid));
    const int wid = __builtin_amdgcn_readfirstlane(tid >> 6), lane = tid & 63, fr = lane & 15, fq = lane >> 4;
    const int my_tiles = (wid < 2) ? tiles_lo : ntiles;
    bf16x8 qf[QB][KS];
#pragma unroll
    for (int qi = 0; qi < QB; ++qi) {
        const bf16_t* qrow = q + (size_t)(wid * 16 * QB + qi * 16 + fr) * ldq;
#pragma unroll
        for (int ks = 0; ks < KS; ++ks) qf[qi][ks] = *(const bf16x8*)(qrow + ks * 32 + fq * 8);
    }
    f32x4 o[QB][DB];
    float mrow[QB], lsum[QB];
#pragma unroll
    for (int qi = 0; qi < QB; ++qi) {
        mrow[qi] = -1e30f; lsum[qi] = 0.f;
#pragma unroll
        for (int db = 0; db < DB; ++db) o[qi][db] = (f32x4){0.f, 0.f, 0.f, 0.f};
    }
    constexpr bool PREFV = PREF && (DV <= 128);
    u32x4 kr[PREF ? KCH : 1], vr[PREFV ? VCH : 1];
    if (PREF) {
#pragma unroll
        for (int i = 0; i < KCH; ++i) { const int c = tid + i * 256, key = c / KCW, cc = c % KCW; kr[PREF ? i : 0] = *(const u32x4*)(k + (size_t)key * ldk + cc * 8); }
        if (PREFV) {
#pragma unroll
            for (int i = 0; i < VCH; ++i) { const int c = tid + i * 256, d = c >> 3, cc = c & 7; vr[PREFV ? i : 0] = *(const u32x4*)(vT + (size_t)d * ldv + cc * 8); }
        }
    }
    for (int kt = 0; kt < ntiles; ++kt) {
        __syncthreads();
        {
            const int kn = kt * 64;
            if (PREF) {
#pragma unroll
                for (int i = 0; i < KCH; ++i) { const int c = tid + i * 256, key = c / KCW, cc = c % KCW; *(u32x4*)(sK + key * KSTR + cc * 16) = kr[PREF ? i : 0]; }
            } else {
#pragma unroll 4
                for (int i = 0; i < KCH; ++i) { const int c = tid + i * 256, key = c / KCW, cc = c % KCW; *(u32x4*)(sK + key * KSTR + cc * 16) = *(const u32x4*)(k + (size_t)(kn + key) * ldk + cc * 8); }
            }
            if (PREFV) {
#pragma unroll
                for (int i = 0; i < VCH; ++i) { const int c = tid + i * 256, d = c >> 3, cc = c & 7; *(u32x4*)(sV + d * VSTR + cc * 16) = vr[PREFV ? i : 0]; }
            } else {
#pragma unroll 4
                for (int i = 0; i < VCH; ++i) { const int c = tid + i * 256, d = c >> 3, cc = c & 7; *(u32x4*)(sV + d * VSTR + cc * 16) = *(const u32x4*)(vT + (size_t)d * ldv + kn + cc * 8); }
            }
        }
        __syncthreads();
        if (PREF && kt + 1 < ntiles) {
            const int kn = (kt + 1) * 64;
#pragma unroll
            for (int i = 0; i < KCH; ++i) { const int c = tid + i * 256, key = c / KCW, cc = c % KCW; kr[PREF ? i : 0] = *(const u32x4*)(k + (size_t)(kn + key) * ldk + cc * 8); }
            if (PREFV) {
#pragma unroll
                for (int i = 0; i < VCH; ++i) { const int c = tid + i * 256, d = c >> 3, cc = c & 7; vr[PREFV ? i : 0] = *(const u32x4*)(vT + (size_t)d * ldv + kn + cc * 8); }
            }
        }
        if (kt < my_tiles) {
            f32x4 s[QB][4];
#pragma unroll
            for (int kb = 0; kb < 4; ++kb) {
#pragma unroll
                for (int qi = 0; qi < QB; ++qi) s[qi][kb] = (f32x4){0.f, 0.f, 0.f, 0.f};
#pragma unroll
                for (int ks = 0; ks < KS; ++ks) {
                    const bf16x8 kf = *(const bf16x8*)(sK + (kb * 16 + fr) * KSTR + ks * 64 + fq * 16);
#pragma unroll
                    for (int qi = 0; qi < QB; ++qi) s[qi][kb] = mfma16(kf, qf[qi][ks], s[qi][kb]);
                }
            }
            bf16x8 pf[QB][2];
#pragma unroll
            for (int qi = 0; qi < QB; ++qi) {
                float mx = -1e30f;
#pragma unroll
                for (int kb = 0; kb < 4; ++kb)
#pragma unroll
                    for (int j = 0; j < 4; ++j) mx = fmaxf(mx, s[qi][kb][j]);
                mx = fmaxf(mx, __shfl_xor(mx, 16)); mx = fmaxf(mx, __shfl_xor(mx, 32));
                const float mnew = fmaxf(mrow[qi], mx);
                const float alpha = __builtin_amdgcn_exp2f(mrow[qi] - mnew);
                mrow[qi] = mnew;
                float ps = 0.f;
#pragma unroll
                for (int kb = 0; kb < 4; ++kb)
#pragma unroll
                    for (int j = 0; j < 4; ++j) { const float e = __builtin_amdgcn_exp2f(s[qi][kb][j] - mnew); s[qi][kb][j] = e; ps += e; }
                lsum[qi] = lsum[qi] * alpha + ps;
#pragma unroll
                for (int db = 0; db < DB; ++db) o[qi][db] *= alpha;
#pragma unroll
                for (int g = 0; g < 2; ++g) {
                    u32x4 w;
                    w.x = cvt_pk_bf16(s[qi][2 * g][0], s[qi][2 * g][1]); w.y = cvt_pk_bf16(s[qi][2 * g][2], s[qi][2 * g][3]);
                    w.z = cvt_pk_bf16(s[qi][2 * g + 1][0], s[qi][2 * g + 1][1]); w.w = cvt_pk_bf16(s[qi][2 * g + 1][2], s[qi][2 * g + 1][3]);
                    pf[qi][g] = as_bf16x8(w);
                }
            }
#pragma unroll
            for (int db = 0; db < DB; ++db) {
#pragma unroll
                for (int g = 0; g < 2; ++g) {
                    const u32x2 v0 = *(const u32x2*)(sV + (db * 16 + fr) * VSTR + ((2 * g) * 16 + fq * 4) * 2);
                    const u32x2 v1 = *(const u32x2*)(sV + (db * 16 + fr) * VSTR + ((2 * g + 1) * 16 + fq * 4) * 2);
                    u32x4 w; w.x = v0.x; w.y = v0.y; w.z = v1.x; w.w = v1.y;
#pragma unroll
                    for (int qi = 0; qi < QB; ++qi) o[qi][db] = mfma16(as_bf16x8(w), pf[qi][g], o[qi][db]);
                }
            }
        }
    }
#pragma unroll
    for (int qi = 0; qi < QB; ++qi) {
        float l = lsum[qi];
        l += __shfl_xor(l, 16); l += __shfl_xor(l, 32);
        const float inv = 1.0f / l;
        bf16_t* orow = out + (size_t)(wid * 16 * QB + qi * 16 + fr) * ldo + fq * 4;
#pragma unroll
        for (int db = 0; db < DB; ++db) {
            u32x2 w; w.x = cvt_pk_bf16(o[qi][db][0] * inv, o[qi][db][1] * inv); w.y = cvt_pk_bf16(o[qi][db][2] * inv, o[qi][db][3] * inv);
            *(u32x2*)(orow + db * 16) = w;
        }
    }
}

#define XB_TMO      128
#define XB_XCNT(j)  (256  + 64 * (j))
#define XB_XSUB(j)  (1280 + 64 * (j))
#define XB_XGEN(j)  (2304 + 64 * (j))
#define XB_TOP      3328
#define XB_TOPGEN   3392
#define XCD_BAR_WORDS 3456
#define XB_SPIN_CAP (1u << 18)
#define LAS __attribute__((address_space(3)))
DEV unsigned xb_ld(unsigned* p)              { return __hip_atomic_load(p, __ATOMIC_RELAXED, __HIP_MEMORY_SCOPE_AGENT); }
DEV unsigned xb_add(unsigned* p, unsigned v) { return __hip_atomic_fetch_add(p, v, __ATOMIC_RELAXED, __HIP_MEMORY_SCOPE_AGENT); }
DEV unsigned xb_xcc_id() { return (unsigned)__builtin_amdgcn_s_getreg((3 << 11) | 20) & 0xFu; }
#define XB_SPIN(cond, bar) do { unsigned _sp = 0; while (cond) { __builtin_amdgcn_s_sleep(1); \
    if ((++_sp & 255u) == 0u) { if (xb_ld(&(bar)[XB_TMO])) break; if (_sp > XB_SPIN_CAP) { atomicAdd(&(bar)[XB_TMO], 1u); break; } } } } while (0)
struct XcdBarrier { unsigned* bar; unsigned x; volatile LAS unsigned* st; };
DEV XcdBarrier xcd_barrier_post(unsigned* bar, volatile LAS unsigned* st) {
    XcdBarrier b; b.bar = bar; b.x = xb_xcc_id(); b.st = st;
    if (threadIdx.x == 0) (void)xb_add(&bar[XB_XCNT(b.x)], 1u);
    return b;
}
DEV void xcd_barrier_complete(unsigned* bar, unsigned x, unsigned& nloc, unsigned& nx) {
    const unsigned G = gridDim.x * gridDim.y * gridDim.z;
    unsigned sum, cnt, mine, sp = 0u;
    for (;;) {
        sum = 0u; cnt = 0u; mine = 0u;
#pragma unroll
        for (unsigned j = 0; j < 16; ++j) { const unsigned c = xb_ld(&bar[XB_XCNT(j)]); sum += c; cnt += (c > 0u) ? 1u : 0u; mine = (j == x) ? c : mine; }
        if (sum == G) break;
        __builtin_amdgcn_s_sleep(1);
        if ((++sp & 255u) == 0u) { if (xb_ld(&bar[XB_TMO])) break; if (sp > XB_SPIN_CAP) { atomicAdd(&bar[XB_TMO], 1u); break; } }
    }
    nloc = mine > 0u ? mine : 1u; nx = cnt > 0u ? cnt : 1u;
}
DEV void xcd_barrier(const XcdBarrier& b) {
    asm volatile("s_waitcnt vmcnt(0)" ::: "memory");
    __syncthreads();
    if (threadIdx.x == 0) {
        unsigned* bar = b.bar;
        __builtin_amdgcn_s_waitcnt(0);
        unsigned nloc = b.st[0], nx = b.st[1];
        if (nloc == 0u) { xcd_barrier_complete(bar, b.x, nloc, nx); b.st[0] = nloc; b.st[1] = nx; }
        const unsigned old = xb_add(&bar[XB_XSUB(b.x)], 1u);
        const unsigned gen = old / nloc;
        if (old + 1u == (gen + 1u) * nloc) {
            __builtin_amdgcn_fence(__ATOMIC_RELEASE, "agent");
            asm volatile("s_waitcnt vmcnt(0)" ::: "memory");
            const unsigned og = xb_add(&bar[XB_TOP], 1u);
            const unsigned tg = og / nx;
            if (og + 1u == (tg + 1u) * nx) xb_add(&bar[XB_TOPGEN], 1u);
            else XB_SPIN(xb_ld(&bar[XB_TOPGEN]) == tg, bar);
            __builtin_amdgcn_fence(__ATOMIC_ACQUIRE, "agent");
            xb_add(&bar[XB_XGEN(b.x)], 1u);
            asm volatile("s_waitcnt vmcnt(0)" ::: "memory");
        } else {
            XB_SPIN(xb_ld(&bar[XB_XGEN(b.x)]) == gen, bar);
            __builtin_amdgcn_fence(__ATOMIC_ACQUIRE, "agent");
            asm volatile("s_waitcnt vmcnt(0)" ::: "memory");
        }
    }
    __syncthreads();
}

DEV unsigned ordkey(float f) { const unsigned u = __float_as_uint(f); return (u & 0x80000000u) ? ~u : (u | 0x80000000u); }
DEV float unordkey(unsigned k) { const unsigned u = (k & 0x80000000u) ? (k & 0x7fffffffu) : ~k; return __uint_as_float(u); }
#define TOPK_INSERT(L, xk) { unsigned x_ = (xk); _Pragma("unroll") for (int s_ = 0; s_ < 16; ++s_) { const unsigned hi_ = max(L[s_], x_); x_ = min(L[s_], x_); L[s_] = hi_; } }
DEV unsigned byte_lookup(unsigned p0, unsigned p1, unsigned p2, unsigned p3, int a) {
    const unsigned w = (a < 8) ? ((a < 4) ? p0 : p1) : ((a < 12) ? p2 : p3);
    return (w >> ((a & 3) * 8)) & 0xffu;
}

DEV void grid_barrier(unsigned* bar, unsigned nblocks, unsigned& gen) {
    __threadfence();
    __syncthreads();
    gen += 1;
    if (threadIdx.x == 0) {
        const unsigned target = gen * nblocks;
        __hip_atomic_fetch_add(bar, 1u, __ATOMIC_RELEASE, __HIP_MEMORY_SCOPE_AGENT);
        while (__hip_atomic_load(bar, __ATOMIC_ACQUIRE, __HIP_MEMORY_SCOPE_AGENT) < target) __builtin_amdgcn_s_sleep(2);
    }
    __syncthreads();
    __threadfence();
}
#ifdef TIMED_MASK
#define GRID_SYNC() do { xcd_barrier(xb); { const long long tn_ = (long long)__builtin_amdgcn_s_memrealtime(); if ((TIMED_MASK >> ph_idx) & 1) t_acc += tn_ - t_last; t_last = tn_; ph_idx++; } } while (0)
#else
#define GRID_SYNC() xcd_barrier(xb)
#endif
#ifndef PH
#define PH 0x0FFF
#endif
constexpr int SMEM_BYTES = 4 * 128 * 144;

__global__ void __launch_bounds__(256, 2) fwd_megakernel(Params P) {
    cg::grid_group grid = cg::this_grid();
    __shared__ __attribute__((aligned(16))) char smem[SMEM_BYTES];
    __shared__ int s_item;
    const int nb = gridDim.x, bid = blockIdx.x;
    const int gsz = nb * 256;
    __shared__ uint4 xb_words;
    if (threadIdx.x == 0) xb_words = make_uint4(0u, 0u, 0u, 0u);
    __syncthreads();
    if (P.ws == nullptr) grid.sync();
    XcdBarrier xb = xcd_barrier_post((unsigned*)(P.ws + O_XBAR), (volatile LAS unsigned*)&xb_words);
#ifdef TIMED_MASK
    long long t_acc = 0, t_last = (long long)__builtin_amdgcn_s_memrealtime(); int ph_idx = 0;
#endif
#define XCD_TILE_LOOP(NM, NN, tm, tn) \
    for (int q_ = (bid % (nb >> 3)), R_ = (NM) >> 3, tm, tn; q_ < R_ * (NN) && ((tn = q_ / R_), (tm = (bid / (nb >> 3)) * R_ + q_ % R_), true); q_ += (nb >> 3))
#define PHASE_IDS int tid = threadIdx.x; asm volatile("" : "+v"(tid)); const int wid = __builtin_amdgcn_readfirstlane(tid >> 6), lane = tid & 63; const int gtid = bid * 256 + tid; (void)wid; (void)lane; (void)gtid;
    char* ws = P.ws;
    float* ssq0 = (float*)(ws + O_SSQ);
    float* ssqm = (float*)(ws + O_SSQ + 65536);
    float* ssqq = (float*)(ws + O_SSQ + 2 * 65536);
    float* ssqkv = (float*)(ws + O_SSQ + 3 * 65536);
    float* ssq1 = (float*)(ws + O_SSQ + 4 * 65536);
    float* ssq2 = (float*)(ws + O_SSQ + 5 * 65536);
    int* counters = (int*)(ws + O_CNT);
    float2* ropetab = (float2*)(ws + O_ROPE);
    bf16_t* p = (bf16_t*)(ws + O_P);
    bf16_t* qmla = (bf16_t*)P.out;
    bf16_t* kfull = (bf16_t*)((char*)P.out + 24 * MB);
    bf16_t* vTm = (bf16_t*)((char*)P.out + 48 * MB);

    auto do_tr = [&](int tile) {
        float* tileS = (float*)smem;

            const float* src; int ldn; bf16_t* dst; int ldk; int KT; int loc; const float* gain = nullptr; int drow_add = 0;
            bool ukv = false;
            if (tile < 560) { loc = tile; src = P.w_in; ldn = 2240; dst = (bf16_t*)(ws + O_WINT); ldk = 1024; KT = 16; gain = P.norm_mix_g; }
            else if (tile < 608) { loc = tile - 560; src = P.w_uq; ldn = 768; dst = (bf16_t*)(ws + O_WUQT); ldk = 256; KT = 4; gain = P.q_norm_g; }
            else if (tile < 640) { loc = tile - 608; src = P.w_ukv; ldn = 1024; dst = (bf16_t*)(ws + O_WUKT); ldk = 128; KT = 2; gain = P.kv_norm_g; ukv = true; }
            else if (tile < 648) { loc = tile - 640; src = P.rw_w_up; ldn = 512; dst = (bf16_t*)(ws + O_WUPT); ldk = 64; KT = 1; }
            else if (tile < 656) { loc = tile - 648; src = P.rw_a_up; ldn = 512; dst = (bf16_t*)(ws + O_AUPT); ldk = 64; KT = 1; }
            else if (tile < 672) { loc = tile - 656; src = P.rw_g_up; ldn = 512; dst = (bf16_t*)(ws + O_GUPT); ldk = 128; KT = 2; }
            else if (tile < 928) { loc = tile - 672; src = P.w_out; ldn = 1024; dst = (bf16_t*)(ws + O_WOUTT); ldk = 1024; KT = 16; }
            else if (tile < 1184) { loc = tile - 928; src = P.xa_wq; ldn = 1024; dst = (bf16_t*)(ws + O_XAQT); ldk = 1024; KT = 16; gain = P.norm_xa_g; }
            else if (tile < 1440) { loc = tile - 1184; src = P.xa_wk; ldn = 1024; dst = (bf16_t*)(ws + O_XAKVT); ldk = 1024; KT = 16; gain = P.norm_mem_g; }
            else if (tile < 1696) { loc = tile - 1440; src = P.xa_wv; ldn = 1024; dst = (bf16_t*)(ws + O_XAKVT); ldk = 1024; KT = 16; gain = P.norm_mem_g; drow_add = 1024; }
            else if (tile < 1952) { loc = tile - 1696; src = P.xa_wo; ldn = 1024; dst = (bf16_t*)(ws + O_XAOT); ldk = 1024; KT = 16; }
            else { loc = tile - 1952; src = P.peer_wq; ldn = 2048; dst = (bf16_t*)(ws + O_PWQT); ldk = 1024; KT = 16; gain = P.norm_ffn_g; }
            const int kt = loc % KT, ntile = loc / KT;
            int n0 = ntile * 64, drow0 = n0 + drow_add;
            if (ukv) {
                const int h = n0 >> 8, part = (n0 >> 7) & 1, d0 = n0 & 127;
                if (part) dst = (bf16_t*)(ws + O_WUVT);
                drow0 = h * 128 + d0;
            }
            tr_tile(src, ldn, dst, ldk, kt * 64, n0, drow0, gain, tileS);
            };
    auto convert_experts = [&](int r0, int r1, int wid, int lane) {
        unsigned char* e8u = (unsigned char*)(ws + O_EUB);
        unsigned char* e8v = (unsigned char*)(ws + O_EVB);
        float* esinv = (float*)(ws + O_SSQ + 6 * 65536);
        for (int r = r0 + wid; r < r1; r += 4) {
            const float* src = (r < 16384) ? (P.expert_u + (size_t)r * 1024) : (P.expert_v + (size_t)(r - 16384) * 1024);
            unsigned char* dst = (r < 16384) ? (e8u + (size_t)r * 1024) : (e8v + (size_t)(r - 16384) * 1024);
            f32x4 v[4]; float amax = 0.f;
#pragma unroll
            for (int i = 0; i < 4; ++i) {
                v[i] = *(const f32x4*)(src + i * 256 + lane * 4);
                amax = fmaxf(amax, fmaxf(fmaxf(fabsf(v[i][0]), fabsf(v[i][1])), fmaxf(fabsf(v[i][2]), fabsf(v[i][3]))));
            }
#pragma unroll
            for (int o = 32; o >= 1; o >>= 1) amax = fmaxf(amax, __shfl_xor(amax, o));
            amax = fmaxf(amax, 1e-30f);
            const float sc = 240.0f / amax;
#pragma unroll
            for (int i = 0; i < 4; ++i) {
                int w = 0;
                w = __builtin_amdgcn_cvt_pk_fp8_f32(v[i][0] * sc, v[i][1] * sc, w, false);
                w = __builtin_amdgcn_cvt_pk_fp8_f32(v[i][2] * sc, v[i][3] * sc, w, true);
                *(int*)(dst + i * 256 + lane * 4) = w;
            }
            if (lane == 0) esinv[r] = amax * (1.0f / 240.0f);
        }
    };
    if (PH & (1 << 0)) {
        PHASE_IDS
        for (int tile = bid; tile < 672 + 512; tile += nb) do_tr(tile < 672 ? tile : tile + 512);
        bf16_t* xb = (bf16_t*)(ws + O_XB);
        bf16_t* memb = (bf16_t*)(ws + O_MEMB);
        for (int r = bid * 4 + wid; r < T + 2048; r += nb * 4) {
            const float* srow = (r < T) ? (P.x + (size_t)r * 1024) : (P.mem + (size_t)(r - T) * 1024);
            bf16_t* drow = (r < T) ? (xb + (size_t)r * 1024) : (memb + (size_t)(r - T) * 1024);
            float ss = 0.f;
#pragma unroll
            for (int i = 0; i < 4; ++i) {
                const f32x4 v = *(const f32x4*)(srow + i * 256 + lane * 4);
                ss += v[0] * v[0] + v[1] * v[1] + v[2] * v[2] + v[3] * v[3];
                u32x2 w; w.x = cvt_pk_bf16(v[0], v[1]); w.y = cvt_pk_bf16(v[2], v[3]);
                *(u32x2*)(drow + i * 256 + lane * 4) = w;
            }
            ss = wave_sum(ss);
            if (lane == 0) { if (r < T) ssq0[r] = ss; else ssqm[r - T] = ss; }
        }
        for (int i = gtid; i < T * 32; i += gsz) {
            const int row = i >> 5, f = i & 31;
            const float inv = exp2f(-(float)f * (13.287712379549449f / 32.0f));
            const float ang = (float)P.pos[row] * inv;
            ropetab[i] = make_float2(cosf(ang), sinf(ang));
        }
        for (int i = gtid; i < T; i += gsz) { ssqq[i] = 0.f; ssqkv[i] = 0.f; ssq1[i] = 0.f; ssq2[i] = 0.f; }
        if (gtid < 64) counters[gtid] = 0;
        {
            bf16_t* keysb = (bf16_t*)(ws + O_KEYS);
            for (int i = gtid; i < 16 * 128 * 128 / 4; i += gsz) {
                const f32x4 v = *(const f32x4*)(P.peer_keys + (size_t)i * 4);
                u32x2 w; w.x = cvt_pk_bf16(v[0], v[1]); w.y = cvt_pk_bf16(v[2], v[3]);
                *(u32x2*)(keysb + (size_t)i * 4) = w;
            }
        }
        {
            u32x4* z = (u32x4*)(ws + O_WINT + (size_t)2240 * 1024 * 2);
            for (int i = gtid; i < 64 * 1024 * 2 / 16; i += gsz) z[i] = (u32x4){0u, 0u, 0u, 0u};
        }
    }
    GRID_SYNC();

    if (PH & (1 << 1)) {
        PHASE_IDS
        const bf16_t* xb = (const bf16_t*)(ws + O_XB);
        const bf16_t* memb = (const bf16_t*)(ws + O_MEMB);
        const bf16_t* winT = (const bf16_t*)(ws + O_WINT);
        const bf16_t* xakvT = (const bf16_t*)(ws + O_XAKVT);
        bf16_t* km = (bf16_t*)(ws + O_KM);
        bf16_t* vmT = (bf16_t*)(ws + O_VMT);
        auto p_epi = [&](const f32x4 (&acc)[4][4], int rbase, int cbase, int fr, int fq) {
#pragma unroll
                        for (int m = 0; m < 4; ++m) {
                            const int row = rbase + m * 16 + fr;
                            const float rs = rsqrtf(ssq0[row] * (1.0f / 1024.0f) + EPS);
                            float ss = 0.f;
#pragma unroll
                            for (int n = 0; n < 4; ++n) {
                                const f32x4 v = acc[m][n] * rs;
                                ss += v[0] * v[0] + v[1] * v[1] + v[2] * v[2] + v[3] * v[3];
                                u32x2 w; w.x = cvt_pk_bf16(v[0], v[1]); w.y = cvt_pk_bf16(v[2], v[3]);
                                *(u32x2*)(p + (size_t)row * 2304 + cbase + n * 16 + fq * 4) = w;
                            }
                            if (cbase < 384) {
                                ss += __shfl_xor(ss, 16); ss += __shfl_xor(ss, 32);
                                if (fq == 0) atomicAdd((cbase < 256) ? &ssqq[row] : &ssqkv[row], ss);
                            }
                        }
                    };
        XCD_TILE_LOOP(64, 16, tm, tn) { gemm_tile_big<true>(xb, 1024, winT, 1024, 1024, tm * 256, tn * 128, smem, p_epi); }
        for (int item = bid; item < 256; item += nb) { const int tm = item >> 1, tn = 16 + (item & 1); gemm_tile_glds<true>(xb, 1024, winT, 1024, 1024, tm * 128, tn * 128, smem, p_epi); }
    }
    GRID_SYNC();

    if (PH & (1 << 2)) {
        PHASE_IDS
        const bf16_t* wuqT = (const bf16_t*)(ws + O_WUQT);
        const bf16_t* wukT = (const bf16_t*)(ws + O_WUKT);
        const bf16_t* wuvT = (const bf16_t*)(ws + O_WUVT);
        const bf16_t* wupT = (const bf16_t*)(ws + O_WUPT);
        const bf16_t* aupT = (const bf16_t*)(ws + O_AUPT);
        const bf16_t* gupT = (const bf16_t*)(ws + O_GUPT);
        bf16_t* gbuf = (bf16_t*)(ws + O_G);
        bf16_t* rwr = (bf16_t*)(ws + O_RW_R);
        bf16_t* rwk = (bf16_t*)(ws + O_RW_K);
        bf16_t* rwv = (bf16_t*)(ws + O_RW_V);
        bf16_t* rwkk = (bf16_t*)(ws + O_RW_KK);
        bf16_t* rwka = (bf16_t*)(ws + O_RW_KA);
        float* decay = (float*)(ws + O_DECAY);
        const float QSCALE = 0.07216878364870322f * 1.4426950408889634f;
        const int N0 = 64 * 6, N1 = N0 + 256, N2 = N1 + 256, N3 = N2 + 512, N4 = N3 + 512, N5 = N4 + 512;
        auto shifted8 = [&](int row, int pc, int j0, float (&o)[8]) {
            const u32x4 cur = *(const u32x4*)(p + (size_t)row * 2304 + pc);
            u32x4 prv = (u32x4){0u, 0u, 0u, 0u};
            if (row & 2047) prv = *(const u32x4*)(p + (size_t)(row - 1) * 2304 + pc);
            const f32x4 m0 = *(const f32x4*)(P.shift_mu + j0), m1 = *(const f32x4*)(P.shift_mu + j0 + 4);
            const unsigned cu[4] = {cur.x, cur.y, cur.z, cur.w}, pu[4] = {prv.x, prv.y, prv.z, prv.w};
#pragma unroll
            for (int i = 0; i < 4; ++i) {
                const float c0 = bf_lo(cu[i]), c1 = bf_hi(cu[i]), p0 = bf_lo(pu[i]), p1 = bf_hi(pu[i]);
                const float mu0 = (i < 2) ? m0[2 * i] : m1[2 * i - 4], mu1 = (i < 2) ? m0[2 * i + 1] : m1[2 * i - 3];
                o[2 * i] = c0 + (p0 - c0) * mu0; o[2 * i + 1] = c1 + (p1 - c1) * mu1;
            }
        };
        auto shifted4 = [&](int row, int pc, int j0, f32x4& o) {
            const u32x2 cur = *(const u32x2*)(p + (size_t)row * 2304 + pc);
            u32x2 prv = (u32x2){0u, 0u};
            if (row & 2047) prv = *(const u32x2*)(p + (size_t)(row - 1) * 2304 + pc);
            const f32x4 mu = *(const f32x4*)(P.shift_mu + j0);
            const float c0 = bf_lo(cur.x), c1 = bf_hi(cur.x), c2 = bf_lo(cur.y), c3 = bf_hi(cur.y);
            const float p0 = bf_lo(prv.x), p1 = bf_hi(prv.x), p2 = bf_lo(prv.y), p3 = bf_hi(prv.y);
            o[0] = c0 + (p0 - c0) * mu[0]; o[1] = c1 + (p1 - c1) * mu[1]; o[2] = c2 + (p2 - c2) * mu[2]; o[3] = c3 + (p3 - c3) * mu[3];
        };
        for (;;) {
            __syncthreads();
            if (tid == 0) s_item = atomicAdd(&counters[1], 1);
            __syncthreads();
            const int item = s_item;
            if (item >= N5) break;
            if (item < N0) {
                const int tm = item / 6, tn = item % 6;
                gemm_tile_big<true>(p, 2304, wuqT, 256, 256, tm * 256, tn * 128, smem,
                    [&](const f32x4 (&acc)[4][4], int rbase, int cbase, int fr, int fq) {
                        const bool rope = (cbase % 192) == 128;
#pragma unroll
                        for (int m = 0; m < 4; ++m) {
                            const int row = rbase + m * 16 + fr;
                            const float rs = rsqrtf(ssqq[row] * (1.0f / 256.0f) + EPS) * QSCALE;
                            f32x4 v[4];
#pragma unroll
                            for (int n = 0; n < 4; ++n) v[n] = acc[m][n] * rs;
                            if (rope) {
#pragma unroll
                                for (int n = 0; n < 2; ++n)
#pragma unroll
                                    for (int j = 0; j < 4; ++j) {
                                        const float2 cs = ropetab[row * 32 + n * 16 + fq * 4 + j];
                                        const float t1 = v[n][j], t2 = v[n + 2][j];
                                        v[n][j] = t1 * cs.x - t2 * cs.y; v[n + 2][j] = t1 * cs.y + t2 * cs.x;
                                    }
                            }
#pragma unroll
                            for (int n = 0; n < 4; ++n) {
                                u32x2 w; w.x = cvt_pk_bf16(v[n][0], v[n][1]); w.y = cvt_pk_bf16(v[n][2], v[n][3]);
                                *(u32x2*)(qmla + (size_t)row * 768 + cbase + n * 16 + fq * 4) = w;
                            }
                        }
                    });
            } else if (item < N1) {
                const int it = item - N0, tm = it >> 2, tn = it & 3;
                gemm_tile_big<true>(p + 256, 2304, wukT, 128, 128, tm * 256, tn * 128, smem,
                    [&](const f32x4 (&acc)[4][4], int rbase, int cbase, int fr, int fq) {
#pragma unroll
                        for (int m = 0; m < 4; ++m) {
                            const int row = rbase + m * 16 + fr;
                            const float rs = rsqrtf(ssqkv[row] * (1.0f / 128.0f) + EPS);
#pragma unroll
                            for (int n = 0; n < 4; ++n) {
                                const int col = cbase + n * 16 + fq * 4, h = col >> 7, d = col & 127;
                                const f32x4 v = acc[m][n] * rs;
                                u32x2 w; w.x = cvt_pk_bf16(v[0], v[1]); w.y = cvt_pk_bf16(v[2], v[3]);
                                *(u32x2*)(kfull + (size_t)row * 768 + h * 192 + d) = w;
                            }
                        }
                    });
            } else if (item < N2) {
                const int it = item - N1, tm = it >> 2, tn = it & 3;
                gemm_tile_big<false>(p + 256, 2304, wuvT, 128, 128, tm * 256, tn * 128, smem,
                    [&](const f32x4 (&acc)[4][4], int rbase, int cbase, int fr, int fq) {
#pragma unroll
                        for (int m = 0; m < 4; ++m) {
                            const int row = rbase + m * 16 + fq * 4;
                            const f32x4 sq = *(const f32x4*)(ssqkv + row);
                            f32x4 rs;
#pragma unroll
                            for (int j = 0; j < 4; ++j) rs[j] = rsqrtf(sq[j] * (1.0f / 128.0f) + EPS);
                            const int b = row >> 11, s = row & 2047;
#pragma unroll
                            for (int n = 0; n < 4; ++n) {
                                const int col = cbase + n * 16 + fr;
                                const f32x4 v = acc[m][n] * rs;
                                u32x2 w; w.x = cvt_pk_bf16(v[0], v[1]); w.y = cvt_pk_bf16(v[2], v[3]);
                                *(u32x2*)(vTm + ((size_t)(b * 512 + col)) * 2048 + s) = w;
                            }
                        }
                    });
            } else if (item < N3) {
                const int it = item - N2, tm = it >> 2, tn = it & 3;
                auto al = [&](int row, int k) -> u32x4 {
                    float o[8]; shifted8(row, 1984 + k, 1536 + k, o);
                    u32x4 w;
                    w.x = cvt_pk_bf16(tanhf(o[0]), tanhf(o[1])); w.y = cvt_pk_bf16(tanhf(o[2]), tanhf(o[3]));
                    w.z = cvt_pk_bf16(tanhf(o[4]), tanhf(o[5])); w.w = cvt_pk_bf16(tanhf(o[6]), tanhf(o[7]));
                    return w;
                };
                gemm_tile<true>(al, wupT, 64, 64, tm * 128, tn * 128, smem,
                    [&](const f32x4 (&acc)[4][4], int rbase, int cbase, int fr, int fq) {
#pragma unroll
                        for (int m = 0; m < 4; ++m) {
                            const int row = rbase + m * 16 + fr;
#pragma unroll
                            for (int n = 0; n < 4; ++n) {
                                const int col = cbase + n * 16 + fq * 4;
                                const f32x4 w0 = *(const f32x4*)(P.rw_w0 + col);
                                f32x4 dv;
#pragma unroll
                                for (int j = 0; j < 4; ++j) {
                                    const float wp = w0[j] + acc[m][n][j];
                                    const float z = -wp;
                                    const float sp = fmaxf(z, 0.f) + log1pf(__expf(-fabsf(z)));
                                    dv[j] = __expf(-__expf(-sp - 0.5f));
                                }
                                *(f32x4*)(decay + (size_t)row * 512 + col) = dv;
                            }
                        }
                    });
            } else if (item < N4) {
                const int it = item - N3, tm = it >> 2, tn = it & 3;
                auto al = [&](int row, int k) -> u32x4 {
                    float o[8]; shifted8(row, 2048 + k, 1600 + k, o);
                    u32x4 w;
                    w.x = cvt_pk_bf16(o[0], o[1]); w.y = cvt_pk_bf16(o[2], o[3]); w.z = cvt_pk_bf16(o[4], o[5]); w.w = cvt_pk_bf16(o[6], o[7]);
                    return w;
                };
                gemm_tile<true>(al, aupT, 64, 64, tm * 128, tn * 128, smem,
                    [&](const f32x4 (&acc)[4][4], int rbase, int cbase, int fr, int fq) {
#pragma unroll
                        for (int m = 0; m < 4; ++m) {
                            const int row = rbase + m * 16 + fr;
                            f32x4 kv[4], kkr[4], av[4];
                            float ss = 0.f;
#pragma unroll
                            for (int n = 0; n < 4; ++n) {
                                const int col = cbase + n * 16 + fq * 4;
                                shifted4(row, 960 + col, 512 + col, kv[n]);
                                const f32x4 kkw = *(const f32x4*)(P.rw_k_k + col);
                                const f32x4 a0 = *(const f32x4*)(P.rw_a0 + col);
#pragma unroll
                                for (int j = 0; j < 4; ++j) {
                                    kkr[n][j] = kv[n][j] * kkw[j]; ss += kkr[n][j] * kkr[n][j];
                                    av[n][j] = sigmoidf_(a0[j] + acc[m][n][j]);
                                }
                            }
                            ss += __shfl_xor(ss, 16); ss += __shfl_xor(ss, 32);
                            const float inv = 1.0f / fmaxf(sqrtf(ss), 1e-12f);
#pragma unroll
                            for (int n = 0; n < 4; ++n) {
                                const int col = cbase + n * 16 + fq * 4;
                                const f32x4 ka = *(const f32x4*)(P.rw_k_a + col);
                                f32x4 rv, vv, kk, k2, kka;
                                shifted4(row, 448 + col, col, rv);
                                shifted4(row, 1472 + col, 1024 + col, vv);
#pragma unroll
                                for (int j = 0; j < 4; ++j) {
                                    kk[j] = kkr[n][j] * inv;
                                    k2[j] = kv[n][j] * (1.0f + (av[n][j] - 1.0f) * ka[j]);
                                    kka[j] = kk[j] * av[n][j];
                                }
                                const size_t o = (size_t)row * 512 + col;
                                u32x2 w;
                                w.x = cvt_pk_bf16(rv[0], rv[1]); w.y = cvt_pk_bf16(rv[2], rv[3]); *(u32x2*)(rwr + o) = w;
                                w.x = cvt_pk_bf16(k2[0], k2[1]); w.y = cvt_pk_bf16(k2[2], k2[3]); *(u32x2*)(rwk + o) = w;
                                w.x = cvt_pk_bf16(vv[0], vv[1]); w.y = cvt_pk_bf16(vv[2], vv[3]); *(u32x2*)(rwv + o) = w;
                                w.x = cvt_pk_bf16(kk[0], kk[1]); w.y = cvt_pk_bf16(kk[2], kk[3]); *(u32x2*)(rwkk + o) = w;
                                w.x = cvt_pk_bf16(kka[0], kka[1]); w.y = cvt_pk_bf16(kka[2], kka[3]); *(u32x2*)(rwka + o) = w;
                            }
                        }
                    });
            } else {
                const int it = item - N4, tm = it >> 2, tn = it & 3;
                auto al = [&](int row, int k) -> u32x4 {
                    float o[8]; shifted8(row, 2112 + k, 1664 + k, o);
                    u32x4 w;
                    w.x = cvt_pk_bf16(sigmoidf_(o[0]), sigmoidf_(o[1])); w.y = cvt_pk_bf16(sigmoidf_(o[2]), sigmoidf_(o[3]));
                    w.z = cvt_pk_bf16(sigmoidf_(o[4]), sigmoidf_(o[5])); w.w = cvt_pk_bf16(sigmoidf_(o[6]), sigmoidf_(o[7]));
                    return w;
                };
                gemm_tile<true>(al, gupT, 128, 128, tm * 128, tn * 128, smem,
                    [&](const f32x4 (&acc)[4][4], int rbase, int cbase, int fr, int fq) {
#pragma unroll
                        for (int m = 0; m < 4; ++m) {
                            const int row = rbase + m * 16 + fr;
#pragma unroll
                            for (int n = 0; n < 4; ++n) {
                                const f32x4 v = acc[m][n];
                                u32x2 w; w.x = cvt_pk_bf16(v[0], v[1]); w.y = cvt_pk_bf16(v[2], v[3]);
                                *(u32x2*)(gbuf + (size_t)row * 512 + cbase + n * 16 + fq * 4) = w;
                            }
                        }
                    });
            }
        }
        for (int i = gtid; i < T * 32; i += gsz) {
            const int row = i >> 5, f = i & 31;
            const float t1 = __uint_as_float((unsigned)p[(size_t)row * 2304 + 384 + f] << 16);
            const float t2 = __uint_as_float((unsigned)p[(size_t)row * 2304 + 416 + f] << 16);
            const float2 cs = ropetab[i];
            const bf16_t o1 = (bf16_t)(cvt_pk_bf16(t1 * cs.x - t2 * cs.y, 0.f) & 0xffffu);
            const bf16_t o2 = (bf16_t)(cvt_pk_bf16(t1 * cs.y + t2 * cs.x, 0.f) & 0xffffu);
#pragma unroll
            for (int h = 0; h < 4; ++h) { kfull[(size_t)row * 768 + h * 192 + 128 + f] = o1; kfull[(size_t)row * 768 + h * 192 + 160 + f] = o2; }
        }
    }
    GRID_SYNC();

    if (PH & (1 << 3)) {
        PHASE_IDS
        const bf16_t* rwr = (const bf16_t*)(ws + O_RW_R);
        const bf16_t* rwk = (const bf16_t*)(ws + O_RW_K);
        const bf16_t* rwv = (const bf16_t*)(ws + O_RW_V);
        const bf16_t* rwkk = (const bf16_t*)(ws + O_RW_KK);
        const bf16_t* rwka = (const bf16_t*)(ws + O_RW_KA);
        const float* decay = (const float*)(ws + O_DECAY);
        bf16_t* yraw = (bf16_t*)(ws + O_YRAW);
        bf16_t* mix = (bf16_t*)(ws + O_MIX);
        for (;;) {
            __syncthreads();
            if (tid == 0) s_item = atomicAdd(&counters[0], 1);
            __syncthreads();
            const int item = s_item;
            if (item >= 256 + 512 + 128 + 320 + 512) break;
            if (item < 256) {
                const int b = item >> 5, h = (item >> 2) & 7, qr = item & 3;
                float* opnd = (float*)smem;
                float* vbuf = (float*)(smem + 40960);
                float* ybuf = (float*)(smem + 40960 + 2048);
                const int seg = lane & 15, rl = wid * 4 + (lane >> 4);
                const int lstep = tid >> 4, lc4 = (tid & 15) * 4;
                const int vstep = (tid & 63) >> 2, vc4 = (tid & 3) * 4;
                const size_t gbase = ((size_t)b * 2048) * 512 + h * 64;
                u32x2 pr_kk, pr_k, pr_r, pr_ka, pr_v; f32x4 pr_w;
                auto prefetch = [&](int ch) {
                    const size_t o = gbase + (size_t)(ch * 16 + lstep) * 512 + lc4;
                    pr_kk = *(const u32x2*)(rwkk + o); pr_k = *(const u32x2*)(rwk + o); pr_r = *(const u32x2*)(rwr + o); pr_ka = *(const u32x2*)(rwka + o);
                    pr_w = *(const f32x4*)(decay + o);
                    if (tid < 64) pr_v = *(const u32x2*)(rwv + gbase + (size_t)(ch * 16 + vstep) * 512 + qr * 16 + vc4);
                };
                auto commit = [&](int buf) {
                    float* ob = opnd + buf * 5120 + lstep * 64 + lc4;
                    *(f32x4*)(ob + 0 * 1024) = (f32x4){bf_lo(pr_kk.x), bf_hi(pr_kk.x), bf_lo(pr_kk.y), bf_hi(pr_kk.y)};
                    *(f32x4*)(ob + 1 * 1024) = pr_w;
                    *(f32x4*)(ob + 2 * 1024) = (f32x4){bf_lo(pr_k.x), bf_hi(pr_k.x), bf_lo(pr_k.y), bf_hi(pr_k.y)};
                    *(f32x4*)(ob + 3 * 1024) = (f32x4){bf_lo(pr_r.x), bf_hi(pr_r.x), bf_lo(pr_r.y), bf_hi(pr_r.y)};
                    *(f32x4*)(ob + 4 * 1024) = (f32x4){bf_lo(pr_ka.x), bf_hi(pr_ka.x), bf_lo(pr_ka.y), bf_hi(pr_ka.y)};
                    if (tid < 64) *(f32x4*)(vbuf + buf * 256 + vstep * 16 + vc4) = (f32x4){bf_lo(pr_v.x), bf_hi(pr_v.x), bf_lo(pr_v.y), bf_hi(pr_v.y)};
                };
                float s0 = 0.f, s1 = 0.f, s2 = 0.f, s3 = 0.f;
                prefetch(0); commit(0);
                __syncthreads();
                for (int ch = 0; ch < 128; ++ch) {
                    if (ch + 1 < 128) prefetch(ch + 1);
                    const float* ob = opnd + (ch & 1) * 5120 + seg * 4;
                    const float* vb = vbuf + (ch & 1) * 256 + rl;
                    float ykeep = 0.f;
                    f32x4 c_kk = *(const f32x4*)(ob + 0 * 1024), c_w = *(const f32x4*)(ob + 1 * 1024), c_k = *(const f32x4*)(ob + 2 * 1024);
                    f32x4 c_r = *(const f32x4*)(ob + 3 * 1024), c_a = *(const f32x4*)(ob + 4 * 1024);
                    float c_v = vb[0];
                    f32x4 r_prev = c_r;
#pragma unroll
                    for (int s = 0; s < 16; ++s) {
                        f32x4 n_kk = c_kk, n_w = c_w, n_k = c_k, n_r = c_r, n_a = c_a; float n_v = c_v;
                        if (s + 1 < 16) {
                            n_kk = *(const f32x4*)(ob + 0 * 1024 + (s + 1) * 64); n_w = *(const f32x4*)(ob + 1 * 1024 + (s + 1) * 64);
                            n_k = *(const f32x4*)(ob + 2 * 1024 + (s + 1) * 64); n_r = *(const f32x4*)(ob + 3 * 1024 + (s + 1) * 64);
                            n_a = *(const f32x4*)(ob + 4 * 1024 + (s + 1) * 64); n_v = vb[(s + 1) * 16];
                        }
                        __builtin_amdgcn_sched_barrier(0);
                        float t0 = opq(s0 * c_kk[0]), u0 = opq(s0 * r_prev[0]);
                        float t1 = opq(s1 * c_kk[1]), u1 = opq(s1 * r_prev[1]);
                        t0 = opq(__builtin_fmaf(s2, c_kk[2], t0)); u0 = opq(__builtin_fmaf(s2, r_prev[2], u0));
                        t1 = opq(__builtin_fmaf(s3, c_kk[3], t1)); u1 = opq(__builtin_fmaf(s3, r_prev[3], u1));
                        float sa = opq(t0 + t1), y = opq(u0 + u1);
                        const float kv0 = opq(c_k[0] * c_v), kv1 = opq(c_k[1] * c_v), kv2 = opq(c_k[2] * c_v), kv3 = opq(c_k[3] * c_v);
                        allreduce16_pair(sa, y);
                        if (s > 0 && (s - 1) == seg) ykeep = y;
                        const float nsa = -sa;
                        s0 = opq(__builtin_fmaf(s0, c_w[0], opq(__builtin_fmaf(c_a[0], nsa, kv0))));
                        s1 = opq(__builtin_fmaf(s1, c_w[1], opq(__builtin_fmaf(c_a[1], nsa, kv1))));
                        s2 = opq(__builtin_fmaf(s2, c_w[2], opq(__builtin_fmaf(c_a[2], nsa, kv2))));
                        s3 = opq(__builtin_fmaf(s3, c_w[3], opq(__builtin_fmaf(c_a[3], nsa, kv3))));
                        r_prev = c_r;
                        c_kk = n_kk; c_w = n_w; c_k = n_k; c_r = n_r; c_a = n_a; c_v = n_v;
                    }
                    {
                        float u0 = opq(s0 * r_prev[0]), u1 = opq(s1 * r_prev[1]);
                        u0 = opq(__builtin_fmaf(s2, r_prev[2], u0)); u1 = opq(__builtin_fmaf(s3, r_prev[3], u1));
                        float y = u0 + u1;
                        y = allreduce16(y);
                        if (seg == 15) ykeep = y;
                    }
                    ybuf[seg * 16 + rl] = ykeep;
                    lds_barrier();
                    yraw[gbase + (size_t)(ch * 16 + (tid >> 4)) * 512 + qr * 16 + (tid & 15)] = (bf16_t)(cvt_pk_bf16(ybuf[tid], 0.f) & 0xffffu);
                    if (ch + 1 < 128) commit((ch + 1) & 1);
                    lds_barrier();
                }
            } else if (item < 768) {
                const int a = item - 256, qb = 15 - (a >> 5), bh = a & 31, b = bh >> 2, h = bh & 3;
                const size_t row0 = (size_t)b * 2048 + qb * 128;
                attn_item<192, 128, false, 2>(qmla + row0 * 768 + h * 192, 768,
                                    kfull + ((size_t)b * 2048) * 768 + h * 192, 768,
                                    vTm + ((size_t)(b * 4 + h) * 128) * 2048, 2048, 2 * qb + 2, 2 * qb + 1,
                                    mix + row0 * 1024 + h * 128, 1024, smem);
            } else if (item < 896) {
                const int i_ = item - 768, tm = i_ >> 4, tn = i_ & 15;
                const bf16_t* memb = (const bf16_t*)(ws + O_MEMB);
                const bf16_t* xakvT = (const bf16_t*)(ws + O_XAKVT);
                bf16_t* km = (bf16_t*)(ws + O_KM);
                bf16_t* vmT = (bf16_t*)(ws + O_VMT);
                if (tn < 8) {
                    gemm_tile_big<true>(memb, 1024, xakvT, 1024, 1024, tm * 256, tn * 128, smem,
                        [&](const f32x4 (&acc)[4][4], int rbase, int cbase, int fr, int fq) {
#pragma unroll
                            for (int m = 0; m < 4; ++m) {
                                const int row = rbase + m * 16 + fr;
                                const float rs = rsqrtf(ssqm[row] * (1.0f / 1024.0f) + EPS);
#pragma unroll
                                for (int n = 0; n < 4; ++n) {
                                    const f32x4 v = acc[m][n] * rs;
                                    u32x2 w; w.x = cvt_pk_bf16(v[0], v[1]); w.y = cvt_pk_bf16(v[2], v[3]);
                                    *(u32x2*)(km + (size_t)row * 1024 + cbase + n * 16 + fq * 4) = w;
                                }
                            }
                        });
                } else {
                    gemm_tile_big<false>(memb, 1024, xakvT, 1024, 1024, tm * 256, tn * 128, smem,
                        [&](const f32x4 (&acc)[4][4], int rbase, int cbase, int fr, int fq) {
#pragma unroll
                            for (int m = 0; m < 4; ++m) {
                                const int row = rbase + m * 16 + fq * 4;
                                const f32x4 sq = *(const f32x4*)(ssqm + row);
                                f32x4 rs;
#pragma unroll
                                for (int j = 0; j < 4; ++j) rs[j] = rsqrtf(sq[j] * (1.0f / 1024.0f) + EPS);
                                const int b = row >> 8, mi = row & 255;
#pragma unroll
                                for (int n = 0; n < 4; ++n) {
                                    const int col = cbase + n * 16 + fr - 1024;
                                    const f32x4 v = acc[m][n] * rs;
                                    u32x2 w; w.x = cvt_pk_bf16(v[0], v[1]); w.y = cvt_pk_bf16(v[2], v[3]);
                                    *(u32x2*)(vmT + ((size_t)(b * 1024 + col)) * 256 + mi) = w;
                                }
                            }
                        });
                }
            } else {
                const int i_ = item - 896;
                if (i_ < 320) { for (int t_ = 0; t_ < 4; ++t_) { const int tl_ = i_ * 4 + t_; do_tr(tl_ < 512 ? 672 + tl_ : 1696 + (tl_ - 512)); } }
                else { const int r0_ = (i_ - 320) * 64; convert_experts(r0_, r0_ + 64, wid, lane); }
            }
        }
    }
    GRID_SYNC();

    if (PH & (1 << 4)) {
        PHASE_IDS
        const bf16_t* rwr = (const bf16_t*)(ws + O_RW_R);
        const bf16_t* rwk = (const bf16_t*)(ws + O_RW_K);
        const bf16_t* rwv = (const bf16_t*)(ws + O_RW_V);
        const bf16_t* gbuf = (const bf16_t*)(ws + O_G);
        const bf16_t* yraw = (const bf16_t*)(ws + O_YRAW);
        bf16_t* mix = (bf16_t*)(ws + O_MIX);
#pragma unroll 8
        for (int i = gtid; i < T * 128; i += gsz) {
            const int row = i >> 7, c4 = (i & 127) * 4;
            const size_t o = (size_t)row * 512 + c4;
            const u32x2 yu = *(const u32x2*)(yraw + o);
            const f32x4 y = (f32x4){bf_lo(yu.x), bf_hi(yu.x), bf_lo(yu.y), bf_hi(yu.y)};
            float s1 = y[0] + y[1] + y[2] + y[3];
#pragma unroll
            for (int d = 1; d < 16; d <<= 1) s1 += __shfl_xor(s1, d);
            const float mu = s1 * (1.0f / 64.0f);
            const f32x4 dy = y - mu;
            float s2 = dy[0] * dy[0] + dy[1] * dy[1] + dy[2] * dy[2] + dy[3] * dy[3];
            const u32x2 ru = *(const u32x2*)(rwr + o), ku = *(const u32x2*)(rwk + o), vu = *(const u32x2*)(rwv + o), gu = *(const u32x2*)(gbuf + o);
            const f32x4 rk = *(const f32x4*)(P.rw_r_k + c4);
            const f32x4 rv = (f32x4){bf_lo(ru.x), bf_hi(ru.x), bf_lo(ru.y), bf_hi(ru.y)};
            const f32x4 kv = (f32x4){bf_lo(ku.x), bf_hi(ku.x), bf_lo(ku.y), bf_hi(ku.y)};
            const f32x4 vv = (f32x4){bf_lo(vu.x), bf_hi(vu.x), bf_lo(vu.y), bf_hi(vu.y)};
            const f32x4 gv = (f32x4){bf_lo(gu.x), bf_hi(gu.x), bf_lo(gu.y), bf_hi(gu.y)};
            float s3 = rv[0] * kv[0] * rk[0] + rv[1] * kv[1] * rk[1] + rv[2] * kv[2] * rk[2] + rv[3] * kv[3] * rk[3];
#pragma unroll
            for (int d = 1; d < 16; d <<= 1) { s2 += __shfl_xor(s2, d); s3 += __shfl_xor(s3, d); }
            const float rstd = rsqrtf(s2 * (1.0f / 64.0f) + 64e-5f);
            const f32x4 lw = *(const f32x4*)(P.rw_lnx_w + c4), lb = *(const f32x4*)(P.rw_lnx_b + c4);
            f32x4 r;
#pragma unroll
            for (int j = 0; j < 4; ++j) {
#ifdef DBG_NOY
                r[j] = (lb[j] + s3 * vv[j]) * gv[j];
#else
                r[j] = (dy[j] * rstd * lw[j] + lb[j] + s3 * vv[j]) * gv[j];
#endif
            }
            u32x2 w; w.x = cvt_pk_bf16(r[0], r[1]); w.y = cvt_pk_bf16(r[2], r[3]);
            *(u32x2*)(mix + (size_t)row * 1024 + 512 + c4) = w;
        }
    }
    GRID_SYNC();

    if (PH & (1 << 5)) {
        PHASE_IDS
        const bf16_t* mix = (const bf16_t*)(ws + O_MIX);
        const bf16_t* woutT = (const bf16_t*)(ws + O_WOUTT);
        bf16_t* h1b = (bf16_t*)(ws + O_H1B);
        XCD_TILE_LOOP(64, 8, tm, tn) {
            auto almix = [&](int row, int k) -> u32x4 {
#ifdef DBG_ZERO_RWKV
                if (k >= 512) return (u32x4){0u, 0u, 0u, 0u};
#endif
#ifdef DBG_ZERO_MLA
                if (k < 512) return (u32x4){0u, 0u, 0u, 0u};
#endif
                return *(const u32x4*)(mix + (size_t)row * 1024 + k);
            };
            (void)almix; gemm_tile_big<true>(mix, 1024, woutT, 1024, 1024, tm * 256, tn * 128, smem,
                [&](const f32x4 (&acc)[4][4], int rbase, int cbase, int fr, int fq) {
#pragma unroll
                    for (int m = 0; m < 4; ++m) {
                        const int row = rbase + m * 16 + fr;
                        float ss = 0.f;
#pragma unroll
                        for (int n = 0; n < 4; ++n) {
                            const size_t o = (size_t)row * 1024 + cbase + n * 16 + fq * 4;
                            const f32x4 v = *(const f32x4*)(P.x + o) + acc[m][n];
                            ss += v[0] * v[0] + v[1] * v[1] + v[2] * v[2] + v[3] * v[3];
                            *(f32x4*)(P.out + o) = v;
                            u32x2 w; w.x = cvt_pk_bf16(v[0], v[1]); w.y = cvt_pk_bf16(v[2], v[3]);
                            *(u32x2*)(h1b + o) = w;
                        }
                        ss += __shfl_xor(ss, 16); ss += __shfl_xor(ss, 32);
                        if (fq == 0) atomicAdd(&ssq1[row], ss);
                    }
                });
        }
    }
    GRID_SYNC();

    if (PH & (1 << 6)) {
        PHASE_IDS
        const bf16_t* h1b = (const bf16_t*)(ws + O_H1B);
        const bf16_t* xaqT = (const bf16_t*)(ws + O_XAQT);
        bf16_t* qxa = (bf16_t*)(ws + O_QXA);
        const float XSCALE = 0.0625f * 1.4426950408889634f;
        XCD_TILE_LOOP(64, 8, tm, tn) {
            gemm_tile_big<true>(h1b, 1024, xaqT, 1024, 1024, tm * 256, tn * 128, smem,
                [&](const f32x4 (&acc)[4][4], int rbase, int cbase, int fr, int fq) {
#pragma unroll
                    for (int m = 0; m < 4; ++m) {
                        const int row = rbase + m * 16 + fr;
                        const float rs = rsqrtf(ssq1[row] * (1.0f / 1024.0f) + EPS) * XSCALE;
#pragma unroll
                        for (int n = 0; n < 4; ++n) {
                            const f32x4 v = acc[m][n] * rs;
                            u32x2 w; w.x = cvt_pk_bf16(v[0], v[1]); w.y = cvt_pk_bf16(v[2], v[3]);
                            *(u32x2*)(qxa + (size_t)row * 1024 + cbase + n * 16 + fq * 4) = w;
                        }
                    }
                });
        }
    }
    GRID_SYNC();

    if (PH & (1 << 7)) {
        PHASE_IDS
        const bf16_t* qxa = (const bf16_t*)(ws + O_QXA);
        const bf16_t* km = (const bf16_t*)(ws + O_KM);
        const bf16_t* vmT = (const bf16_t*)(ws + O_VMT);
        bf16_t* oxa = (bf16_t*)(ws + O_OXA);
        for (int item = bid; item < 8 * 4 * 32; item += nb) {
            const int qt = item >> 5 & 31, bh = item & 31;
            const int b = bh >> 2, h = bh & 3;
            const size_t row0 = (size_t)b * 2048 + qt * 64;
            attn_item<256, 256, true, 1>(qxa + row0 * 1024 + h * 256, 1024,
                                km + ((size_t)b * 256) * 1024 + h * 256, 1024,
                                vmT + ((size_t)(b * 4 + h) * 256) * 256, 256, 4, 4,
                                oxa + row0 * 1024 + h * 256, 1024, smem);
        }
    }
    GRID_SYNC();

    if (PH & (1 << 8)) {
        PHASE_IDS
        const bf16_t* oxa = (const bf16_t*)(ws + O_OXA);
        const bf16_t* xaoT = (const bf16_t*)(ws + O_XAOT);
        bf16_t* h2b = (bf16_t*)(ws + O_H2B);
        XCD_TILE_LOOP(64, 8, tm, tn) {
            gemm_tile_big<true>(oxa, 1024, xaoT, 1024, 1024, tm * 256, tn * 128, smem,
                [&](const f32x4 (&acc)[4][4], int rbase, int cbase, int fr, int fq) {
#pragma unroll
                    for (int m = 0; m < 4; ++m) {
                        const int row = rbase + m * 16 + fr;
                        float ss = 0.f;
#pragma unroll
                        for (int n = 0; n < 4; ++n) {
                            const size_t o = (size_t)row * 1024 + cbase + n * 16 + fq * 4;
                            const f32x4 v = *(const f32x4*)(P.out + o) + acc[m][n];
                            ss += v[0] * v[0] + v[1] * v[1] + v[2] * v[2] + v[3] * v[3];
                            *(f32x4*)(P.out + o) = v;
                            u32x2 w; w.x = cvt_pk_bf16(v[0], v[1]); w.y = cvt_pk_bf16(v[2], v[3]);
                            *(u32x2*)(h2b + o) = w;
                        }
                        ss += __shfl_xor(ss, 16); ss += __shfl_xor(ss, 32);
                        if (fq == 0) atomicAdd(&ssq2[row], ss);
                    }
                });
        }
    }
    GRID_SYNC();

    if (PH & (1 << 9)) {
        PHASE_IDS
        const bf16_t* h2b = (const bf16_t*)(ws + O_H2B);
        const bf16_t* pwqT = (const bf16_t*)(ws + O_PWQT);
        bf16_t* pq = (bf16_t*)(ws + O_PQ);
        const bf16_t* keysb = (const bf16_t*)(ws + O_KEYS);
        bf16_t* scores = (bf16_t*)(ws + O_SCORES);
        (void)pq;
        XCD_TILE_LOOP(64, 16, tm, g) { pq_scores_tile(h2b, 1024, pwqT, 1024, 1024, tm * 256, g, ssq2, keysb, scores, smem); }
    }
    GRID_SYNC();

    if (PH & (1 << 11)) {
        PHASE_IDS
        const bf16_t* scores = (const bf16_t*)(ws + O_SCORES);
        const unsigned char* eu8 = (const unsigned char*)(ws + O_EUB);
        const unsigned char* ev8 = (const unsigned char*)(ws + O_EVB);
        const float* esinv = (const float*)(ws + O_SSQ + 6 * 65536);
        char* wsm = smem + wid * 13824;
        int* eidx = (int*)wsm;
        float* egate = (float*)(wsm + 4096);
        float* esu = (float*)(wsm + 8192);
        unsigned char* xs = (unsigned char*)(wsm + 12288);
        float* acts = (float*)(wsm + 13312);
        const int fr = lane & 15, fq = lane >> 4;
        for (int witem = bid * 4 + wid; witem < T / 8; witem += nb * 4) {
            const int t0 = witem * 8;
            {
                const int tt = lane >> 3, h = lane & 7;
                const bf16_t* sp = scores + (size_t)(t0 + tt) * 2048 + h * 256;
                unsigned L1[16], L2[16];
#pragma unroll
                for (int s = 0; s < 16; ++s) { L1[s] = 0u; L2[s] = 0u; }
                for (int i = 0; i < 128; i += 8) {
                    const u32x4 a = *(const u32x4*)(sp + i);
                    const u32x4 b = *(const u32x4*)(sp + 128 + i);
                    const unsigned au[4] = {a.x, a.y, a.z, a.w}, bu[4] = {b.x, b.y, b.z, b.w};
#pragma unroll
                    for (int e = 0; e < 4; ++e) {
                        const unsigned id0 = 127u - (unsigned)(i + 2 * e), id1 = id0 - 1u;
                        TOPK_INSERT(L1, (ordkey(bf_lo(au[e])) & ~127u) | id0);
                        TOPK_INSERT(L1, (ordkey(bf_hi(au[e])) & ~127u) | id1);
                        TOPK_INSERT(L2, (ordkey(bf_lo(bu[e])) & ~127u) | id0);
                        TOPK_INSERT(L2, (ordkey(bf_hi(bu[e])) & ~127u) | id1);
                    }
                }
                float v1[16], v2[16];
                unsigned pa0 = 0u, pa1 = 0u, pa2 = 0u, pa3 = 0u, pb0 = 0u, pb1 = 0u, pb2 = 0u, pb3 = 0u;
#pragma unroll
                for (int s = 0; s < 16; ++s) {
                    v1[s] = unordkey(L1[s] & ~127u); v2[s] = unordkey(L2[s] & ~127u);
                    const unsigned i1_ = (127u - (L1[s] & 127u)) << ((s & 3) * 8), i2_ = (127u - (L2[s] & 127u)) << ((s & 3) * 8);
                    if ((s >> 2) == 0) { pa0 |= i1_; pb0 |= i2_; } else if ((s >> 2) == 1) { pa1 |= i1_; pb1 |= i2_; }
                    else if ((s >> 2) == 2) { pa2 |= i1_; pb2 |= i2_; } else { pa3 |= i1_; pb3 |= i2_; }
                }
                unsigned C[16];
#pragma unroll
                for (int s = 0; s < 16; ++s) C[s] = 0u;
#pragma unroll
                for (int a = 0; a < 16; ++a)
#pragma unroll
                    for (int b = 0; b < 16; ++b)
                        if ((a + 1) * (b + 1) <= 16) { TOPK_INSERT(C, (ordkey(v1[a] + v2[b]) & ~255u) | (255u - (unsigned)(a * 16 + b))); }
                float cv[16], sum = 0.f;
                {
                    const float mxv = unordkey(C[0] & ~255u);
                    sum = 0.f;
#pragma unroll
                    for (int s = 0; s < 16; ++s) { cv[s] = __expf(unordkey(C[s] & ~255u) - mxv); sum += cv[s]; }
                }
                const float isum = 1.0f / sum;
#pragma unroll
                for (int s = 0; s < 16; ++s) {
                    const int ab = 255 - (int)(C[s] & 255u), a = ab >> 4, b = ab & 15;
                    const int e = (int)(byte_lookup(pa0, pa1, pa2, pa3, a) * 128u + byte_lookup(pb0, pb1, pb2, pb3, b));
                    eidx[tt * 128 + h * 16 + s] = e;
                    egate[tt * 128 + h * 16 + s] = cv[s] * isum * esinv[16384 + e];
                    esu[tt * 128 + h * 16 + s] = esinv[e];
                }
            }
            __builtin_amdgcn_wave_barrier();
            for (int tt = 0; tt < 8; ++tt) {
                const int row = t0 + tt;
                const float* hrow = P.out + (size_t)row * 1024 + lane * 16;
                f32x4 hv[4];
#pragma unroll
                for (int i = 0; i < 4; ++i) hv[i] = *(const f32x4*)(hrow + i * 4);
                const float rs2 = rsqrtf(ssq2[row] * (1.0f / 1024.0f) + EPS);
                float sxinv;
                {
                    f32x4 a[4]; float amax = 0.f;
#pragma unroll
                    for (int i = 0; i < 4; ++i) {
                        a[i] = hv[i] * *(const f32x4*)(P.norm_ffn_g + lane * 16 + i * 4) * rs2;
                        amax = fmaxf(amax, fmaxf(fmaxf(fabsf(a[i][0]), fabsf(a[i][1])), fmaxf(fabsf(a[i][2]), fabsf(a[i][3]))));
                    }
#pragma unroll
                    for (int o = 32; o >= 1; o >>= 1) amax = fmaxf(amax, __shfl_xor(amax, o));
                    amax = fmaxf(amax, 1e-30f);
                    const float sc = 240.0f / amax; sxinv = amax * (1.0f / 240.0f);
                    int w[4];
#pragma unroll
                    for (int i = 0; i < 4; ++i) {
                        w[i] = __builtin_amdgcn_cvt_pk_fp8_f32(a[i][0] * sc, a[i][1] * sc, 0, false);
                        w[i] = __builtin_amdgcn_cvt_pk_fp8_f32(a[i][2] * sc, a[i][3] * sc, w[i], true);
                    }
                    *(u32x4*)(xs + lane * 16) = (u32x4){(unsigned)w[0], (unsigned)w[1], (unsigned)w[2], (unsigned)w[3]};
                }
                __builtin_amdgcn_wave_barrier();
                int er[8];
#pragma unroll
                for (int eg = 0; eg < 8; ++eg) er[eg] = eidx[tt * 128 + eg * 16 + fr];
                f32x4 acc[8];
#pragma unroll
                for (int eg = 0; eg < 8; ++eg) acc[eg] = (f32x4){0.f, 0.f, 0.f, 0.f};
#pragma unroll 2
                for (int it = 0; it < 16; ++it) {
                    const i64x2 xq = *(const i64x2*)(xs + it * 64 + fq * 16);
#pragma unroll
                    for (int eg = 0; eg < 8; ++eg) {
                        const i64x2 uq = *(const i64x2*)(eu8 + (size_t)er[eg] * 1024 + it * 64 + fq * 16);
                        acc[eg] = __builtin_amdgcn_mfma_f32_16x16x32_fp8_fp8(uq.x, xq.x, acc[eg], 0, 0, 0);
                        acc[eg] = __builtin_amdgcn_mfma_f32_16x16x32_fp8_fp8(uq.y, xq.y, acc[eg], 0, 0, 0);
                    }
                }
                {
                    const int my_eg = fr & 7, my_jp = fr >> 3;
                    float p0 = 0.f, p1 = 0.f;
#pragma unroll
                    for (int eg = 0; eg < 8; ++eg) {
                        const float q0 = my_jp ? acc[eg][2] : acc[eg][0], q1 = my_jp ? acc[eg][3] : acc[eg][1];
                        p0 = (eg == my_eg) ? q0 : p0; p1 = (eg == my_eg) ? q1 : p1;
                    }
                    const int sidx = my_eg * 16 + fq * 4 + my_jp * 2;
                    const f32x2_t gt = *(const f32x2_t*)(egate + tt * 128 + sidx), su = *(const f32x2_t*)(esu + tt * 128 + sidx);
                    const float pre0 = p0 * su[0] * sxinv, pre1 = p1 * su[1] * sxinv;
                    f32x2_t av;
                    av[0] = 0.5f * pre0 * (1.0f + erff(pre0 * 0.70710678118654752f)) * gt[0];
                    av[1] = 0.5f * pre1 * (1.0f + erff(pre1 * 0.70710678118654752f)) * gt[1];
                    *(f32x2_t*)(acts + sidx) = av;
                }
                __builtin_amdgcn_wave_barrier();
                f32x4 oa[4];
#pragma unroll
                for (int i = 0; i < 4; ++i) oa[i] = (f32x4){0.f, 0.f, 0.f, 0.f};
                for (int j0 = 0; j0 < 128; j0 += 8) {
                    const f32x4 a4 = *(const f32x4*)(acts + j0), a5 = *(const f32x4*)(acts + j0 + 4);
                    const float as[8] = {a4[0], a4[1], a4[2], a4[3], a5[0], a5[1], a5[2], a5[3]};
                    u32x4 vq[8];
                    const u32x4 ei0 = *(const u32x4*)(eidx + tt * 128 + j0), ei1 = *(const u32x4*)(eidx + tt * 128 + j0 + 4);
                    const unsigned eis[8] = {ei0.x, ei0.y, ei0.z, ei0.w, ei1.x, ei1.y, ei1.z, ei1.w};
#pragma unroll
                    for (int jj = 0; jj < 8; ++jj) vq[jj] = *(const u32x4*)(ev8 + (size_t)eis[jj] * 1024 + lane * 16);
#pragma unroll
                    for (int jj = 0; jj < 8; ++jj) {
                        const float a = as[jj];
                        const unsigned q4[4] = {vq[jj].x, vq[jj].y, vq[jj].z, vq[jj].w};
#pragma unroll
                        for (int i = 0; i < 4; ++i) {
                            const f32x2_t lo = __builtin_amdgcn_cvt_pk_f32_fp8((int)q4[i], false), hi = __builtin_amdgcn_cvt_pk_f32_fp8((int)q4[i], true);
                            oa[i][0] += a * lo[0]; oa[i][1] += a * lo[1]; oa[i][2] += a * hi[0]; oa[i][3] += a * hi[1];
                        }
                    }
                }
                float ss = 0.f;
#pragma unroll
                for (int i = 0; i < 4; ++i) { hv[i] = hv[i] + oa[i]; ss += hv[i][0] * hv[i][0] + hv[i][1] * hv[i][1] + hv[i][2] * hv[i][2] + hv[i][3] * hv[i][3]; }
                ss = wave_sum(ss);
                const float rs3 = rsqrtf(ss * (1.0f / 1024.0f) + EPS);
                float* orow = P.out + (size_t)row * 1024 + lane * 16;
#pragma unroll
                for (int i = 0; i < 4; ++i) *(f32x4*)(orow + i * 4) = hv[i] * rs3 * *(const f32x4*)(P.final_norm_g + lane * 16 + i * 4);
                __builtin_amdgcn_wave_barrier();
            }
        }
    }
#ifdef TIMED_MASK
    {
        xcd_barrier(xb);
        const long long tn_ = (long long)__builtin_amdgcn_s_memrealtime();
        if ((TIMED_MASK >> ph_idx) & 1) t_acc += tn_ - t_last;
        const long long t_end = tn_ + t_acc;
        while ((long long)__builtin_amdgcn_s_memrealtime() < t_end) __builtin_amdgcn_s_sleep(8);
    }
#endif
    if (PH & (1 << 12)) {
        PHASE_IDS
        GRID_SYNC();
        const float* src = (PH & (1 << 5)) ? (const float*)P.out : P.x;
        for (int r = bid * 4 + wid; r < T; r += nb * 4) {
            const float* srow = src + (size_t)r * 1024;
            f32x4 v[4]; float ss = 0.f;
#pragma unroll
            for (int i = 0; i < 4; ++i) { v[i] = *(const f32x4*)(srow + i * 256 + lane * 4); ss += v[i][0] * v[i][0] + v[i][1] * v[i][1] + v[i][2] * v[i][2] + v[i][3] * v[i][3]; }
            ss = wave_sum(ss);
            const float rs = rsqrtf(ss * (1.0f / 1024.0f) + EPS);
#pragma unroll
            for (int i = 0; i < 4; ++i) *(f32x4*)(P.out + (size_t)r * 1024 + i * 256 + lane * 4) = v[i] * rs * *(const f32x4*)(P.final_norm_g + i * 256 + lane * 4);
        }
    }
}

extern "C" void kernel_launch(void* const* d_in, const int* in_sizes, int n_in, void* d_out, int out_size, void* d_ws, size_t ws_size,
                              hipStream_t stream) {
    (void)in_sizes; (void)n_in; (void)out_size;
    if (ws_size < WS_NEED) { fprintf(stderr, "workspace too small: %zu\n", ws_size); return; }
    static int grid_blocks = 0;
    if (!grid_blocks) {
        int dev = 0, cus = 0, per_cu = 0;
        hipGetDevice(&dev);
        hipDeviceGetAttribute(&cus, hipDeviceAttributeMultiprocessorCount, dev);
        hipOccupancyMaxActiveBlocksPerMultiprocessor(&per_cu, fwd_megakernel, 256, 0);
        if (per_cu > 2) per_cu = 2;
        grid_blocks = cus * per_cu;
    }
    Params p{};
    const float** fp = (const float**)&p;
    (void)fp;
    p.x = (const float*)d_in[0]; p.mem = (const float*)d_in[1]; p.pos = (const int*)d_in[2];
    p.norm_mix_g = (const float*)d_in[3]; p.w_in = (const float*)d_in[4]; p.shift_mu = (const float*)d_in[5];
    p.q_norm_g = (const float*)d_in[6]; p.kv_norm_g = (const float*)d_in[7]; p.w_uq = (const float*)d_in[8]; p.w_ukv = (const float*)d_in[9];
    p.rw_w0 = (const float*)d_in[10]; p.rw_w_up = (const float*)d_in[11]; p.rw_a0 = (const float*)d_in[12]; p.rw_a_up = (const float*)d_in[13];
    p.rw_g_up = (const float*)d_in[14]; p.rw_k_k = (const float*)d_in[15]; p.rw_k_a = (const float*)d_in[16]; p.rw_r_k = (const float*)d_in[17];
    p.rw_lnx_w = (const float*)d_in[18]; p.rw_lnx_b = (const float*)d_in[19]; p.w_out = (const float*)d_in[20];
    p.norm_xa_g = (const float*)d_in[21]; p.norm_mem_g = (const float*)d_in[22]; p.xa_wq = (const float*)d_in[23]; p.xa_wk = (const float*)d_in[24];
    p.xa_wv = (const float*)d_in[25]; p.xa_wo = (const float*)d_in[26]; p.norm_ffn_g = (const float*)d_in[27]; p.peer_wq = (const float*)d_in[28];
    p.peer_keys = (const float*)d_in[29]; p.expert_u = (const float*)d_in[30]; p.expert_v = (const float*)d_in[31]; p.final_norm_g = (const float*)d_in[32];
    p.out = (float*)d_out; p.ws = (char*)d_ws;
    hipMemsetAsync((char*)d_ws + O_XBAR, 0, XCD_BAR_WORDS_BYTES, stream);
    void* args[] = {&p};
    hipError_t e = hipLaunchCooperativeKernel((void*)fwd_megakernel, dim3(grid_blocks), dim3(256), args, 0, stream);
    if (e != hipSuccess) fprintf(stderr, "cooperative launch failed: %s (grid %d)\n", hipGetErrorString(e), grid_blocks);
}
```
